# Optimizing an MI355X kernel written in HIP

```python
import jax, jax.numpy as jnp
from jax import lax
import numpy as np

D_MODEL = 4096
BATCH = 2
SEQ = 4096
DEPTH = 1

MIX_WIDTH = D_MODEL
RWKV_WIDTH = MIX_WIDTH // 2
CONV_WIDTH = MIX_WIDTH - RWKV_WIDTH
RWKV_HEAD_DIM = 64
RWKV_HEADS = RWKV_WIDTH // RWKV_HEAD_DIM
DECAY_LORA = 96
ICLR_LORA = 96
GATE_LORA = 256
RWKV_IN = 3 * RWKV_WIDTH + DECAY_LORA + ICLR_LORA + GATE_LORA
RWKV_SPLITS = (RWKV_WIDTH, 2 * RWKV_WIDTH, 3 * RWKV_WIDTH,
               3 * RWKV_WIDTH + DECAY_LORA, 3 * RWKV_WIDTH + DECAY_LORA + ICLR_LORA)
CONV_IN = 3 * CONV_WIDTH
IN_TOTAL = RWKV_IN + CONV_IN
CONV_K = 3
PEER_HEADS = 8
N_KEYS = 128
N_EXPERTS = N_KEYS * N_KEYS
PEER_QUERY = 256
PEER_HALF = PEER_QUERY // 2
PEER_TOPK = 16
PEER_CHUNK = 128
NORM_EPS = 1e-6
GN_EPS = 64e-5

kernel_name = "hybrid_rwkv7_shortconv_peer"


def rms_norm(x, w):
    xf = x.astype(jnp.float32)
    y = xf * lax.rsqrt(jnp.mean(xf * xf, axis=-1, keepdims=True) + NORM_EPS)
    return (y * w.astype(jnp.float32)).astype(x.dtype)


def shift_right(z, n):
    return jnp.pad(z, ((0, 0), (n, 0), (0, 0)))[:, : z.shape[1]]


def wkv7_scan(r, w, k, v, a, b):
    bsz, _, h, n = r.shape

    def step(state, inp):
        r_t, w_t, k_t, v_t, a_t, b_t = inp
        sa = jnp.einsum('bhij,bhj->bhi', state, a_t)
        state = (state * w_t[:, :, None, :]
                 + sa[..., None] * b_t[:, :, None, :]
                 + v_t[..., None] * k_t[:, :, None, :])
        y_t = jnp.einsum('bhij,bhj->bhi', state, r_t)
        return state, y_t

    xs = tuple(jnp.moveaxis(z, 1, 0) for z in (r, w, k, v, a, b))
    s0 = jnp.zeros((bsz, h, n, n), jnp.float32)
    _, ys = lax.scan(step, s0, xs)
    return jnp.moveaxis(ys, 0, 1)


def rwkv7_time_mix(p, mu, w0, w2, a0, a2, g2, k_k, k_a, r_k, ln_x_w, ln_x_b):
    f32 = jnp.float32
    p = p.astype(f32)
    ps = p + (shift_right(p, 1) - p) * mu.astype(f32)
    r, k, v, wl, al, gl = jnp.split(ps, RWKV_SPLITS, axis=-1)
    w_log = -jax.nn.softplus(-(w0.astype(f32) + jnp.tanh(wl) @ w2.astype(f32))) - 0.5
    decay = jnp.exp(-jnp.exp(w_log))
    a = jax.nn.sigmoid(a0.astype(f32) + al @ a2.astype(f32))
    g = jax.nn.sigmoid(gl) @ g2.astype(f32)
    bsz, s, _ = p.shape
    hv = lambda z: z.reshape(bsz, s, RWKV_HEADS, RWKV_HEAD_DIM)
    hp = lambda z: z.astype(f32).reshape(RWKV_HEADS, RWKV_HEAD_DIM)
    r, k, v, decay, a = hv(r), hv(k), hv(v), hv(decay), hv(a)
    kk = k * hp(k_k)
    kk = kk * lax.rsqrt(jnp.maximum(jnp.sum(kk * kk, axis=-1, keepdims=True), 1e-24))
    k = k * (1.0 + (a - 1.0) * hp(k_a))
    y = wkv7_scan(r, decay, k, v, -kk, kk * a)
    mean = jnp.mean(y, axis=-1, keepdims=True)
    var = jnp.mean(jnp.square(y - mean), axis=-1, keepdims=True)
    y = (y - mean) * lax.rsqrt(var + GN_EPS) * hp(ln_x_w) + hp(ln_x_b)
    y = y + jnp.sum(r * k * hp(r_k), axis=-1, keepdims=True) * v
    return y.reshape(bsz, s, RWKV_WIDTH) * g


def short_conv_mix(p, conv_w):
    b_gate, c_gate, h = jnp.split(p, 3, axis=-1)
    z = c_gate * h
    zc = sum(conv_w[:, j] * shift_right(z, CONV_K - 1 - j) for j in range(CONV_K))
    return b_gate * zc


def peer_ffn(x, w_q, sub_keys, expert_down, expert_up):
    bsz, s, d = x.shape
    q = (x @ w_q).reshape(bsz, s, PEER_HEADS, 2, PEER_HALF)
    scores = jnp.einsum('bshcd,hcnd->bshcn', q, sub_keys).astype(jnp.float32)
    top_s, top_i = lax.top_k(scores, PEER_TOPK)
    cand = top_s[..., 0, :, None] + top_s[..., 1, None, :]
    cand = cand.reshape(bsz, s, PEER_HEADS, PEER_TOPK * PEER_TOPK)
    best_s, best_c = lax.top_k(cand, PEER_TOPK)
    i1 = jnp.take_along_axis(top_i[..., 0, :], best_c // PEER_TOPK, axis=-1)
    i2 = jnp.take_along_axis(top_i[..., 1, :], best_c % PEER_TOPK, axis=-1)
    expert = i1 * N_KEYS + i2
    gate = jax.nn.softmax(best_s, axis=-1).astype(x.dtype)
    n_chunks = (bsz * s) // PEER_CHUNK
    xs = (x.reshape(n_chunks, PEER_CHUNK, d),
          expert.reshape(n_chunks, PEER_CHUNK, PEER_HEADS, PEER_TOPK),
          gate.reshape(n_chunks, PEER_CHUNK, PEER_HEADS, PEER_TOPK))

    def block(args):
        xc, ec, gc = args
        u = jnp.take(expert_down, ec, axis=0)
        act = jax.nn.gelu(jnp.einsum('thkd,td->thk', u, xc), approximate=False)
        vsel = jnp.take(expert_up, ec, axis=0)
        return jnp.einsum('thk,thkd->td', gc * act, vsel)

    out = lax.map(block, xs)
    return out.reshape(bsz, s, d)


def setup_inputs(seed: int = 0) -> dict:
    key = jax.random.key(seed)
    ks = jax.random.split(key, 24)
    f32 = jnp.float32
    nrm = lambda k, shape, scale: jax.random.normal(k, shape, f32) * scale
    L, D, W = DEPTH, D_MODEL, RWKV_WIDTH
    decay_base = jnp.linspace(-6.0, -1.0, W, dtype=f32)
    return {
        "x": nrm(ks[0], (BATCH, SEQ, D), 1.0),
        "norm1_w": 1.0 + nrm(ks[1], (L, D), 0.02),
        "w_in": nrm(ks[2], (L, D, IN_TOTAL), D ** -0.5),
        "mu_shift": jax.random.uniform(ks[3], (L, RWKV_IN), f32),
        "w0": decay_base[None, :] + nrm(ks[4], (L, W), 0.1),
        "w2": nrm(ks[5], (L, DECAY_LORA, W), 0.1 * DECAY_LORA ** -0.5),
        "a0": nrm(ks[6], (L, W), 0.1),
        "a2": nrm(ks[7], (L, ICLR_LORA, W), 0.5 * ICLR_LORA ** -0.5),
        "g2": nrm(ks[8], (L, GATE_LORA, W), GATE_LORA ** -0.5),
        "k_k": 0.85 + nrm(ks[9], (L, W), 0.02),
        "k_a": 1.0 + nrm(ks[10], (L, W), 0.02),
        "r_k": nrm(ks[11], (L, W), 0.1),
        "ln_x_w": 1.0 + nrm(ks[12], (L, W), 0.02),
        "ln_x_b": nrm(ks[13], (L, W), 0.02),
        "conv_w": nrm(ks[14], (L, CONV_WIDTH, CONV_K), CONV_K ** -0.5),
        "w_out": nrm(ks[15], (L, MIX_WIDTH, D), MIX_WIDTH ** -0.5),
        "norm2_w": 1.0 + nrm(ks[16], (L, D), 0.02),
        "w_q": nrm(ks[17], (L, D, PEER_HEADS * PEER_QUERY), D ** -0.5),
        "sub_keys": nrm(ks[18], (L, PEER_HEADS, 2, N_KEYS, PEER_HALF), PEER_HALF ** -0.5),
        "expert_down": nrm(ks[19], (L, N_EXPERTS, D), D ** -0.5),
        "expert_up": nrm(ks[20], (L, N_EXPERTS, D), 0.5),
        "norm_f_w": 1.0 + nrm(ks[21], (D,), 0.02),
    }


def reference(x, norm1_w, w_in, mu_shift, w0, w2, a0, a2, g2, k_k, k_a, r_k, ln_x_w, ln_x_b,
              conv_w, w_out, norm2_w, w_q, sub_keys, expert_down, expert_up, norm_f_w):
    h = x
    for l in range(DEPTH):
        xn = rms_norm(h, norm1_w[l])
        proj = xn @ w_in[l]
        y_rwkv = rwkv7_time_mix(proj[..., :RWKV_IN], mu_shift[l], w0[l], w2[l], a0[l], a2[l], g2[l],
                                k_k[l], k_a[l], r_k[l], ln_x_w[l], ln_x_b[l]).astype(h.dtype)
        y_conv = short_conv_mix(proj[..., RWKV_IN:], conv_w[l])
        mixed = jnp.concatenate([y_rwkv, y_conv], axis=-1)
        h = h + mixed @ w_out[l]
        h = h + peer_ffn(rms_norm(h, norm2_w[l]), w_q[l], sub_keys[l], expert_down[l], expert_up[l])
    return rms_norm(h, norm_f_w)
```

```cpp
#include <hip/hip_runtime.h>
#include <cstdio>
#include <cstdint>
namespace pg8 {
#define PG8_LAS __attribute__((address_space(3)))
typedef unsigned short bf16_t;
typedef short bf16x8 __attribute__((ext_vector_type(8)));
typedef float f32x4 __attribute__((ext_vector_type(4)));
typedef unsigned u32x4 __attribute__((ext_vector_type(4)));
constexpr int BM = 256, BK = 64, HALF = 128, HTB = HALF * BK * 2  , STAGE_BYTES = 8 * HTB, NXCD = 8, WGM = 8;

__host__ __device__ __forceinline__ int lds_byte(int r, int c) { const int st = (r >> 4) * 2 + (c >> 5), rr = r & 15, cc = c & 31, ob = rr * 64 + cc * 2; return st * 1024 + (ob ^ (((ob >> 9) & 1) << 5)); }
__host__ __device__ __forceinline__ void stage_rc(int b, int& R, int& C) { const int st = b / 1024, sb = b % 1024, swz = sb ^ (((sb >> 9) & 1) << 5); R = (st >> 1) * 16 + swz / 64; C = (st & 1) * 32 + (swz % 64) / 2; }
__host__ __device__ __forceinline__ int perm32(int rho) { const int n = rho >> 4, i = rho & 15; return 8 * (i >> 2) + 4 * n + (i & 3); }

struct Unit { int pm, pn; };
struct Gemm { const bf16_t* A; const bf16_t* Bt; int M, N, K, ld; };

struct StaticOrder {
    int nM, nN, nwg, G, c;
    __host__ __device__ void init(int M, int N, int G_, int c_) { nM = M / BM; nN = N / BM; nwg = nM * nN; G = G_; c = c_; }
    __host__ __device__ bool next(int i, Unit& u) const {
        const long L = (long)i * G + c; if (L >= nwg) return false;
        int wgid = (int)L; { const int q = nwg / NXCD, r = nwg % NXCD, xcd = wgid % NXCD, off = wgid / NXCD; wgid = (xcd < r ? xcd * (q + 1) : r * (q + 1) + (xcd - r) * q) + off; }
        const int nig = WGM * nN, gid = wgid / nig, fm = gid * WGM, gsz = (nM - fm) < WGM ? (nM - fm) : WGM;
        u.pm = fm + ((wgid % nig) % gsz); u.pn = (wgid % nig) / gsz; return true;
    }
    __device__ __forceinline__ void a_ready(const Unit&) const {}
    __device__ __forceinline__ void done(const Unit&) const {}
};

struct SingleUnit {
    int pm, pn;
    __device__ __forceinline__ bool next(int i, Unit& u) const { if (i != 0) return false; u.pm = pm; u.pn = pn; return true; }
    __device__ __forceinline__ void a_ready(const Unit&) const {}
    __device__ __forceinline__ void done(const Unit&) const {}
};
__device__ __forceinline__ unsigned cvt_pk_bf16(float lo, float hi) { unsigned r; asm volatile("v_cvt_pk_bf16_f32 %0, %1, %2" : "=v"(r) : "v"(lo), "v"(hi)); return r; }
typedef float f32x2 __attribute__((ext_vector_type(2)));
__device__ __forceinline__ f32x2 gelu_pk(f32x2 v) {
    const f32x2 av = __builtin_elementwise_abs(v), d = av * 0.2316418882f + 1.0f;
    f32x2 t; t.x = __builtin_amdgcn_rcpf(d.x); t.y = __builtin_amdgcn_rcpf(d.y);
    f32x2 q = t * 0.5307027145f + (-0.7265760135f); q = q * t + 0.7107068705f; q = q * t + (-0.142248368f); q = q * t + 0.127414796f; q = q * t;
    const f32x2 s = (v * v) * (-0.72134752044f);
    f32x2 e; e.x = __builtin_amdgcn_exp2f(s.x); e.y = __builtin_amdgcn_exp2f(s.y);
    const f32x2 m = v * (q * e), r = v - m;
    f32x2 o; o.x = v.x < 0.f ? m.x : r.x; o.y = v.y < 0.f ? m.y : r.y; return o;
}


typedef unsigned u32x2 __attribute__((ext_vector_type(2)));
__device__ __forceinline__ float fast_sigmoid(float v) { return __builtin_amdgcn_rcpf(1.0f + __expf(-v)); }

struct EpiPlainBf16 {
    static constexpr bool PERM = true, AFTER_DRAIN = false;
    bf16_t* O; int ldc;
    __device__ __forceinline__ void operator()(const f32x4 (&acc)[2][2][4][2], const Unit& u, int wr, int wc, int fr, int fq) const {
        const int row0 = u.pm * BM + wr * 64 + fr, col0 = u.pn * BM + wc * 32 + 8 * fq;
#pragma unroll
        for (int ai = 0; ai < 2; ++ai)
#pragma unroll
            for (int m = 0; m < 4; ++m) { bf16_t* rowp = O + (size_t)(row0 + ai * HALF + m * 16) * ldc + col0;
#pragma unroll
                for (int bj = 0; bj < 2; ++bj) { const f32x4 v0 = acc[ai][bj][m][0], v1 = acc[ai][bj][m][1];
                    u32x4 w; w.x = cvt_pk_bf16(v0[0], v0[1]); w.y = cvt_pk_bf16(v0[2], v0[3]); w.z = cvt_pk_bf16(v1[0], v1[1]); w.w = cvt_pk_bf16(v1[2], v1[3]);
                    *(u32x4*)(rowp + bj * HALF) = w; } }
    }
};

struct EpiSlabF32 {
    static constexpr bool PERM = false, AFTER_DRAIN = false;
    float* O; int ldc;
    __device__ __forceinline__ void operator()(const f32x4 (&acc)[2][2][4][2], const Unit& u, int wr, int wc, int fr, int fq) const {
        const int row0 = u.pm * BM + wr * 64 + fr, col0 = u.pn * BM + wc * 32 + 4 * fq;
#pragma unroll
        for (int ai = 0; ai < 2; ++ai)
#pragma unroll
            for (int m = 0; m < 4; ++m) { float* rowp = O + (size_t)(row0 + ai * HALF + m * 16) * ldc + col0;
#pragma unroll
                for (int bj = 0; bj < 2; ++bj)
#pragma unroll
                    for (int n = 0; n < 2; ++n) *(f32x4*)(rowp + bj * HALF + n * 16) = acc[ai][bj][m][n]; }
    }
};

#ifndef SCAN_CHUNKED
#define SCAN_CHUNKED 1
#endif
struct EpiLora {
    static constexpr bool PERM = true, AFTER_DRAIN = false;
    float* Wd; bf16_t* Aa; bf16_t* Gg; const float* w0; const float* a0;
    template <int KIND> __device__ __forceinline__ void run(const f32x4 (&acc)[2][2][4][2], const Unit& u, int wr, int wc, int fr, int fq) const {
        const int row0 = u.pm * BM + wr * 64 + fr, col0 = (u.pn & 7) * BM + wc * 32 + 8 * fq;
        f32x4 bv[2][2];
#pragma unroll
        for (int bj = 0; bj < 2; ++bj)
#pragma unroll
            for (int n = 0; n < 2; ++n) { if (KIND == 2) bv[bj][n] = (f32x4){0.f, 0.f, 0.f, 0.f}; else bv[bj][n] = *(const f32x4*)((KIND == 0 ? w0 : a0) + col0 + bj * HALF + 4 * n); }
#pragma unroll
        for (int ai = 0; ai < 2; ++ai)
#pragma unroll
            for (int m = 0; m < 4; ++m) { const size_t roff = (size_t)(row0 + ai * HALF + m * 16) * 2048 + col0;
#pragma unroll
                for (int bj = 0; bj < 2; ++bj) { f32x4 v0 = acc[ai][bj][m][0] + bv[bj][0], v1 = acc[ai][bj][m][1] + bv[bj][1];
                    if (KIND == 0) {
                        f32x4 d0, d1;
                        d0.x = -0.60653066f * fast_sigmoid(v0.x); d0.y = -0.60653066f * fast_sigmoid(v0.y); d0.z = -0.60653066f * fast_sigmoid(v0.z); d0.w = -0.60653066f * fast_sigmoid(v0.w);
                        d1.x = -0.60653066f * fast_sigmoid(v1.x); d1.y = -0.60653066f * fast_sigmoid(v1.y); d1.z = -0.60653066f * fast_sigmoid(v1.z); d1.w = -0.60653066f * fast_sigmoid(v1.w);
                        if (!SCAN_CHUNKED) { d0.x = __expf(d0.x); d0.y = __expf(d0.y); d0.z = __expf(d0.z); d0.w = __expf(d0.w); d1.x = __expf(d1.x); d1.y = __expf(d1.y); d1.z = __expf(d1.z); d1.w = __expf(d1.w); }
                        *(f32x4*)(Wd + roff + bj * HALF) = d0; *(f32x4*)(Wd + roff + bj * HALF + 4) = d1;
                    } else {
                        if (KIND == 1) { v0.x = fast_sigmoid(v0.x); v0.y = fast_sigmoid(v0.y); v0.z = fast_sigmoid(v0.z); v0.w = fast_sigmoid(v0.w); v1.x = fast_sigmoid(v1.x); v1.y = fast_sigmoid(v1.y); v1.z = fast_sigmoid(v1.z); v1.w = fast_sigmoid(v1.w); }
                        u32x4 w; w.x = cvt_pk_bf16(v0.x, v0.y); w.y = cvt_pk_bf16(v0.z, v0.w); w.z = cvt_pk_bf16(v1.x, v1.y); w.w = cvt_pk_bf16(v1.z, v1.w);
                        *(u32x4*)((KIND == 1 ? Aa : Gg) + roff + bj * HALF) = w;
                    } } }
    }
    __device__ __forceinline__ void operator()(const f32x4 (&acc)[2][2][4][2], const Unit& u, int wr, int wc, int fr, int fq) const {
        const int kind = u.pn >> 3;
        if (kind == 0) run<0>(acc, u, wr, wc, fr, fq); else if (kind == 1) run<1>(acc, u, wr, wc, fr, fq); else run<2>(acc, u, wr, wc, fr, fq);
    }
};

template <bool ATOM> struct EpiOut {
    static constexpr bool PERM = true, AFTER_DRAIN = false;
    const float* X; float* H1; bf16_t* HB; const float* nw; float* ssq;
    __device__ __forceinline__ void operator()(const f32x4 (&acc)[2][2][4][2], const Unit& u, int wr, int wc, int fr, int fq) const {
        const int row0 = u.pm * BM + wr * 64 + fr, col0 = u.pn * BM + wc * 32 + 8 * fq;
        f32x4 nv[2][2];
#pragma unroll
        for (int bj = 0; bj < 2; ++bj)
#pragma unroll
            for (int n = 0; n < 2; ++n) nv[bj][n] = *(const f32x4*)(nw + col0 + bj * HALF + 4 * n);
#pragma unroll
        for (int ai = 0; ai < 2; ++ai)
#pragma unroll
            for (int m = 0; m < 4; ++m) { const int row = row0 + ai * HALF + m * 16; const size_t roff = (size_t)row * 4096 + col0; float s = 0.f;
#pragma unroll
                for (int bj = 0; bj < 2; ++bj) {
                    const f32x4 x0 = *(const f32x4*)(X + roff + bj * HALF), x1 = *(const f32x4*)(X + roff + bj * HALF + 4);
                    const f32x4 h0 = acc[ai][bj][m][0] + x0, h1 = acc[ai][bj][m][1] + x1;
                    s += (h0[0] * h0[0] + h0[1] * h0[1]) + (h0[2] * h0[2] + h0[3] * h0[3]) + (h1[0] * h1[0] + h1[1] * h1[1]) + (h1[2] * h1[2] + h1[3] * h1[3]);
                    const f32x4 g0 = h0 * nv[bj][0], g1 = h1 * nv[bj][1];
                    u32x4 w; w.x = cvt_pk_bf16(g0[0], g0[1]); w.y = cvt_pk_bf16(g0[2], g0[3]); w.z = cvt_pk_bf16(g1[0], g1[1]); w.w = cvt_pk_bf16(g1[2], g1[3]);
                    *(u32x4*)(HB + roff + bj * HALF) = w; }
                s += __shfl_xor(s, 16); s += __shfl_xor(s, 32);
                if (ATOM && fq == 0) atomicAdd(ssq + row, s); }
    }
};

struct EpiQ {
    static constexpr bool PERM = true, AFTER_DRAIN = false;
    bf16_t* Q; const float* ssq;
    __device__ __forceinline__ void operator()(const f32x4 (&acc)[2][2][4][2], const Unit& u, int wr, int wc, int fr, int fq) const {
        const int row0 = u.pm * BM + wr * 64 + fr, col0 = u.pn * BM + wc * 32 + 8 * fq;
#pragma unroll
        for (int ai = 0; ai < 2; ++ai)
#pragma unroll
            for (int m = 0; m < 4; ++m) { const int row = row0 + ai * HALF + m * 16; const float rs = __builtin_amdgcn_rsqf(ssq[row] * (1.0f / 4096.0f) + 1e-6f);
                bf16_t* rowp = Q + (size_t)row * 2048 + col0;
#pragma unroll
                for (int bj = 0; bj < 2; ++bj) { const f32x4 v0 = acc[ai][bj][m][0] * rs, v1 = acc[ai][bj][m][1] * rs;
                    u32x4 w; w.x = cvt_pk_bf16(v0[0], v0[1]); w.y = cvt_pk_bf16(v0[2], v0[3]); w.z = cvt_pk_bf16(v1[0], v1[1]); w.w = cvt_pk_bf16(v1[2], v1[3]);
                    *(u32x4*)(rowp + bj * HALF) = w; } }
    }
};

template <class Epi, class Sched, bool ALIGN_EPI = false, bool SP2 = false>
__device__ __forceinline__ void gemm_phase(PG8_LAS unsigned char* lds, const Gemm g, const Sched& S, const Epi& E) {
    const int tid = threadIdx.x, wid = __builtin_amdgcn_readfirstlane(tid >> 6), lane = tid & 63, wr = wid >> 2, wc = wid & 3, fr = lane & 15, fq = lane >> 4;
    const int K = g.ld, nt = g.K / BK;
    unsigned voffA[2], voffB[2];
#pragma unroll
    for (int i = 0; i < 2; ++i) { int R, C; stage_rc(tid * 16 + i * 8192, R, C); const int Rb = Epi::PERM ? ((R & ~31) + perm32(R & 31)) : R;
        voffA[i] = (unsigned)(R * K + C) * 2u; voffB[i] = (unsigned)(Rb * K + C) * 2u; }
    const size_t kstep = (size_t)(BK * 2);
    const size_t hstep = (size_t)HALF * K * 2;
    const size_t tstep = 2 * hstep;
    const unsigned ldsw = (unsigned)wid * 1024u;
    const int aoff = lds_byte(wr * 64 + fr, fq * 8), boff = lds_byte(wc * 32 + fr, fq * 8);
#define PG8_SA(b, h) (((b) * 2 + (h)) * HTB)
#define PG8_SB(b, h) ((4 + (b) * 2 + (h)) * HTB)
#define PG8_STAGE(bufoff, gbase, voff) do { _Pragma("unroll") for (int _i = 0; _i < 2; ++_i) \
        __builtin_amdgcn_global_load_lds((const unsigned*)((const char*)(gbase) + (voff)[_i]), (PG8_LAS unsigned*)(lds + (bufoff) + ldsw + _i * 8192), 16, 0, 0); } while (0)
#define PG8_LDA(dst, b, h) do { _Pragma("unroll") for (int m = 0; m < 4; ++m) _Pragma("unroll") for (int k = 0; k < 2; ++k) dst[m][k] = *(const PG8_LAS bf16x8*)(lds + PG8_SA(b, h) + aoff + m * 2048 + k * 1024); } while (0)
#define PG8_LDB(dst, b, h) do { _Pragma("unroll") for (int n = 0; n < 2; ++n) _Pragma("unroll") for (int k = 0; k < 2; ++k) dst[n][k] = *(const PG8_LAS bf16x8*)(lds + PG8_SB(b, h) + boff + n * 2048 + k * 1024); } while (0)
#define PG8_MMA(ai, bj, At, Bt) do { __builtin_amdgcn_s_setprio(1); _Pragma("unroll") for (int m = 0; m < 4; ++m) _Pragma("unroll") for (int n = 0; n < 2; ++n) _Pragma("unroll") for (int k = 0; k < 2; ++k) \
        acc[ai][bj][m][n] = __builtin_amdgcn_mfma_f32_16x16x32_bf16(Bt[n][k], At[m][k], acc[ai][bj][m][n], 0, 0, 0); __builtin_amdgcn_s_setprio(0); } while (0)
#define PG8_WAIT_V(n) asm volatile("s_waitcnt vmcnt(" #n ")" ::: "memory")
#define PG8_WAIT_L(n) asm volatile("s_waitcnt lgkmcnt(" #n ")" ::: "memory")
#define PG8_BAR __builtin_amdgcn_s_barrier()
#define PG8_SCHED __builtin_amdgcn_sched_barrier(0)
    Unit cur, nxt; int ui = 0;
    if (!S.next(0, cur)) return;
    f32x4 acc[2][2][4][2];
#pragma unroll
    for (int a = 0; a < 2; ++a)
#pragma unroll
        for (int b = 0; b < 2; ++b)
#pragma unroll
            for (int m = 0; m < 4; ++m)
#pragma unroll
                for (int n = 0; n < 2; ++n) acc[a][b][m][n] = (f32x4){0.f, 0.f, 0.f, 0.f};
    bf16x8 At[4][2], B0[2][2], B1[2][2];
    const char* cA = (const char*)g.A + (size_t)cur.pm * tstep; const char* cB = (const char*)g.Bt + (size_t)cur.pn * tstep;
    S.a_ready(cur);
    if constexpr (SP2) {
        PG8_STAGE(PG8_SB(0, 0), cB, voffB); PG8_STAGE(PG8_SB(0, 1), cB + hstep, voffB); PG8_STAGE(PG8_SA(0, 0), cA, voffA); PG8_STAGE(PG8_SA(0, 1), cA + hstep, voffA);
        if (wr == 1) PG8_BAR;
        PG8_WAIT_V(2); PG8_BAR;
        PG8_STAGE(PG8_SB(1, 0), cB + kstep, voffB); PG8_STAGE(PG8_SA(1, 0), cA + kstep, voffA); PG8_STAGE(PG8_SB(1, 1), cB + hstep + kstep, voffB);
        PG8_WAIT_V(6); PG8_BAR;
    } else {
        PG8_STAGE(PG8_SB(0, 0), cB, voffB); PG8_STAGE(PG8_SA(0, 0), cA, voffA); PG8_STAGE(PG8_SB(0, 1), cB + hstep, voffB); PG8_STAGE(PG8_SA(0, 1), cA + hstep, voffA);
        if (wr == 1) PG8_BAR;
        PG8_WAIT_V(4); PG8_BAR;
        PG8_STAGE(PG8_SB(1, 0), cB + kstep, voffB); PG8_STAGE(PG8_SA(1, 0), cA + kstep, voffA); PG8_STAGE(PG8_SB(1, 1), cB + hstep + kstep, voffB);
        PG8_WAIT_V(6); PG8_BAR;
    }
    for (;;) {
        const bool has_next = S.next(ui + 1, nxt);
        const char* nA = has_next ? (const char*)g.A + (size_t)nxt.pm * tstep : cA; const char* nB = has_next ? (const char*)g.Bt + (size_t)nxt.pn * tstep : cB;
        for (int t = 0; t < nt; t += 2) {
            const bool last = (t == nt - 2);
            const char* a1 = cA + (size_t)(t + 1) * kstep;
            const char* a2 = last ? nA : cA + (size_t)(t + 2) * kstep; const char* b2 = last ? nB : cB + (size_t)(t + 2) * kstep;
            const char* a3 = a2 + kstep; const char* b3 = b2 + kstep;
            if (last && has_next) S.a_ready(nxt);
            if constexpr (SP2) {
            PG8_LDB(B0, 0, 0); PG8_LDB(B1, 0, 1); PG8_SCHED; PG8_LDA(At, 0, 0); PG8_STAGE(PG8_SA(1, 1), a1 + hstep, voffA);
            PG8_WAIT_V(8); PG8_WAIT_L(0); PG8_BAR; PG8_MMA(0, 0, At, B0); PG8_MMA(0, 1, At, B1); PG8_BAR; PG8_SCHED;
            PG8_LDA(At, 0, 1); PG8_STAGE(PG8_SB(0, 0), b2, voffB); PG8_STAGE(PG8_SB(0, 1), b2 + hstep, voffB); PG8_STAGE(PG8_SA(0, 0), a2, voffA);
            PG8_WAIT_V(8); PG8_WAIT_L(0); PG8_BAR; PG8_MMA(1, 0, At, B0); PG8_MMA(1, 1, At, B1); PG8_BAR; PG8_SCHED;
            PG8_LDB(B0, 1, 0); PG8_LDB(B1, 1, 1); PG8_SCHED; PG8_LDA(At, 1, 0); PG8_STAGE(PG8_SA(0, 1), a2 + hstep, voffA);
            PG8_WAIT_V(8); PG8_WAIT_L(0); PG8_BAR; PG8_MMA(0, 0, At, B0); PG8_MMA(0, 1, At, B1); PG8_BAR; PG8_SCHED;
            PG8_LDA(At, 1, 1); PG8_STAGE(PG8_SB(1, 0), b3, voffB); PG8_STAGE(PG8_SB(1, 1), b3 + hstep, voffB); PG8_STAGE(PG8_SA(1, 0), a3, voffA);
            PG8_WAIT_V(8); PG8_WAIT_L(0); PG8_BAR; PG8_MMA(1, 0, At, B0); PG8_MMA(1, 1, At, B1); PG8_BAR; PG8_SCHED;
            } else {
            PG8_LDB(B0, 0, 0); PG8_SCHED; PG8_LDA(At, 0, 0); PG8_STAGE(PG8_SA(1, 1), a1 + hstep, voffA);
            PG8_WAIT_L(8); PG8_BAR; PG8_WAIT_L(0); PG8_MMA(0, 0, At, B0); PG8_BAR; PG8_SCHED;
            PG8_LDB(B1, 0, 1); PG8_STAGE(PG8_SB(0, 0), b2, voffB);
            PG8_BAR; PG8_WAIT_L(0); PG8_MMA(0, 1, At, B1); PG8_BAR;
            PG8_LDA(At, 0, 1); PG8_STAGE(PG8_SA(0, 0), a2, voffA);
            PG8_BAR; PG8_WAIT_L(0); PG8_MMA(1, 0, At, B0); PG8_BAR; PG8_SCHED;
            PG8_STAGE(PG8_SB(0, 1), b2 + hstep, voffB);
            PG8_WAIT_V(6); PG8_BAR; PG8_MMA(1, 1, At, B1); PG8_BAR;
            PG8_LDB(B0, 1, 0); PG8_SCHED; PG8_LDA(At, 1, 0); PG8_STAGE(PG8_SA(0, 1), a2 + hstep, voffA);
            PG8_WAIT_L(8); PG8_BAR; PG8_WAIT_L(0); PG8_MMA(0, 0, At, B0); PG8_BAR; PG8_SCHED;
            PG8_LDB(B1, 1, 1); PG8_STAGE(PG8_SB(1, 0), b3, voffB);
            PG8_BAR; PG8_WAIT_L(0); PG8_MMA(0, 1, At, B1); PG8_BAR;
            PG8_LDA(At, 1, 1); PG8_STAGE(PG8_SA(1, 0), a3, voffA);
            PG8_BAR; PG8_WAIT_L(0); PG8_MMA(1, 0, At, B0); PG8_BAR; PG8_SCHED;
            PG8_STAGE(PG8_SB(1, 1), b3 + hstep, voffB);
            PG8_WAIT_V(6); PG8_BAR; PG8_MMA(1, 1, At, B1); PG8_BAR;
            }
        }
        if constexpr (ALIGN_EPI) { if (wr == 0) PG8_BAR; }
        if constexpr (!Epi::AFTER_DRAIN) { E(acc, cur, wr, wc, fr, fq); S.done(cur); }
        if (!has_next) break;
#pragma unroll
        for (int a = 0; a < 2; ++a)
#pragma unroll
            for (int b = 0; b < 2; ++b)
#pragma unroll
                for (int m = 0; m < 4; ++m)
#pragma unroll
                    for (int n = 0; n < 2; ++n) acc[a][b][m][n] = (f32x4){0.f, 0.f, 0.f, 0.f};
        cur = nxt; cA = nA; cB = nB; ++ui;
        if constexpr (ALIGN_EPI) { if (wr == 1) PG8_BAR; }
    }
    PG8_WAIT_V(0);
    if constexpr (!ALIGN_EPI) { if (wr == 0) PG8_BAR; }
    PG8_BAR;
    if constexpr (Epi::AFTER_DRAIN) { E.fused(acc, cur, wr, wc, fr, fq, lds, wid, lane); S.done(cur); }
#undef PG8_SA
#undef PG8_SB
#undef PG8_STAGE
#undef PG8_LDA
#undef PG8_LDB
#undef PG8_MMA
#undef PG8_WAIT_V
#undef PG8_WAIT_L
#undef PG8_BAR
#undef PG8_SCHED
}
}


#define GAS __attribute__((address_space(1)))
#define LAS __attribute__((address_space(3)))
typedef unsigned short bf16;
typedef unsigned v4u __attribute__((ext_vector_type(4)));
typedef unsigned v2u __attribute__((ext_vector_type(2)));
typedef float f32x4 __attribute__((ext_vector_type(4)));
typedef float f32x2 __attribute__((ext_vector_type(2)));
#define RLX_AGENT __ATOMIC_RELAXED, __HIP_MEMORY_SCOPE_AGENT
#define LDS_WAIT() asm volatile("s_waitcnt lgkmcnt(0)" ::: "memory")
#define VM_WAIT() asm volatile("s_waitcnt vmcnt(0)" ::: "memory")

constexpr int NWAVES = 8, NTHREADS = 512;
#ifndef MK_N_LAUNCHES
#define MK_N_LAUNCHES 1
#endif
constexpr int D = 4096, BATCH = 2, SEQ = 4096, M = BATCH * SEQ;
constexpr int RW = 2048, CW = 2048, NH = 32, HD = 64;
constexpr int RWKV_IN = 6592, IN_TOTAL = 12736, NWIN = 12800, NPROJ = 12288;
constexpr int COL_R = 0, COL_K = 2048, COL_V = 4096, COL_CB = 6144, COL_CC = 8192, COL_CH = 10240;
constexpr int SRC_WL = 6144, NLIN = 448, KSPLIT = 4, SLABW = 512;
constexpr int KLORA = 512, NLORA = 6144;
constexpr int PH = 8, NKEYS = 128, NEXP = 16384, PQ = 256, TOPK = 16;
constexpr int NPHASES = 12;

constexpr size_t MiB = 1u << 20;
constexpr size_t WS_CTL = 0, CTL_ZERO_BYTES = 64 * 1024;
constexpr size_t WS_SSQ = 1 * MiB;
constexpr size_t WS_DSCALE = WS_SSQ + 64 * 1024;
constexpr size_t WS_USCALE = WS_DSCALE + 64 * 1024;
constexpr size_t WS_BONUS = 2 * MiB;
constexpr size_t WS_WLORA = 4 * MiB;
constexpr size_t WS_WQT = 10 * MiB;
constexpr size_t WS_WOUTT = 26 * MiB;
constexpr size_t WS_WINT = 58 * MiB;
constexpr size_t WS_XN = 158 * MiB;
constexpr size_t WS_PROJ = 222 * MiB;
constexpr size_t WS_LIN = 422 * MiB;
constexpr size_t WS_WD = 430 * MiB;
constexpr size_t WS_AA = 494 * MiB;
constexpr size_t WS_G = 526 * MiB;
constexpr size_t WS_R = 558 * MiB, WS_K = 590 * MiB, WS_KK = 622 * MiB, WS_BB = 654 * MiB;
constexpr size_t WS_REC = 558 * MiB;
constexpr size_t WS_V = 750 * MiB;
constexpr size_t WS_SLAB = 718 * MiB;
constexpr size_t WS_Y = WS_WD;
constexpr size_t WS_MIXED = 782 * MiB;
constexpr size_t WS_Q = 846 * MiB;
constexpr size_t WS_EIDX = 878 * MiB;
constexpr size_t WS_GATE = 882 * MiB;
constexpr size_t WS_DQ = 886 * MiB;
constexpr size_t WS_UQ = 950 * MiB;
constexpr size_t WS_SKB = 1016 * MiB;
constexpr size_t WS_BR = 1014 * MiB, WS_KR = 1015 * MiB;
constexpr size_t WS_END = 1017 * MiB;

constexpr int CW_BAR = 1024;

constexpr int RING_OFF = 0, RING_BYTES = 131072;
constexpr int LDSCTL_OFF = 147456, MISC_OFF = LDSCTL_OFF + 64;
constexpr int LDS_BYTES = 147456 + 512;

__device__ __forceinline__ unsigned f2bf(float f) { unsigned u = __builtin_bit_cast(unsigned, f); return (u + 0x7fffu + ((u >> 16) & 1u)) >> 16; }
typedef __bf16 bf16x2v __attribute__((ext_vector_type(2)));
__device__ __forceinline__ unsigned pk2(float lo, float hi) { const bf16x2v r = __builtin_convertvector((f32x2){lo, hi}, bf16x2v); return __builtin_bit_cast(unsigned, r); }
__device__ __forceinline__ float bflo(unsigned w) { return __builtin_bit_cast(float, w << 16); }
__device__ __forceinline__ float bfhi(unsigned w) { return __builtin_bit_cast(float, w & 0xffff0000u); }
__device__ __forceinline__ float wave_sum(float v) {
#pragma unroll
    for (int o = 1; o < 64; o <<= 1) v += __shfl_xor(v, o);
    return v;
}
__device__ __forceinline__ float wave_max(float v) {
#pragma unroll
    for (int o = 1; o < 64; o <<= 1) v = fmaxf(v, __shfl_xor(v, o));
    return v;
}
__device__ __forceinline__ float sigmoidf_(float v) { return 1.0f / (1.0f + __expf(-v)); }

#define XB_TMO      128
#define XB_XCNT(j)  (256  + 64 * (j))
#define XB_XSUB(j)  (1280 + 64 * (j))
#define XB_XGEN(j)  (2304 + 64 * (j))
#define XB_TOP      3328
#define XB_TOPGEN   3392
#define XCD_BAR_WORDS 3456
#define XB_SPIN_CAP (1u << 22)
__device__ __forceinline__ unsigned xb_ld(unsigned* p)              { return __hip_atomic_load(p, __ATOMIC_RELAXED, __HIP_MEMORY_SCOPE_AGENT); }
__device__ __forceinline__ unsigned xb_add(unsigned* p, unsigned v) { return __hip_atomic_fetch_add(p, v, __ATOMIC_RELAXED, __HIP_MEMORY_SCOPE_AGENT); }
__device__ __forceinline__ unsigned xb_xcc_id() { return (unsigned)__builtin_amdgcn_s_getreg((3 << 11) | 20) & 0xFu; }
#define XB_SPIN(cond, bar) do { unsigned _sp = 0; while (cond) { __builtin_amdgcn_s_sleep(1); \
    if ((++_sp & 255u) == 0u) { if (xb_ld(&(bar)[XB_TMO])) break; if (_sp > XB_SPIN_CAP) { atomicAdd(&(bar)[XB_TMO], 1u); break; } } } } while (0)
struct XcdBarrier { unsigned* bar; unsigned x; volatile LAS unsigned* st; };
__device__ __forceinline__ XcdBarrier xcd_barrier_post(unsigned* bar, volatile LAS unsigned* st) {
    XcdBarrier b; b.bar = bar; b.x = xb_xcc_id(); b.st = st;
    if (threadIdx.x == 0) (void)xb_add(&bar[XB_XCNT(b.x)], 1u);
    return b;
}
__device__ __forceinline__ void xcd_barrier_complete(unsigned* bar, unsigned x, unsigned& nloc, unsigned& nx) {
    const unsigned G = gridDim.x * gridDim.y * gridDim.z;
    unsigned sum, cnt, mine, sp = 0u;
    for (;;) {
        sum = 0u; cnt = 0u; mine = 0u;
#pragma unroll
        for (unsigned j = 0; j < 16; ++j) { const unsigned c = xb_ld(&bar[XB_XCNT(j)]); sum += c; cnt += (c > 0u) ? 1u : 0u; mine = (j == x) ? c : mine; }
        if (sum == G) break;
        __builtin_amdgcn_s_sleep(1);
        if ((++sp & 255u) == 0u) { if (xb_ld(&bar[XB_TMO])) break; if (sp > XB_SPIN_CAP) { atomicAdd(&bar[XB_TMO], 1u); break; } }
    }
    nloc = mine > 0u ? mine : 1u; nx = cnt > 0u ? cnt : 1u;
}
__device__ __forceinline__ void xcd_barrier(const XcdBarrier& b) {
    asm volatile("s_waitcnt vmcnt(0)" ::: "memory");
    __syncthreads();
    if (threadIdx.x == 0) {
        unsigned* bar = b.bar;
        __builtin_amdgcn_s_waitcnt(0);
        unsigned nloc = b.st[0], nx = b.st[1];
        if (nloc == 0u) { xcd_barrier_complete(bar, b.x, nloc, nx); b.st[0] = nloc; b.st[1] = nx; }
        const unsigned old = xb_add(&bar[XB_XSUB(b.x)], 1u);
        const unsigned gen = old / nloc;
        if (old + 1u == (gen + 1u) * nloc) {
            __builtin_amdgcn_fence(__ATOMIC_RELEASE, "agent");
            asm volatile("s_waitcnt vmcnt(0)" ::: "memory");
            const unsigned og = xb_add(&bar[XB_TOP], 1u);
            const unsigned tg = og / nx;
            if (og + 1u == (tg + 1u) * nx) xb_add(&bar[XB_TOPGEN], 1u);
            else XB_SPIN(xb_ld(&bar[XB_TOPGEN]) == tg, bar);
            __builtin_amdgcn_fence(__ATOMIC_ACQUIRE, "agent");
            xb_add(&bar[XB_XGEN(b.x)], 1u);
            asm volatile("s_waitcnt vmcnt(0)" ::: "memory");
        } else {
            XB_SPIN(xb_ld(&bar[XB_XGEN(b.x)]) == gen, bar);
            __builtin_amdgcn_fence(__ATOMIC_ACQUIRE, "agent");
            asm volatile("s_waitcnt vmcnt(0)" ::: "memory");
        }
    }
    __syncthreads();
}

struct Args {
    const float* in[22]; float* out; unsigned char* ws; int ph_lo, ph_hi, li, pad;
};

template <bool WIN> __device__ __forceinline__ void p0_transpose_item(const float* W, int K, int N, bf16* WT, LAS float* scr, int item, int lane) {
    const int nblk = N / 32, kb = item / nblk, nb = item % nblk, k0 = 64 * kb, n0 = 32 * nb;
    const int d0 = !WIN ? n0 : (n0 < SRC_WL ? n0 : (n0 < RWKV_IN ? NPROJ + (n0 - SRC_WL) : n0 - NLIN));
#pragma unroll 8
    for (int i = 0; i < 32; ++i) { const int kk = 2 * i + (lane >> 5); scr[kk * 33 + (lane & 31)] = W[(size_t)(k0 + kk) * N + n0 + (lane & 31)]; }
    LDS_WAIT(); asm volatile("" ::: "memory");
    const int c = lane & 7;
#pragma unroll
    for (int j = 0; j < 4; ++j) { const int n = (lane >> 3) + 8 * j; const LAS float* s = scr + (8 * c) * 33 + n;
        v4u o; o.x = pk2(s[0 * 33], s[1 * 33]); o.y = pk2(s[2 * 33], s[3 * 33]); o.z = pk2(s[4 * 33], s[5 * 33]); o.w = pk2(s[6 * 33], s[7 * 33]);
        *(GAS v4u*)(WT + (size_t)(d0 + n) * K + k0 + 8 * c) = o; }
    LDS_WAIT(); asm volatile("" ::: "memory");
}

#ifndef PEER_FP6
#define PEER_FP6 1
#endif
#ifndef PEER_UP_FP4
#define PEER_UP_FP4 1
#endif
constexpr int ROWB = PEER_FP6 ? 3072 : 4096;
#ifndef PEER_DN_FP4
#define PEER_DN_FP4 0
#endif
constexpr int ROWB_DN = PEER_DN_FP4 ? 2048 : ROWB;
constexpr int ROWB_UP = PEER_UP_FP4 ? 2048 : ROWB;
typedef float f32x16v __attribute__((ext_vector_type(16)));
typedef float f32x32v __attribute__((ext_vector_type(32)));
typedef unsigned v6u __attribute__((ext_vector_type(6)));
__device__ __forceinline__ void quant_pack_store(const f32x4 (&v)[16], float am, unsigned char* dst, float* scp, int lane, bool fp4 = false) {
    if ((PEER_UP_FP4 || PEER_DN_FP4) && fp4) {
        const float s4 = am > 0.f ? 6.0f / am : 1.0f;
        if (lane == 0) *scp = am > 0.f ? am * (1.0f / 6.0f) : 1.0f;
        unsigned d4[8];
#pragma unroll
        for (int w = 0; w < 8; ++w) { unsigned p = 0u;
#define FP4_PK(b2) { const int t0 = 8 * w + 2 * (b2); p = (unsigned)__builtin_amdgcn_cvt_scalef32_pk_fp4_f32(p, v[t0 >> 2][t0 & 3] * s4, v[(t0 + 1) >> 2][(t0 + 1) & 3] * s4, 1.0f, b2); }
            FP4_PK(0) FP4_PK(1) FP4_PK(2) FP4_PK(3)
#undef FP4_PK
            d4[w] = p; }
        *(GAS v4u*)(dst + lane * 16) = (v4u){d4[0], d4[1], d4[2], d4[3]}; *(GAS v4u*)(dst + 1024 + lane * 16) = (v4u){d4[4], d4[5], d4[6], d4[7]};
        return;
    }
    constexpr float QMAX = PEER_FP6 ? 7.5f : 448.0f;
    const float s = am > 0.f ? QMAX / am : 1.0f;
    if (lane == 0) *scp = am > 0.f ? am * (1.0f / QMAX) : 1.0f;
#if PEER_FP6
    unsigned d[12];
#pragma unroll
    for (int g = 0; g < 2; ++g) { f32x16v x0, x1;
#pragma unroll
        for (int i = 0; i < 16; ++i) { const int t0 = 32 * g + 2 * i, t1 = t0 + 1;
            x0[i] = v[t0 >> 2][t0 & 3] * s; x1[i] = v[t1 >> 2][t1 & 3] * s; }
        const v6u pk = __builtin_amdgcn_cvt_scalef32_2xpk16_fp6_f32(x0, x1, 1.0f);
#pragma unroll
        for (int k = 0; k < 6; ++k) d[g * 6 + k] = pk[k]; }
#pragma unroll
    for (int c = 0; c < 3; ++c) *(GAS v4u*)(dst + c * 1024 + lane * 16) = (v4u){d[4 * c], d[4 * c + 1], d[4 * c + 2], d[4 * c + 3]};
#else
#pragma unroll
    for (int i = 0; i < 4; ++i) { v4u o;
#pragma unroll
        for (int j = 0; j < 4; ++j) { const f32x4 x = v[i * 4 + j] * s; int p = __builtin_amdgcn_cvt_pk_fp8_f32(x.x, x.y, 0, false); p = __builtin_amdgcn_cvt_pk_fp8_f32(x.z, x.w, p, true); o[j] = (unsigned)p; }
        *(GAS v4u*)(dst + i * 1024 + lane * 16) = o; }
#endif
}
__device__ __forceinline__ void load_qrow(const unsigned char* rp  , float (&e)[64]) {
#if PEER_FP6
    const v4u c0 = *(const GAS v4u*)(rp), c1 = *(const GAS v4u*)(rp + 1024), c2 = *(const GAS v4u*)(rp + 2048);
    const v6u pa = (v6u){c0.x, c0.y, c0.z, c0.w, c1.x, c1.y}, pb = (v6u){c1.z, c1.w, c2.x, c2.y, c2.z, c2.w};
    const f32x32v ra = __builtin_amdgcn_cvt_scalef32_pk32_f32_fp6(pa, 1.0f), rb = __builtin_amdgcn_cvt_scalef32_pk32_f32_fp6(pb, 1.0f);
#pragma unroll
    for (int k = 0; k < 32; ++k) { e[k] = ra[k]; e[32 + k] = rb[k]; }
#else
#pragma unroll
    for (int i = 0; i < 4; ++i) { const v4u w = *(const GAS v4u*)(rp + i * 1024);
#pragma unroll
        for (int j = 0; j < 4; ++j) { const f32x2 lo = __builtin_amdgcn_cvt_pk_f32_fp8(w[j], false), hi = __builtin_amdgcn_cvt_pk_f32_fp8(w[j], true);
            e[i * 16 + j * 4 + 0] = lo.x; e[i * 16 + j * 4 + 1] = lo.y; e[i * 16 + j * 4 + 2] = hi.x; e[i * 16 + j * 4 + 3] = hi.y; } }
#endif
}
__device__ __forceinline__ void p0_quant_row(const float* src, unsigned char* dst, float* sc, int lane, bool fp4 = false) {
    f32x4 v[16]; float am = 0.f;
#pragma unroll
    for (int i = 0; i < 4; ++i)
#pragma unroll
        for (int j = 0; j < 4; ++j) { v[i * 4 + j] = *(const GAS f32x4*)(src + (i * 4 + j) * 256 + lane * 4);
            am = fmaxf(am, fmaxf(fmaxf(fabsf(v[i * 4 + j].x), fabsf(v[i * 4 + j].y)), fmaxf(fabsf(v[i * 4 + j].z), fabsf(v[i * 4 + j].w)))); }
    am = wave_max(am);
    quant_pack_store(v, am, dst, sc, lane, fp4);
}

__device__ __forceinline__ void quant_rows(const Args& a, int first, int stride, int lane) {
    unsigned char* ws = a.ws;
    f32x4 cur[16], nxt[16];
    auto srcp = [&](int r) { return r < NEXP ? a.in[19] + (size_t)r * D : a.in[20] + (size_t)(r - NEXP) * D; };
    if (first < 2 * NEXP) { const float* p = srcp(first);
#pragma unroll
        for (int k = 0; k < 16; ++k) cur[k] = *(const GAS f32x4*)(p + k * 256 + lane * 4); }
    for (int r = first; r < 2 * NEXP; r += stride) {
        const int rn = r + stride;
        if (rn < 2 * NEXP) { const float* p = srcp(rn);
#pragma unroll
            for (int k = 0; k < 16; ++k) nxt[k] = *(const GAS f32x4*)(p + k * 256 + lane * 4); }
        float am = 0.f;
#pragma unroll
        for (int k = 0; k < 16; ++k) am = fmaxf(am, fmaxf(fmaxf(fabsf(cur[k].x), fabsf(cur[k].y)), fmaxf(fabsf(cur[k].z), fabsf(cur[k].w))));
        am = wave_max(am);
        if (r < NEXP) quant_pack_store(cur, am, ws + WS_DQ + (size_t)r * ROWB_DN, (float*)(ws + WS_DSCALE) + r, lane, PEER_DN_FP4 != 0);
        else quant_pack_store(cur, am, ws + WS_UQ + (size_t)(r - NEXP) * ROWB_UP, (float*)(ws + WS_USCALE) + (r - NEXP), lane, true);
#pragma unroll
        for (int k = 0; k < 16; ++k) cur[k] = nxt[k];
    }
}

#ifndef QUANT_IN_SCAN
#define QUANT_IN_SCAN 1
#endif
__device__ __forceinline__ void phase0(const Args& a, LAS unsigned char* lds, int gw, int NGW, int wave, int lane) {
    unsigned char* ws = a.ws;
    LAS float* scr = (LAS float*)(lds + RING_OFF + wave * 16384);
    constexpr int I_IN = (D / 64) * (IN_TOTAL / 32), I_OUT = (D / 64) * (D / 32), I_Q = (D / 64) * (2048 / 32);
    for (int it = gw; it < I_IN + I_OUT + I_Q; it += NGW) {
        int r = it;
        if (r < I_IN) { p0_transpose_item<true>(a.in[2], D, IN_TOTAL, (bf16*)(ws + WS_WINT), scr, r, lane); continue; } r -= I_IN;
        if (r < I_OUT) { p0_transpose_item<false>(a.in[15], D, D, (bf16*)(ws + WS_WOUTT), scr, r, lane); continue; } r -= I_OUT;
        p0_transpose_item<false>(a.in[17], D, 2048, (bf16*)(ws + WS_WQT), scr, r, lane);
    }
    const int gt = gw * 64 + lane, NGT = NGW * 64;
    { GAS v4u* p = (GAS v4u*)(ws + WS_WINT + (size_t)IN_TOTAL * D * 2);
      for (int i = gt; i < (NWIN - IN_TOTAL) * D * 2 / 16; i += NGT) p[i] = (v4u){0u, 0u, 0u, 0u}; }
    { const float* sk = a.in[18]; bf16* SKB = (bf16*)(ws + WS_SKB);
      for (int i = gt; i < PH * 2 * NKEYS * 128 / 8; i += NGT) { const f32x4 v0 = *(const GAS f32x4*)(sk + (size_t)i * 8), v1 = *(const GAS f32x4*)(sk + (size_t)i * 8 + 4);
          v4u o; o.x = pk2(v0.x, v0.y); o.y = pk2(v0.z, v0.w); o.z = pk2(v1.x, v1.y); o.w = pk2(v1.z, v1.w); *(GAS v4u*)(SKB + (size_t)i * 8) = o; } }
    { float* p = (float*)(ws + WS_SSQ); for (int i = gt; i < M; i += NGT) p[i] = 0.f; }
    { bf16* WL = (bf16*)(ws + WS_WLORA); const float* w2 = a.in[5]; const float* a2 = a.in[7]; const float* g2 = a.in[8];
      for (int it = gw; it < (KLORA / 64) * (NLORA / 32); it += NGW) {
          const int kb = it / (NLORA / 32), nb = it % (NLORA / 32), k0 = 64 * kb, n0 = 32 * nb, kind = n0 >> 11, cb = (n0 & 2047) + (lane & 31);
          const float* srcw = kind == 0 ? w2 : (kind == 1 ? a2 : g2); const int klo = kind == 0 ? 0 : (kind == 1 ? 96 : 192), khi = kind == 0 ? 96 : (kind == 1 ? 192 : 448);
#pragma unroll 8
          for (int i = 0; i < 32; ++i) { const int kk = 2 * i + (lane >> 5), k = k0 + kk; scr[kk * 33 + (lane & 31)] = (k >= klo && k < khi) ? srcw[(size_t)(k - klo) * 2048 + cb] : 0.f; }
          LDS_WAIT(); asm volatile("" ::: "memory");
          const int c = lane & 7;
#pragma unroll
          for (int j = 0; j < 4; ++j) { const int n = (lane >> 3) + 8 * j; const LAS float* s = scr + (8 * c) * 33 + n;
              v4u o; o.x = pk2(s[0 * 33], s[1 * 33]); o.y = pk2(s[2 * 33], s[3 * 33]); o.z = pk2(s[4 * 33], s[5 * 33]); o.w = pk2(s[6 * 33], s[7 * 33]);
              *(GAS v4u*)(WL + (size_t)(n0 + n) * KLORA + k0 + 8 * c) = o; }
          LDS_WAIT(); asm volatile("" ::: "memory");
      } }
    { const float* x = a.in[0]; const float* nw = a.in[1]; bf16* XN = (bf16*)(ws + WS_XN);
      for (int m = gw; m < M; m += NGW) {
          f32x4 v[16]; float s = 0.f;
#pragma unroll
          for (int c = 0; c < 8; ++c)
#pragma unroll
              for (int j = 0; j < 2; ++j) { const f32x4 t = *(const GAS f32x4*)(x + (size_t)m * D + c * 512 + lane * 8 + j * 4); v[c * 2 + j] = t; s += (t.x * t.x + t.y * t.y) + (t.z * t.z + t.w * t.w); }
          const float rs = 1.0f / sqrtf(wave_sum(s) * (1.0f / D) + 1e-6f);
#pragma unroll
          for (int c = 0; c < 8; ++c) { const f32x4 w0 = *(const GAS f32x4*)(nw + c * 512 + lane * 8), w1 = *(const GAS f32x4*)(nw + c * 512 + lane * 8 + 4);
              const f32x4 p = v[c * 2] * rs * w0, q = v[c * 2 + 1] * rs * w1;
              v4u o; o.x = pk2(p.x, p.y); o.y = pk2(p.z, p.w); o.z = pk2(q.x, q.y); o.w = pk2(q.z, q.w);
              *(GAS v4u*)(XN + (size_t)m * D + c * 512 + lane * 8) = o; }
      } }
    if (!QUANT_IN_SCAN) { const float* ed = a.in[19]; const float* eu = a.in[20];
      for (int r = gw; r < 2 * NEXP; r += NGW) {
          if (r < NEXP) p0_quant_row(ed + (size_t)r * D, ws + WS_DQ + (size_t)r * ROWB_DN, (float*)(ws + WS_DSCALE) + r, lane, PEER_DN_FP4 != 0);
          else { const int e = r - NEXP; p0_quant_row(eu + (size_t)e * D, ws + WS_UQ + (size_t)e * ROWB_UP, (float*)(ws + WS_USCALE) + e, lane, true); } } }
}

__device__ __forceinline__ void unpack8(const v4u w, float (&f)[8]) {
    f[0] = bflo(w.x); f[1] = bfhi(w.x); f[2] = bflo(w.y); f[3] = bfhi(w.y); f[4] = bflo(w.z); f[5] = bfhi(w.z); f[6] = bflo(w.w); f[7] = bfhi(w.w);
}
__device__ __forceinline__ v4u pack8(const float (&f)[8]) { v4u o; o.x = pk2(f[0], f[1]); o.y = pk2(f[2], f[3]); o.z = pk2(f[4], f[5]); o.w = pk2(f[6], f[7]); return o; }

__device__ __forceinline__ void phase2(const Args& a, int gt, int NGT) {
    unsigned char* ws = a.ws;
    const bf16* P = (const bf16*)(ws + WS_PROJ); const float* mu = a.in[3]; const float* cw = a.in[14];
    bf16* LIN = (bf16*)(ws + WS_LIN); bf16* MIX = (bf16*)(ws + WS_MIXED);
    const v4u z4 = (v4u){0u, 0u, 0u, 0u};
    const float* SL = (const float*)(ws + WS_SLAB);
    for (int it = gt; it < M * 64; it += NGT) {
        const int m = it >> 6, j0 = (it & 63) * 8, t = m & (SEQ - 1);
        v4u o = z4;
        if (j0 < NLIN) {
            f32x4 p0 = (f32x4){0.f, 0.f, 0.f, 0.f}, p1 = p0, q0 = p0, q1 = p0;
#pragma unroll
            for (int ks = 0; ks < KSPLIT; ++ks) { const float* sp = SL + ((size_t)ks * M + m) * SLABW + j0;
                p0 += *(const GAS f32x4*)(sp); p1 += *(const GAS f32x4*)(sp + 4);
                if (t > 0) { q0 += *(const GAS f32x4*)(sp - SLABW); q1 += *(const GAS f32x4*)(sp - SLABW + 4); } }
            const f32x4 m0 = *(const GAS f32x4*)(mu + SRC_WL + j0), m1 = *(const GAS f32x4*)(mu + SRC_WL + j0 + 4);
            float r[8];
#pragma unroll
            for (int j = 0; j < 8; ++j) { const float p = j < 4 ? p0[j] : p1[j - 4], q = j < 4 ? q0[j] : q1[j - 4], mm = j < 4 ? m0[j] : m1[j - 4]; const float ps = p + (q - p) * mm;
                r[j] = j0 < 96 ? tanhf(ps) : (j0 < 192 ? ps : sigmoidf_(ps)); }
            o = pack8(r);
        }
        *(GAS v4u*)(LIN + (size_t)m * KLORA + j0) = o;
    }
    for (int it = gt; it < M * 256; it += NGT) {
        const int m = it >> 8, c0 = (it & 255) * 8, t = m & (SEQ - 1);
        const bf16* row = P + (size_t)m * NPROJ;
        float bg[8], c_[8], h_[8], z0[8], z1[8], z2[8], y[8];
        unpack8(*(const GAS v4u*)(row + COL_CB + c0), bg); unpack8(*(const GAS v4u*)(row + COL_CC + c0), c_); unpack8(*(const GAS v4u*)(row + COL_CH + c0), h_);
#pragma unroll
        for (int j = 0; j < 8; ++j) z0[j] = c_[j] * h_[j];
        if (t >= 1) { unpack8(*(const GAS v4u*)(row - NPROJ + COL_CC + c0), c_); unpack8(*(const GAS v4u*)(row - NPROJ + COL_CH + c0), h_);
#pragma unroll
            for (int j = 0; j < 8; ++j) z1[j] = c_[j] * h_[j]; }
        else {
#pragma unroll
            for (int j = 0; j < 8; ++j) z1[j] = 0.f; }
        if (t >= 2) { unpack8(*(const GAS v4u*)(row - 2 * NPROJ + COL_CC + c0), c_); unpack8(*(const GAS v4u*)(row - 2 * NPROJ + COL_CH + c0), h_);
#pragma unroll
            for (int j = 0; j < 8; ++j) z2[j] = c_[j] * h_[j]; }
        else {
#pragma unroll
            for (int j = 0; j < 8; ++j) z2[j] = 0.f; }
        const float* cwp = cw + c0 * 3;
#pragma unroll
        for (int j = 0; j < 8; ++j) y[j] = bg[j] * (cwp[j * 3 + 0] * z2[j] + cwp[j * 3 + 1] * z1[j] + cwp[j * 3 + 2] * z0[j]);
        *(GAS v4u*)(MIX + (size_t)m * D + RW + c0) = pack8(y);
    }
}

__device__ __forceinline__ void phase4(const Args& a, int gw, int NGW, int lane) {
    unsigned char* ws = a.ws;
    const bf16* P = (const bf16*)(ws + WS_PROJ); const float* mu = a.in[3]; const bf16* AA = (const bf16*)(ws + WS_AA);
    const float* k_k = a.in[9]; const float* k_a = a.in[10]; const float* r_k = a.in[11];
    bf16* R = (bf16*)(ws + WS_R); bf16* K = (bf16*)(ws + WS_K); bf16* KK = (bf16*)(ws + WS_KK); bf16* BB = (bf16*)(ws + WS_BB); bf16* V = (bf16*)(ws + WS_V);
    float* BON = (float*)(ws + WS_BONUS);
    const v4u z4 = (v4u){0u, 0u, 0u, 0u};
    for (int it = gw; it < M * 4; it += NGW) {
        const int m = it >> 2, ch = (it & 3) * 512 + lane * 8, t = m & (SEQ - 1);
        const bf16* row = P + (size_t)m * NPROJ;
        float r[8], k[8], v[8], q[8], av[8];
        auto lerp8 = [&](int col, float (&o)[8]) {
            unpack8(*(const GAS v4u*)(row + col + ch), o); unpack8(t > 0 ? *(const GAS v4u*)(row - NPROJ + col + ch) : z4, q);
            const f32x4 m0 = *(const GAS f32x4*)(mu + col + ch), m1 = *(const GAS f32x4*)(mu + col + ch + 4);
#pragma unroll
            for (int j = 0; j < 8; ++j) o[j] = o[j] + (q[j] - o[j]) * (j < 4 ? m0[j] : m1[j - 4]);
        };
        lerp8(COL_R, r); lerp8(COL_K, k); lerp8(COL_V, v);
        unpack8(*(const GAS v4u*)(AA + (size_t)m * RW + ch), av);
        float kk[8], kp[8], bb[8]; float ss = 0.f, bn = 0.f, kr = 0.f, brs = 0.f;
        const f32x4 kk0 = *(const GAS f32x4*)(k_k + ch), kk1 = *(const GAS f32x4*)(k_k + ch + 4), ka0 = *(const GAS f32x4*)(k_a + ch), ka1 = *(const GAS f32x4*)(k_a + ch + 4);
        const f32x4 rk0 = *(const GAS f32x4*)(r_k + ch), rk1 = *(const GAS f32x4*)(r_k + ch + 4);
#pragma unroll
        for (int j = 0; j < 8; ++j) { kk[j] = k[j] * (j < 4 ? kk0[j] : kk1[j - 4]); ss += kk[j] * kk[j];
            kp[j] = k[j] * (1.0f + (av[j] - 1.0f) * (j < 4 ? ka0[j] : ka1[j - 4])); bn += r[j] * kp[j] * (j < 4 ? rk0[j] : rk1[j - 4]); kr += r[j] * kp[j]; }
        ss += __shfl_xor(ss, 1); ss += __shfl_xor(ss, 2); ss += __shfl_xor(ss, 4);
        bn += __shfl_xor(bn, 1); bn += __shfl_xor(bn, 2); bn += __shfl_xor(bn, 4);
        const float inv = 1.0f / sqrtf(fmaxf(ss, 1e-24f));
#pragma unroll
        for (int j = 0; j < 8; ++j) { kk[j] *= inv; bb[j] = kk[j] * av[j]; brs += bb[j] * r[j]; }
        brs += __shfl_xor(brs, 1); brs += __shfl_xor(brs, 2); brs += __shfl_xor(brs, 4);
        kr += __shfl_xor(kr, 1); kr += __shfl_xor(kr, 2); kr += __shfl_xor(kr, 4);
        const size_t o = (size_t)m * RW + ch;
        *(GAS v4u*)(R + o) = pack8(r); *(GAS v4u*)(K + o) = pack8(kp); *(GAS v4u*)(KK + o) = pack8(kk); *(GAS v4u*)(BB + o) = pack8(bb); *(GAS v4u*)(V + o) = pack8(v);
        if ((lane & 7) == 0) { BON[(size_t)m * NH + (ch >> 6)] = bn; ((float*)(ws + WS_BR))[(size_t)m * NH + (ch >> 6)] = brs; ((float*)(ws + WS_KR))[(size_t)m * NH + (ch >> 6)] = kr; }
    }
}

constexpr int TC = 32;
constexpr int SC_A = 0, SC_WR = TC * 256, SC_W = 2 * TC * 256, SC_B = 3 * TC * 256, SC_K = 4 * TC * 256, SC_V = 5 * TC * 256, SC_S = SC_V + TC * 64, SC_BYTES = SC_S + TC * 8;
__device__ __forceinline__ float dpp_f(float v, const int ctrl_sel) {
    const int x = __builtin_bit_cast(int, v); int r;
    if (ctrl_sel == 0) r = __builtin_amdgcn_update_dpp(0, x, 0xB1, 0xF, 0xF, true);
    else if (ctrl_sel == 1) r = __builtin_amdgcn_update_dpp(0, x, 0x4E, 0xF, 0xF, true);
    else if (ctrl_sel == 2) r = __builtin_amdgcn_update_dpp(0, x, 0x141, 0xF, 0xF, true);
    else r = __builtin_amdgcn_update_dpp(0, x, 0x140, 0xF, 0xF, true);
    return __builtin_bit_cast(float, r);
}
__device__ __forceinline__ void phase5(const Args& a, LAS unsigned char* lds, int tid) {
    unsigned char* ws = a.ws;
    const float* WD = (const float*)(ws + WS_WD);
    const bf16* R = (const bf16*)(ws + WS_R); const bf16* K = (const bf16*)(ws + WS_K); const bf16* KK = (const bf16*)(ws + WS_KK); const bf16* BB = (const bf16*)(ws + WS_BB); const bf16* V = (const bf16*)(ws + WS_V);
    const float* BRs = (const float*)(ws + WS_BR); const float* KRs = (const float*)(ws + WS_KR);
    float* Y = (float*)(ws + WS_Y);
    constexpr int NCH = SEQ / TC;
    const int qlane = tid & 63, NLW = gridDim.x * 4; int qnext = blockIdx.x * 4 + ((tid >> 6) & 3), qrow = 2 * NEXP;
    for (int item = blockIdx.x; item < 256; item += gridDim.x) {
        const int bh = item >> 2, rg = item & 3, b = bh >> 5, h = bh & 31;
        const size_t base = (size_t)b * SEQ * RW + h * 64;
        __syncthreads();
        if (tid >= 256) {
            const int lt = tid - 256, st = lt >> 3, c8 = (lt & 7) * 8;
            f32x4 w0, w1; v4u xkk, xbb, xk, xr; unsigned xv; float sbr = 0.f, skr = 0.f;
            auto gload = [&](int c) {
                const size_t o = base + (size_t)(c * TC + st) * RW + c8;
                w0 = *(const GAS f32x4*)(WD + o); w1 = *(const GAS f32x4*)(WD + o + 4);
                xkk = *(const GAS v4u*)(KK + o); xbb = *(const GAS v4u*)(BB + o); xk = *(const GAS v4u*)(K + o); xr = *(const GAS v4u*)(R + o);
                xv = *(const GAS unsigned*)(V + base + (size_t)(c * TC + st) * RW + rg * 16 + (lt & 7) * 2);
                if (lt < TC) { const size_t mm = (size_t)b * SEQ + c * TC + lt; sbr = BRs[mm * NH + h]; skr = KRs[mm * NH + h]; }
            };
            f32x4 qv[16];
            auto quant_load = [&](int r) {
                const float* srcp = (r < NEXP ? a.in[19] + (size_t)r * D : a.in[20] + (size_t)(r - NEXP) * D);
#pragma unroll
                for (int i2 = 0; i2 < 4; ++i2)
#pragma unroll
                    for (int j = 0; j < 4; ++j) qv[i2 * 4 + j] = *(const GAS f32x4*)(srcp + (i2 * 4 + j) * 256 + qlane * 4);
            };
            auto quant_finish = [&](int r) {
                float am = 0.f;
#pragma unroll
                for (int k = 0; k < 16; ++k) am = fmaxf(am, fmaxf(fmaxf(fabsf(qv[k].x), fabsf(qv[k].y)), fmaxf(fabsf(qv[k].z), fabsf(qv[k].w))));
                am = wave_max(am);
                unsigned char* dst = (r < NEXP ? ws + WS_DQ + (size_t)r * ROWB_DN : ws + WS_UQ + (size_t)(r - NEXP) * ROWB_UP);
                float* scp = (r < NEXP ? (float*)(ws + WS_DSCALE) + r : (float*)(ws + WS_USCALE) + (r - NEXP));
                quant_pack_store(qv, am, dst, scp, qlane, r >= NEXP || PEER_DN_FP4 != 0);
            };
            auto lstore = [&](int buf) {
                LAS unsigned char* L = lds + buf * SC_BYTES; const int o = st * 256 + c8 * 4;
                float fk[8], fb[8], fkk[8], fr[8]; unpack8(xkk, fkk); unpack8(xbb, fb); unpack8(xk, fk); unpack8(xr, fr);
                *(LAS f32x4*)(L + SC_A + o) = (f32x4){-fkk[0], -fkk[1], -fkk[2], -fkk[3]}; *(LAS f32x4*)(L + SC_A + o + 16) = (f32x4){-fkk[4], -fkk[5], -fkk[6], -fkk[7]};
                *(LAS f32x4*)(L + SC_WR + o) = (f32x4){w0.x * fr[0], w0.y * fr[1], w0.z * fr[2], w0.w * fr[3]}; *(LAS f32x4*)(L + SC_WR + o + 16) = (f32x4){w1.x * fr[4], w1.y * fr[5], w1.z * fr[6], w1.w * fr[7]};
                *(LAS f32x4*)(L + SC_W + o) = w0; *(LAS f32x4*)(L + SC_W + o + 16) = w1;
                *(LAS f32x4*)(L + SC_B + o) = (f32x4){fb[0], fb[1], fb[2], fb[3]}; *(LAS f32x4*)(L + SC_B + o + 16) = (f32x4){fb[4], fb[5], fb[6], fb[7]};
                *(LAS f32x4*)(L + SC_K + o) = (f32x4){fk[0], fk[1], fk[2], fk[3]}; *(LAS f32x4*)(L + SC_K + o + 16) = (f32x4){fk[4], fk[5], fk[6], fk[7]};
                *(LAS f32x2*)(L + SC_V + st * 64 + (lt & 7) * 8) = (f32x2){bflo(xv), bfhi(xv)};
                if (lt < TC) *(LAS f32x2*)(L + SC_S + lt * 8) = (f32x2){sbr, skr};
            };
            gload(0); lstore(0);
            gload(1);
            __syncthreads();
            for (int c = 0; c < NCH; ++c) {
                if (c + 1 < NCH) lstore((c + 1) & 1);
                if (c + 2 < NCH) gload(c + 2);
                if (QUANT_IN_SCAN) {
                    const int ph = c & 3;
                    if (ph == 0) { qrow = qnext; qnext += NLW; if (qrow < 2 * NEXP) quant_load(qrow); }
                    else if (ph == 2) { if (qrow < 2 * NEXP) quant_finish(qrow); }
                }
                __syncthreads();
            }
        } else {
            const int i = tid >> 4, q = tid & 15;
            f32x2 s01 = (f32x2){0.f, 0.f}, s23 = (f32x2){0.f, 0.f};
            float* yp = Y + base + rg * 16 + i;
            float ykeep = 0.f;
            __builtin_amdgcn_s_setprio(3);
            __syncthreads();
            for (int c = 0; c < NCH; ++c) {
                const LAS unsigned char* L = lds + (c & 1) * SC_BYTES;
                f32x4 a4 = *(const LAS f32x4*)(L + SC_A + q * 16), wr4 = *(const LAS f32x4*)(L + SC_WR + q * 16), w4 = *(const LAS f32x4*)(L + SC_W + q * 16), b4 = *(const LAS f32x4*)(L + SC_B + q * 16), k4 = *(const LAS f32x4*)(L + SC_K + q * 16);
                float vi = *(const LAS float*)(L + SC_V + i * 4); f32x2 sc = *(const LAS f32x2*)(L + SC_S);
#pragma unroll
                for (int tt = 0; tt < TC; ++tt) {
                    const f32x4 ca = a4, cwr = wr4, cw = w4, cb = b4, ck = k4; const float cvi = vi; const f32x2 csc = sc;
                    if (tt + 1 < TC) {
                        a4 = *(const LAS f32x4*)(L + SC_A + (tt + 1) * 256 + q * 16); wr4 = *(const LAS f32x4*)(L + SC_WR + (tt + 1) * 256 + q * 16); w4 = *(const LAS f32x4*)(L + SC_W + (tt + 1) * 256 + q * 16);
                        b4 = *(const LAS f32x4*)(L + SC_B + (tt + 1) * 256 + q * 16); k4 = *(const LAS f32x4*)(L + SC_K + (tt + 1) * 256 + q * 16);
                        vi = *(const LAS float*)(L + SC_V + (tt + 1) * 64 + i * 4); sc = *(const LAS f32x2*)(L + SC_S + (tt + 1) * 8);
                    }
                    f32x2 da = s01 * (f32x2){ca.x, ca.y}; da = s23 * (f32x2){ca.z, ca.w} + da;
                    f32x2 dr = s01 * (f32x2){cwr.x, cwr.y}; dr = s23 * (f32x2){cwr.z, cwr.w} + dr;
                    float sa = da.x + da.y, yy = dr.x + dr.y;
                    const f32x2 vv = (f32x2){cvi, cvi};
                    const f32x2 t01 = s01 * (f32x2){cw.x, cw.y} + vv * (f32x2){ck.x, ck.y}, t23 = s23 * (f32x2){cw.z, cw.w} + vv * (f32x2){ck.z, ck.w};
                    sa += dpp_f(sa, 0); yy += dpp_f(yy, 0);
                    sa += dpp_f(sa, 1); yy += dpp_f(yy, 1);
                    sa += dpp_f(sa, 2); yy += dpp_f(yy, 2);
                    sa += dpp_f(sa, 3); yy += dpp_f(yy, 3);
                    const f32x2 ss = (f32x2){sa, sa};
                    s01 = ss * (f32x2){cb.x, cb.y} + t01; s23 = ss * (f32x2){cb.z, cb.w} + t23;
                    yy += sa * csc.x + cvi * csc.y;
                    ykeep = ((tt & 15) == q) ? yy : ykeep;
                    if ((tt & 15) == 15) yp[(size_t)(c * TC + (tt & 16) + q) * RW] = ykeep;
                }
                __syncthreads();
            }
            __builtin_amdgcn_s_setprio(0);
        }
    }
    if (QUANT_IN_SCAN && tid >= 256) {
        for (; qnext < 2 * NEXP; qnext += NLW) {
            const int r = qnext;
            if (r < NEXP) p0_quant_row(a.in[19] + (size_t)r * D, ws + WS_DQ + (size_t)r * ROWB_DN, (float*)(ws + WS_DSCALE) + r, qlane, PEER_DN_FP4 != 0);
            else p0_quant_row(a.in[20] + (size_t)(r - NEXP) * D, ws + WS_UQ + (size_t)(r - NEXP) * ROWB_UP, (float*)(ws + WS_USCALE) + (r - NEXP), qlane, true);
        }
    }
}

constexpr int CH = 32, NCHK = SEQ / CH;
constexpr int SUM_GT = 0, SUM_QT = 8192, SUM_HT = 12288, SUM_YL = 20480, SUM_BYTES = 24576;
constexpr int CW_BYTES = 18432;
constexpr int CA_OFF = 0, CB_OFF = 8704, CC_OFF = 13312;
constexpr int TMS = 144, CMS = 80;
typedef float f32x16c __attribute__((ext_vector_type(16)));
typedef short bf16x8c __attribute__((ext_vector_type(8)));
__device__ __forceinline__ bf16x8c cvt8(const f32x16c& x, const int base) {
    v4u w; w.x = pk2(x[base + 0], x[base + 1]); w.y = pk2(x[base + 2], x[base + 3]); w.z = pk2(x[base + 4], x[base + 5]); w.w = pk2(x[base + 6], x[base + 7]);
    return __builtin_bit_cast(bf16x8c, w);
}
__device__ __forceinline__ bf16x8c lds_nat(const LAS unsigned char* img, int row, int pitch, int ks, int hf) {
    return __builtin_bit_cast(bf16x8c, *(const LAS v4u*)(img + row * pitch + (16 * ks + 8 * hf) * 2));
}
__device__ __forceinline__ bf16x8c lds_sig(const LAS unsigned char* img, int row, int pitch, int ks, int hf) {
    const v2u lo = *(const LAS v2u*)(img + row * pitch + (16 * ks + 4 * hf) * 2), hi = *(const LAS v2u*)(img + row * pitch + (16 * ks + 8 + 4 * hf) * 2);
    return __builtin_bit_cast(bf16x8c, (v4u){lo.x, lo.y, hi.x, hi.y});
}
#define MFMA32(a, b, c) __builtin_amdgcn_mfma_f32_32x32x16_bf16((a), (b), (c), 0, 0, 0)

__device__ __forceinline__ void diag_add(f32x16c& x, int tl, int hf, float v) {
#pragma unroll
    for (int i = 0; i < 16; ++i) { const int r = (i & 3) + 8 * (i >> 2) + 4 * hf; x[i] += (r == tl) ? v : 0.f; }
}
__device__ __forceinline__ f32x16c xty(const f32x16c& X, const f32x16c& Y, f32x16c c) { c = MFMA32(cvt8(X, 0), cvt8(Y, 0), c); c = MFMA32(cvt8(X, 8), cvt8(Y, 8), c); return c; }
__device__ __forceinline__ void phase5a(const Args& a, LAS unsigned char* lds, int gw, int NGW, int wave, int lane_in) {
    unsigned char* ws = a.ws;
    const float* LWG = (const float*)(ws + WS_WD);
    const bf16* PRJ = (const bf16*)(ws + WS_PROJ); const bf16* AAg = (const bf16*)(ws + WS_AA); bf16* Vw = (bf16*)(ws + WS_V); float* BONw = (float*)(ws + WS_BONUS);
    const float* mu = a.in[3]; const float* k_k = a.in[9]; const float* k_a = a.in[10]; const float* r_k = a.in[11];
    LAS unsigned char* LA = lds + wave * CW_BYTES + CA_OFF; LAS unsigned char* LB = lds + wave * CW_BYTES + CB_OFF; LAS unsigned char* LC = lds + wave * CW_BYTES + CC_OFF;
    f32x16c zero16;
#pragma unroll
    for (int i = 0; i < 16; ++i) zero16[i] = 0.f;
    for (int item = gw; item < 64 * NCHK; item += NGW) {
        int lane_l = lane_in; asm volatile("" : "+v"(lane_l));
        const int lane = lane_l, tl = lane & 31, hf = lane >> 5;
        const int bh = item / NCHK, c = item % NCHK, b = bh >> 5, h = bh & 31;
        const float* lwu = LWG + ((size_t)b * SEQ + c * CH) * RW + h * 64;
        const int tpos = c * CH + tl;
        const bf16* pu = PRJ + ((size_t)b * SEQ + c * CH) * NPROJ + h * 64;
        const int lo_p = tl * NPROJ + 32 * hf, lo_q = (tpos > 0) ? lo_p - NPROJ : lo_p;
        const float pmask = (tpos > 0) ? 1.0f : 0.0f;
        const int lo_c = tl * RW + 32 * hf;
        const size_t ub = ((size_t)b * SEQ + c * CH) * RW + h * 64;
        const bf16* aau = AAg + ub; bf16* vwu = Vw + ub;
        const float* muu = mu + h * 64; const float* kku = k_k + h * 64; const float* kau = k_a + h * 64; const float* rku = r_k + h * 64; const int lo_h = 32 * hf;
        f32x4 lwr[8]; v4u rcw[4], rpw[4], vcw[4], vpw[4], kcw[4], kpw[4], aaw[4];
#pragma unroll
        for (int q = 0; q < 8; ++q) lwr[q] = *(const GAS f32x4*)(lwu + lo_c + 4 * q);
#pragma unroll
        for (int q = 0; q < 4; ++q) { rcw[q] = *(const GAS v4u*)(pu + COL_R + lo_p + 8 * q); rpw[q] = *(const GAS v4u*)(pu + COL_R + lo_q + 8 * q);
            vcw[q] = *(const GAS v4u*)(pu + COL_V + lo_p + 8 * q); vpw[q] = *(const GAS v4u*)(pu + COL_V + lo_q + 8 * q);
        }
        asm volatile("" ::: "memory");
        {
#pragma unroll
          for (int q = 0; q < 8; ++q) *(LAS f32x4*)(LA + (tl * 68 + 32 * hf + 4 * q) * 4) = lwr[q];
          LDS_WAIT();
          float accl = 0.f;
#pragma unroll
          for (int t = 0; t < CH; ++t) { accl += *(const LAS float*)(LA + (t * 68 + lane) * 4); *(LAS float*)(LA + (t * 68 + lane) * 4) = accl; }
          LDS_WAIT();
        }
#pragma unroll
        for (int q = 0; q < 4; ++q) { kcw[q] = *(const GAS v4u*)(pu + COL_K + lo_p + 8 * q); kpw[q] = *(const GAS v4u*)(pu + COL_K + lo_q + 8 * q); aaw[q] = *(const GAS v4u*)(aau + lo_c + 8 * q); }
        asm volatile("" ::: "memory");
        const float pc0 = __expf(*(const LAS float*)(LA + (31 * 68 + tl) * 4)), pc1 = __expf(*(const LAS float*)(LA + (31 * 68 + 32 + tl) * 4));
        v4u kh_[4], rt_[4], at_[4];
        bf16x8c fb[4], fk[4], fr[4], fa[4];
#define TM_WRITE(dst, src) do { _Pragma("unroll") for (int q = 0; q < 4; ++q) *(LAS v4u*)((dst) + tl * TMS + (32 * hf + 8 * q) * 2) = src[q]; LDS_WAIT(); } while (0)
#define TM_FRAGS(dst) do { _Pragma("unroll") for (int ks = 0; ks < 4; ++ks) dst[ks] = lds_nat(LB, tl, TMS, ks, hf); LDS_WAIT(); } while (0)
#define CM_WRITE(dst, src) do { _Pragma("unroll") for (int q = 0; q < 4; ++q) { const v4u _w = src[q]; _Pragma("unroll") for (int e = 0; e < 4; ++e) { \
            *(LAS unsigned short*)((dst) + (32 * hf + 8 * q + 2 * e) * CMS + tl * 2) = (unsigned short)(_w[e] & 0xffffu); *(LAS unsigned short*)((dst) + (32 * hf + 8 * q + 2 * e + 1) * CMS + tl * 2) = (unsigned short)(_w[e] >> 16); } } LDS_WAIT(); } while (0)
#define LROW(q) const f32x4 L0 = *(const LAS f32x4*)(LA + (tl * 68 + 32 * hf + 8 * (q)) * 4), L1 = *(const LAS f32x4*)(LA + (tl * 68 + 32 * hf + 8 * (q) + 4) * 4)
#define EROW(q) const f32x4 E0 = *(const LAS f32x4*)(LA + (31 * 68 + 32 * hf + 8 * (q)) * 4), E1 = *(const LAS f32x4*)(LA + (31 * 68 + 32 * hf + 8 * (q) + 4) * 4)
#define LERP8(cw, pw, col, q, out) do { float _c[8], _p[8]; unpack8(cw[q], _c); unpack8(pw[q], _p); \
            const f32x4 _m0 = *(const GAS f32x4*)(muu + (col) + lo_h + 8 * (q)), _m1 = *(const GAS f32x4*)(muu + (col) + lo_h + 8 * (q) + 4); \
            _Pragma("unroll") for (int j = 0; j < 8; ++j) out[j] = _c[j] + (_p[j] * pmask - _c[j]) * (j < 4 ? _m0[j] : _m1[j - 4]); } while (0)
        {
#pragma unroll
            for (int q = 0; q < 4; ++q) { LROW(q); float x8[8], u1[8]; LERP8(rcw, rpw, COL_R, q, x8);
#pragma unroll
                for (int j = 0; j < 8; ++j) { const float L = j < 4 ? L0[j] : L1[j - 4]; u1[j] = x8[j] * __expf(L); }
                rt_[q] = pack8(u1); }
        }
        {
#pragma unroll
            for (int q = 0; q < 4; ++q) { float x8[8]; LERP8(vcw, vpw, COL_V, q, x8); *(GAS v4u*)(vwu + lo_c + 8 * q) = pack8(x8); }
        }
        float inv_kk; v4u ks_[4];
        {
            float ss = 0.f;
#pragma unroll
            for (int q = 0; q < 4; ++q) { float x8[8]; LERP8(kcw, kpw, COL_K, q, x8); ks_[q] = pack8(x8);
                const f32x4 k0 = *(const GAS f32x4*)(kku + lo_h + 8 * q), k1 = *(const GAS f32x4*)(kku + lo_h + 8 * q + 4);
#pragma unroll
                for (int j = 0; j < 8; ++j) { const float t2 = x8[j] * (j < 4 ? k0[j] : k1[j - 4]); ss += t2 * t2; } }
            ss += __shfl_xor(ss, 32);
            inv_kk = 1.0f / sqrtf(fmaxf(ss, 1e-24f));
        }
        {
            v4u kt_[4]; float bon = 0.f;
#pragma unroll
            for (int q = 0; q < 4; ++q) { LROW(q); EROW(q); float x8[8], av[8], rt8[8]; unpack8(ks_[q], x8); unpack8(aaw[q], av); unpack8(rt_[q], rt8);
                const f32x4 a0v = *(const GAS f32x4*)(kau + lo_h + 8 * q), a1v = *(const GAS f32x4*)(kau + lo_h + 8 * q + 4), q0 = *(const GAS f32x4*)(rku + lo_h + 8 * q), q1 = *(const GAS f32x4*)(rku + lo_h + 8 * q + 4);
                float o_kt[8], o_kh[8];
#pragma unroll
                for (int j = 0; j < 8; ++j) { const float L = j < 4 ? L0[j] : L1[j - 4], Le = j < 4 ? E0[j] : E1[j - 4];
                    const float kp = x8[j] * (1.0f + (av[j] - 1.0f) * (j < 4 ? a0v[j] : a1v[j - 4])), enL = __expf(-L);
                    bon += rt8[j] * enL * (j < 4 ? q0[j] : q1[j - 4]) * kp;
                    o_kt[j] = kp * enL; o_kh[j] = kp * __expf(Le - L); }
                kt_[q] = pack8(o_kt); kh_[q] = pack8(o_kh); if (q == 1) asm volatile("" ::: "memory"); }
            bon += __shfl_xor(bon, 32);
            if (hf == 0) (BONw + ((size_t)b * SEQ + c * CH) * NH + h)[tl * NH] = bon;
            TM_WRITE(LB, kt_); TM_FRAGS(fk);
        }
        asm volatile("" ::: "memory");
        {
            v4u bt_[4], bh_[4];
#pragma unroll
            for (int q = 0; q < 4; ++q) { LROW(q); EROW(q); float x8[8], av[8]; unpack8(ks_[q], x8); unpack8(aaw[q], av);
                const f32x4 k0 = *(const GAS f32x4*)(kku + lo_h + 8 * q), k1 = *(const GAS f32x4*)(kku + lo_h + 8 * q + 4);
                const int rwp = tl > 0 ? tl - 1 : 0; const float pm2 = tl > 0 ? 1.0f : 0.0f;
                const f32x4 W0 = *(const LAS f32x4*)(LA + (rwp * 68 + 32 * hf + 8 * q) * 4) * pm2, W1 = *(const LAS f32x4*)(LA + (rwp * 68 + 32 * hf + 8 * q + 4) * 4) * pm2;
                float o_at[8], o_bt[8], o_bh[8];
#pragma unroll
                for (int j = 0; j < 8; ++j) { const float L = j < 4 ? L0[j] : L1[j - 4], Le = j < 4 ? E0[j] : E1[j - 4], lw1 = j < 4 ? W0[j] : W1[j - 4];
                    const float kk = x8[j] * (j < 4 ? k0[j] : k1[j - 4]) * inv_kk, bb = kk * av[j];
                    o_at[j] = -kk * __expf(lw1); o_bt[j] = bb * __expf(-L); o_bh[j] = bb * __expf(Le - L); }
                at_[q] = pack8(o_at); bt_[q] = pack8(o_bt); bh_[q] = pack8(o_bh); if (q == 1) asm volatile("" ::: "memory"); }
            TM_WRITE(LB, bt_); TM_FRAGS(fb); CM_WRITE(LC, bh_);
        }
        asm volatile("" ::: "memory");
        TM_WRITE(LB, rt_); TM_FRAGS(fr);
        TM_WRITE(LB, at_); TM_FRAGS(fa);
        asm volatile("" ::: "memory");
#undef LERP8
        CM_WRITE(LA, at_);
        TM_WRITE(LB, rt_);
        f32x16c P = zero16, R = zero16, KT = zero16, Mkr = zero16, Mbr = zero16;
#pragma unroll
        for (int ks = 0; ks < 4; ++ks) { P = MFMA32(fb[ks], fa[ks], P); R = MFMA32(fa[ks], fb[ks], R); KT = MFMA32(fa[ks], fk[ks], KT); Mkr = MFMA32(fk[ks], fr[ks], Mkr); Mbr = MFMA32(fb[ks], fr[ks], Mbr); }
#pragma unroll
        for (int i = 0; i < 16; ++i) { const int r = (i & 3) + 8 * (i >> 2) + 4 * hf;
            P[i] = (r < tl) ? P[i] : 0.f; Mkr[i] = (r <= tl) ? Mkr[i] : 0.f; Mbr[i] = (r <= tl) ? Mbr[i] : 0.f;
            R[i] = (tl < r) ? R[i] : 0.f; KT[i] = (tl < r) ? KT[i] : 0.f; }
        f32x16c T = P; diag_add(T, tl, hf, 1.0f);
#pragma unroll
        for (int lev = 0; lev < 4; ++lev) {
            const f32x16c Pn = (lev < 3) ? xty(R, P, zero16) : zero16;
            const f32x16c Rn = xty(P, R, zero16);
            P = Pn; R = Rn;
            f32x16c IR = R; diag_add(IR, tl, hf, 1.0f);
            T = xty(IR, T, zero16);
        }
        f32x16c Xa[2], Wt;
        { const bf16x8c t0 = cvt8(T, 0), t1 = cvt8(T, 8);
#pragma unroll
          for (int jt = 0; jt < 2; ++jt) { Xa[jt] = MFMA32(t0, lds_sig(LA, 32 * jt + tl, CMS, 0, hf), zero16); Xa[jt] = MFMA32(t1, lds_sig(LA, 32 * jt + tl, CMS, 1, hf), Xa[jt]); }
          Wt = MFMA32(t0, cvt8(KT, 0), zero16); Wt = MFMA32(t1, cvt8(KT, 8), Wt); }
        bf16x8c bs[2][2];
#pragma unroll
        for (int rt2 = 0; rt2 < 2; ++rt2)
#pragma unroll
            for (int ks = 0; ks < 2; ++ks) bs[rt2][ks] = lds_sig(LC, 32 * rt2 + tl, CMS, ks, hf);
        LDS_WAIT();
        { v4u vr[4];
#pragma unroll
          for (int q = 0; q < 4; ++q) vr[q] = *(const GAS v4u*)(vwu + lo_c + 8 * q);
          TM_WRITE(LA, kh_);
          CM_WRITE(LC, vr); }
        unsigned char* rec = ws + WS_REC + (size_t)item * SUM_BYTES;
#pragma unroll
        for (int bt2 = 0; bt2 < 2; ++bt2) { const bf16x8c x0 = cvt8(Xa[bt2], 0), x1 = cvt8(Xa[bt2], 8);
#pragma unroll
            for (int at2 = 0; at2 < 2; ++at2) { f32x16c g = MFMA32(x0, bs[at2][0], zero16); g = MFMA32(x1, bs[at2][1], g);
                if (at2 == bt2) diag_add(g, tl, hf, at2 == 0 ? pc0 : pc1);
#pragma unroll
                for (int k2 = 0; k2 < 2; ++k2) *(GAS bf16x8c*)(rec + SUM_GT + (32 * at2 + tl) * 128 + (2 * bt2 + k2) * 32 + hf * 16) = cvt8(g, 8 * k2);
            } }
        { const bf16x8c mb0 = cvt8(Mbr, 0), mb1 = cvt8(Mbr, 8);
#pragma unroll
          for (int jt = 0; jt < 2; ++jt) { f32x16c qv_;
#pragma unroll
              for (int i = 0; i < 16; ++i) { const int j = 32 * jt + (i & 3) + 8 * (i >> 2) + 4 * hf; qv_[i] = __builtin_bit_cast(float, (unsigned)(*(const LAS unsigned short*)(LB + tl * TMS + j * 2)) << 16); }
              qv_ = MFMA32(cvt8(Xa[jt], 0), mb0, qv_); qv_ = MFMA32(cvt8(Xa[jt], 8), mb1, qv_);
#pragma unroll
              for (int k2 = 0; k2 < 2; ++k2) *(GAS bf16x8c*)(rec + SUM_QT + tl * 128 + (2 * jt + k2) * 32 + hf * 16) = cvt8(qv_, 8 * k2);
          } }
        LDS_WAIT();
        bf16x8c vp[2][2];
#pragma unroll
        for (int it = 0; it < 2; ++it)
#pragma unroll
            for (int ks = 0; ks < 2; ++ks) vp[it][ks] = lds_sig(LC, 32 * it + tl, CMS, ks, hf);
        const bf16x8c w0 = cvt8(Wt, 0), w1 = cvt8(Wt, 8);
#pragma unroll
        for (int jt = 0; jt < 2; ++jt) { f32x16c zk;
#pragma unroll
            for (int i = 0; i < 16; ++i) { const int s = (i & 3) + 8 * (i >> 2) + 4 * hf; zk[i] = __builtin_bit_cast(float, (unsigned)(*(const LAS unsigned short*)(LA + s * TMS + (32 * jt + tl) * 2)) << 16); }
            zk = MFMA32(w0, bs[jt][0], zk); zk = MFMA32(w1, bs[jt][1], zk);
            const bf16x8c z0 = cvt8(zk, 0), z1 = cvt8(zk, 8);
#pragma unroll
            for (int it = 0; it < 2; ++it) { f32x16c hv = MFMA32(z0, vp[it][0], zero16); hv = MFMA32(z1, vp[it][1], hv);
                unsigned char* dst = rec + SUM_HT + ((size_t)(it * 64 + lane) * 2 + jt) * 32;
                *(GAS bf16x8c*)(dst) = cvt8(hv, 0); *(GAS bf16x8c*)(dst + 16) = cvt8(hv, 8);
            } }
        { f32x16c zy = MFMA32(w0, cvt8(Mbr, 0), Mkr); zy = MFMA32(w1, cvt8(Mbr, 8), zy);
          const bf16x8c y0 = cvt8(zy, 0), y1 = cvt8(zy, 8);
#pragma unroll
          for (int it = 0; it < 2; ++it) { f32x16c yv = MFMA32(y0, vp[it][0], zero16); yv = MFMA32(y1, vp[it][1], yv);
              unsigned char* dst = rec + SUM_YL + (size_t)(it * 64 + lane) * 32;
              *(GAS bf16x8c*)(dst) = cvt8(yv, 0); *(GAS bf16x8c*)(dst + 16) = cvt8(yv, 8);
          } }
        LDS_WAIT();
#undef TM_WRITE
#undef TM_FRAGS
#undef CM_WRITE
#undef LROW
#undef EROW
    }
}

constexpr int RING_SLOTS = 5, NLOADW = 5, RING_FLAGS = RING_SLOTS * SUM_BYTES;
__device__ __forceinline__ int ring_swz(int o) {
    return (o < SUM_HT) ? ((o & ~127) | ((((o >> 4) ^ (o >> 7)) & 7) << 4)) : o;
}
__device__ __forceinline__ void spin_until(volatile LAS unsigned* p, unsigned want) {
    unsigned sp = 0u;
    while (*p < want) { __builtin_amdgcn_s_sleep(1); if (++sp > (1u << 24)) break; }
}
__device__ __forceinline__ void phase5b(const Args& a, LAS unsigned char* lds, int bx, int G, int tid, int wave, int lane) {
    unsigned char* ws = a.ws;
    const int tl = lane & 31, hf = lane >> 5;
    volatile LAS unsigned* full = (volatile LAS unsigned*)(lds + RING_FLAGS); volatile LAS unsigned* freef = (volatile LAS unsigned*)(lds + RING_FLAGS + 32);
    if (tid < 64) ((LAS unsigned*)(lds + RING_FLAGS))[tid] = 0u;
    __syncthreads();
    const bool chain_block = (G >= 128) && (bx < 128);
    const int bh = bx >> 1, it = bx & 1, b = bh >> 5, h = bh & 31;
    const unsigned char* rec0 = ws + WS_REC + (size_t)bh * NCHK * SUM_BYTES;
    volatile LAS unsigned* freeB = (volatile LAS unsigned*)(lds + RING_FLAGS + 64); volatile LAS unsigned* sfull = (volatile LAS unsigned*)(lds + RING_FLAGS + 96); volatile LAS unsigned* sfree = (volatile LAS unsigned*)(lds + RING_FLAGS + 112);
    LAS unsigned char* sring = lds + RING_FLAGS + 256;
    constexpr int SSLOTS = 2;
    auto unp16 = [&](const bf16x8c lo, const bf16x8c hi2) { f32x16c r; const v4u l4 = __builtin_bit_cast(v4u, lo), h4 = __builtin_bit_cast(v4u, hi2);
#pragma unroll
        for (int e2 = 0; e2 < 4; ++e2) { r[2 * e2] = bflo(l4[e2]); r[2 * e2 + 1] = bfhi(l4[e2]); r[8 + 2 * e2] = bflo(h4[e2]); r[8 + 2 * e2 + 1] = bfhi(h4[e2]); }
        return r; };
    if (chain_block && wave == 0) {
        f32x16c S0, S1;
#pragma unroll
        for (int i = 0; i < 16; ++i) { S0[i] = 0.f; S1[i] = 0.f; }
        for (int c = 0; c < NCHK; ++c) {
            const int slot = c % RING_SLOTS, ss = c % SSLOTS; const LAS unsigned char* R = lds + slot * SUM_BYTES; LAS unsigned char* SR = sring + ss * 4096;
            const bf16x8c bs0 = cvt8(S0, 0), bs1 = cvt8(S0, 8), bs2 = cvt8(S1, 0), bs3 = cvt8(S1, 8);
            if (c >= SSLOTS) spin_until(sfree + ss, (unsigned)(c - SSLOTS + 1));
            asm volatile("" ::: "memory");
            *(LAS bf16x8c*)(SR + lane * 16) = bs0; *(LAS bf16x8c*)(SR + 1024 + lane * 16) = bs1; *(LAS bf16x8c*)(SR + 2048 + lane * 16) = bs2; *(LAS bf16x8c*)(SR + 3072 + lane * 16) = bs3;
            asm volatile("" ::: "memory");
            if (lane == 0) sfull[ss] = (unsigned)(c + 1);
            spin_until(full + slot, (unsigned)(c + 1));
            asm volatile("" ::: "memory");
            bf16x8c ga[2][4], hi_[2][2];
#pragma unroll
            for (int at2 = 0; at2 < 2; ++at2)
#pragma unroll
                for (int ks = 0; ks < 4; ++ks) ga[at2][ks] = *(const LAS bf16x8c*)(R + ring_swz(SUM_GT + (32 * at2 + tl) * 128 + ks * 32 + hf * 16));
#pragma unroll
            for (int jt = 0; jt < 2; ++jt) { const int o = SUM_HT + ((it * 64 + lane) * 2 + jt) * 32; hi_[jt][0] = *(const LAS bf16x8c*)(R + o); hi_[jt][1] = *(const LAS bf16x8c*)(R + o + 16); }
            LDS_WAIT();
            if (lane == 0) freef[slot] = (unsigned)(c + 1);
            f32x16c n0 = unp16(hi_[0][0], hi_[0][1]), n1 = unp16(hi_[1][0], hi_[1][1]);
            n0 = MFMA32(ga[0][0], bs0, n0); n1 = MFMA32(ga[1][0], bs0, n1);
            n0 = MFMA32(ga[0][1], bs1, n0); n1 = MFMA32(ga[1][1], bs1, n1);
            n0 = MFMA32(ga[0][2], bs2, n0); n1 = MFMA32(ga[1][2], bs2, n1);
            n0 = MFMA32(ga[0][3], bs3, n0); n1 = MFMA32(ga[1][3], bs3, n1);
            S0 = n0; S1 = n1;
        }
    } else if (chain_block && wave == 1) {
        float* Y = (float*)(ws + WS_Y);
        for (int c = 0; c < NCHK; ++c) {
            const int slot = c % RING_SLOTS, ss = c % SSLOTS; const LAS unsigned char* R = lds + slot * SUM_BYTES; const LAS unsigned char* SR = sring + ss * 4096;
            spin_until(full + slot, (unsigned)(c + 1)); spin_until(sfull + ss, (unsigned)(c + 1));
            asm volatile("" ::: "memory");
            bf16x8c qa[4], yi_[2];
#pragma unroll
            for (int ks = 0; ks < 4; ++ks) qa[ks] = *(const LAS bf16x8c*)(R + ring_swz(SUM_QT + tl * 128 + ks * 32 + hf * 16));
            { const int o = SUM_YL + (it * 64 + lane) * 32; yi_[0] = *(const LAS bf16x8c*)(R + o); yi_[1] = *(const LAS bf16x8c*)(R + o + 16); }
            const bf16x8c bs0 = *(const LAS bf16x8c*)(SR + lane * 16), bs1 = *(const LAS bf16x8c*)(SR + 1024 + lane * 16), bs2 = *(const LAS bf16x8c*)(SR + 2048 + lane * 16), bs3 = *(const LAS bf16x8c*)(SR + 3072 + lane * 16);
            LDS_WAIT();
            if (lane == 0) { freeB[slot] = (unsigned)(c + 1); sfree[ss] = (unsigned)(c + 1); }
            f32x16c yv = unp16(yi_[0], yi_[1]);
            yv = MFMA32(qa[0], bs0, yv); yv = MFMA32(qa[1], bs1, yv); yv = MFMA32(qa[2], bs2, yv); yv = MFMA32(qa[3], bs3, yv);
            float* yp = Y + ((size_t)b * SEQ + c * CH) * RW + h * 64 + 32 * it + tl;
#pragma unroll
            for (int i = 0; i < 16; ++i) { const int t = (i & 3) + 8 * (i >> 2) + 4 * hf; yp[(size_t)t * RW] = yv[i]; }
        }
    } else if (chain_block && wave >= 2 && wave < 2 + NLOADW) {
        for (int c = wave - 2; c < NCHK; c += NLOADW) {
            const int slot = c % RING_SLOTS; LAS unsigned char* R = lds + slot * SUM_BYTES;
            const unsigned char* rec = rec0 + (size_t)c * SUM_BYTES;
            v4u buf[18];
#pragma unroll
            for (int k = 0; k < 18; ++k) { const int pc = k < 12 ? k : (k < 16 ? 12 + 4 * it + (k - 12) : 20 + 2 * it + (k - 16)); buf[k] = *(const GAS v4u*)(rec + pc * 1024 + lane * 16); }
            if (c >= RING_SLOTS) { spin_until(freef + slot, (unsigned)(c - RING_SLOTS + 1)); spin_until(freeB + slot, (unsigned)(c - RING_SLOTS + 1)); }
            asm volatile("" ::: "memory");
#pragma unroll
            for (int k = 0; k < 18; ++k) { const int pc = k < 12 ? k : (k < 16 ? 12 + 4 * it + (k - 12) : 20 + 2 * it + (k - 16)); *(LAS v4u*)(R + ring_swz(pc * 1024 + lane * 16)) = buf[k]; }
            LDS_WAIT();
            if (lane == 0) full[slot] = (unsigned)(c + 1);
        }
    } else if (QUANT_IN_SCAN) {
        constexpr int NQW = 6 - NLOADW;
        const int nchain = (G >= 128) ? 128 : 0;
        const int nq = NQW * nchain + 8 * (G - nchain);
        const int qid = chain_block ? NQW * bx + (wave - 2 - NLOADW) : NQW * nchain + 8 * (bx - nchain) + wave;
        quant_rows(a, qid, nq, lane);
    }
    if (G < 128 && bx == 0 && wave == 0) {
        float* Y = (float*)(ws + WS_Y); for (int i = lane; i < 4096; i += 64) Y[i] = __builtin_nanf("");
    }
}

__device__ __forceinline__ void phase6(const Args& a, int gw, int NGW, int lane) {
    unsigned char* ws = a.ws;
    const float* Y = (const float*)(ws + WS_Y); const bf16* V = (const bf16*)(ws + WS_V); const bf16* G = (const bf16*)(ws + WS_G); const float* BON = (const float*)(ws + WS_BONUS);
    const float* lw = a.in[12]; const float* lb = a.in[13]; bf16* MIX = (bf16*)(ws + WS_MIXED);
    for (int it = gw; it < M * 4; it += NGW) {
        const int m = it >> 2, ch = (it & 3) * 512 + lane * 8; const size_t o = (size_t)m * RW + ch;
        const f32x4 y0 = *(const GAS f32x4*)(Y + o), y1 = *(const GAS f32x4*)(Y + o + 4);
        float y[8] = {y0.x, y0.y, y0.z, y0.w, y1.x, y1.y, y1.z, y1.w}, v[8], g[8];
        unpack8(*(const GAS v4u*)(V + o), v); unpack8(*(const GAS v4u*)(G + o), g);
        float s = 0.f;
#pragma unroll
        for (int j = 0; j < 8; ++j) s += y[j];
        s += __shfl_xor(s, 1); s += __shfl_xor(s, 2); s += __shfl_xor(s, 4);
        const float mean = s * (1.0f / 64.0f); float q = 0.f;
#pragma unroll
        for (int j = 0; j < 8; ++j) { y[j] -= mean; q += y[j] * y[j]; }
        q += __shfl_xor(q, 1); q += __shfl_xor(q, 2); q += __shfl_xor(q, 4);
        const float rstd = 1.0f / sqrtf(q * (1.0f / 64.0f) + 64e-5f), bn = BON[(size_t)m * NH + (ch >> 6)];
        const f32x4 w0 = *(const GAS f32x4*)(lw + ch), w1 = *(const GAS f32x4*)(lw + ch + 4), b0 = *(const GAS f32x4*)(lb + ch), b1 = *(const GAS f32x4*)(lb + ch + 4);
        float r[8];
#pragma unroll
        for (int j = 0; j < 8; ++j) r[j] = (y[j] * rstd * (j < 4 ? w0[j] : w1[j - 4]) + (j < 4 ? b0[j] : b1[j - 4]) + bn * v[j]) * g[j];
        *(GAS v4u*)(MIX + (size_t)m * D + ch) = pack8(r);
    }
}

typedef short bf16x8_t __attribute__((ext_vector_type(8)));
typedef float f32x16 __attribute__((ext_vector_type(16)));
__device__ __forceinline__ unsigned f2ord(float f) { const unsigned u = __builtin_bit_cast(unsigned, f); return (u & 0x80000000u) ? ~u : (u | 0x80000000u); }
__device__ __forceinline__ float ord2f(unsigned o) { const unsigned u = (o & 0x80000000u) ? (o & 0x7fffffffu) : ~o; return __builtin_bit_cast(float, u); }
__device__ __forceinline__ void ce_desc(unsigned& x, unsigned& y) { const unsigned hi = max(x, y), lo = min(x, y); x = hi; y = lo; }
template <int B> __device__ __forceinline__ void sort16_desc(unsigned (&u)[64]) {
#define CE(i, j) ce_desc(u[B + (i)], u[B + (j)]);
    CE(0,1) CE(2,3) CE(0,2) CE(1,3) CE(1,2) CE(4,5) CE(6,7) CE(4,6) CE(5,7) CE(5,6) CE(0,4) CE(2,6) CE(2,4) CE(1,5) CE(3,7) CE(3,5) CE(1,2) CE(3,4) CE(5,6) CE(8,9) CE(10,11) CE(8,10) CE(9,11) CE(9,10) CE(12,13) CE(14,15) CE(12,14) CE(13,15) CE(13,14) CE(8,12) CE(10,14) CE(10,12) CE(9,13) CE(11,15) CE(11,13) CE(9,10) CE(11,12) CE(13,14) CE(0,8) CE(4,12) CE(4,8) CE(2,10) CE(6,14) CE(6,10) CE(2,4) CE(6,8) CE(10,12) CE(1,9) CE(5,13) CE(5,9) CE(3,11) CE(7,15) CE(7,11) CE(3,5) CE(7,9) CE(11,13) CE(1,2) CE(3,4) CE(5,6) CE(7,8) CE(9,10) CE(11,12) CE(13,14)
#undef CE
}
template <int B> __device__ __forceinline__ void bitonic16_desc(unsigned (&u)[64]) {
#define CE(i, j) ce_desc(u[B + (i)], u[B + (j)]);
    CE(0,8) CE(1,9) CE(2,10) CE(3,11) CE(4,12) CE(5,13) CE(6,14) CE(7,15) CE(0,4) CE(1,5) CE(2,6) CE(3,7) CE(8,12) CE(9,13) CE(10,14) CE(11,15) CE(0,2) CE(1,3) CE(4,6) CE(5,7) CE(8,10) CE(9,11) CE(12,14) CE(13,15) CE(0,1) CE(2,3) CE(4,5) CE(6,7) CE(8,9) CE(10,11) CE(12,13) CE(14,15)
#undef CE
}
template <int BA, int BB> __device__ __forceinline__ void merge_top16(unsigned (&u)[64]) {
#pragma unroll
    for (int i = 0; i < 16; ++i) u[BA + i] = max(u[BA + i], u[BB + 15 - i]);
    bitonic16_desc<BA>(u);
}
__device__ __forceinline__ void top16_of_64(unsigned (&u)[64]) {
    sort16_desc<0>(u); sort16_desc<16>(u); sort16_desc<32>(u); sort16_desc<48>(u);
    merge_top16<0, 16>(u); merge_top16<32, 48>(u); merge_top16<0, 32>(u);
}
__device__ __forceinline__ void phase9(const Args& a, int gw, int NGW, int lane) {
    unsigned char* ws = a.ws;
    const bf16* SKB = (const bf16*)(ws + WS_SKB); const bf16* Q = (const bf16*)(ws + WS_Q);
    int* EIDX = (int*)(ws + WS_EIDX); float* GATE = (float*)(ws + WS_GATE);
    const int tokl = lane & 31, hh = lane >> 5;
    for (int unit = gw; unit < (M / 32) * PH; unit += NGW) {
        const int h = unit & 7, m0 = (unit >> 3) * 32;
        unsigned tc[2][16];
#pragma unroll
        for (int c = 0; c < 2; ++c) {
            f32x16 acc[4];
#pragma unroll
            for (int t = 0; t < 4; ++t)
#pragma unroll
                for (int r = 0; r < 16; ++r) acc[t][r] = 0.f;
            const bf16* qrow = Q + (size_t)(m0 + tokl) * 2048 + h * 256 + c * 128 + 8 * hh;
            const bf16* krow = SKB + ((size_t)(h * 2 + c) * 128 + tokl) * 128 + 8 * hh;
#pragma unroll 4
            for (int ks = 0; ks < 8; ++ks) {
                const bf16x8_t bq = __builtin_bit_cast(bf16x8_t, *(const GAS v4u*)(qrow + ks * 16));
#pragma unroll
                for (int t = 0; t < 4; ++t) { const bf16x8_t ak = __builtin_bit_cast(bf16x8_t, *(const GAS v4u*)(krow + t * 32 * 128 + ks * 16));
                    acc[t] = __builtin_amdgcn_mfma_f32_32x32x16_bf16(ak, bq, acc[t], 0, 0, 0); }
            }
            unsigned u[64];
#pragma unroll
            for (int t = 0; t < 4; ++t)
#pragma unroll
                for (int r = 0; r < 16; ++r) { const int nb = t * 32 + (r & 3) + 8 * (r >> 2);
                    u[t * 16 + r] = (f2ord(acc[t][r]) & ~127u) | (unsigned)(127 - nb - 4 * hh); }
            top16_of_64(u);
#pragma unroll
            for (int i = 0; i < 16; ++i) { const unsigned p = (unsigned)__shfl_xor((int)u[15 - i], 32); u[16 + i] = p; }
#pragma unroll
            for (int i = 0; i < 16; ++i) u[i] = max(u[i], u[16 + i]);
            bitonic16_desc<0>(u);
#pragma unroll
            for (int i = 0; i < 16; ++i) tc[c][i] = u[i];
        }
        float s0[16], s1[16]; unsigned n0[16], n1[16];
#pragma unroll
        for (int i = 0; i < 16; ++i) { s0[i] = ord2f(tc[0][i] & ~127u); s1[i] = ord2f(tc[1][i] & ~127u); n0[i] = (127u - (tc[0][i] & 127u)) << 7; n1[i] = 127u - (tc[1][i] & 127u); }
        unsigned u[64];
#define CAND(k, i, j) u[k] = (f2ord(s0[i] + s1[j]) & ~0x3FFFu) | (n0[i] | n1[j]);
        CAND(0,0,0) CAND(1,0,1) CAND(2,0,2) CAND(3,0,3) CAND(4,0,4) CAND(5,0,5) CAND(6,0,6) CAND(7,0,7) CAND(8,0,8) CAND(9,0,9) CAND(10,0,10) CAND(11,0,11) CAND(12,0,12) CAND(13,0,13) CAND(14,0,14) CAND(15,0,15) CAND(16,1,0) CAND(17,1,1) CAND(18,1,2) CAND(19,1,3) CAND(20,1,4) CAND(21,1,5) CAND(22,1,6) CAND(23,1,7) CAND(24,2,0) CAND(25,2,1) CAND(26,2,2) CAND(27,2,3) CAND(28,2,4) CAND(29,3,0) CAND(30,3,1) CAND(31,3,2) CAND(32,3,3) CAND(33,4,0) CAND(34,4,1) CAND(35,4,2) CAND(36,5,0) CAND(37,5,1) CAND(38,6,0) CAND(39,6,1) CAND(40,7,0) CAND(41,7,1) CAND(42,8,0) CAND(43,9,0) CAND(44,10,0) CAND(45,11,0) CAND(46,12,0) CAND(47,13,0) CAND(48,14,0) CAND(49,15,0)
#undef CAND
#pragma unroll
        for (int k = 50; k < 64; ++k) u[k] = 0u;
        top16_of_64(u);
        float ex[16]; float den = 0.f; const float mx = ord2f(u[0] & ~0x3FFFu);
#pragma unroll
        for (int r = 0; r < 16; ++r) { ex[r] = __expf(ord2f(u[r] & ~0x3FFFu) - mx); den += ex[r]; }
        const float inv = 1.0f / den;
        if (hh == 0) {
            const size_t o = (size_t)(m0 + tokl) * 128 + h * 16;
#pragma unroll
            for (int r4 = 0; r4 < 4; ++r4) {
                *(GAS v4u*)(EIDX + o + r4 * 4) = (v4u){u[r4 * 4] & 0x3FFFu, u[r4 * 4 + 1] & 0x3FFFu, u[r4 * 4 + 2] & 0x3FFFu, u[r4 * 4 + 3] & 0x3FFFu};
                *(GAS f32x4*)(GATE + o + r4 * 4) = (f32x4){ex[r4 * 4] * inv, ex[r4 * 4 + 1] * inv, ex[r4 * 4 + 2] * inv, ex[r4 * 4 + 3] * inv};
            }
        }
    }
}

__device__ __forceinline__ float gelu_erf(float v) { return 0.5f * v * (1.0f + erff(v * 0.70710678118f)); }
constexpr int PW_BYTES = 1536;
__device__ __forceinline__ void phase10(const Args& a, LAS unsigned char* lds, int gw, int NGW, int wave, int lane, float* OUT) {
    unsigned char* ws = a.ws;
    const bf16* HB = (const bf16*)(ws + WS_XN); const float* SSQ = (const float*)(ws + WS_SSQ);
    const int* EIDX = (const int*)(ws + WS_EIDX); const float* GATE = (const float*)(ws + WS_GATE);
    const unsigned char* DQ = ws + WS_DQ; const unsigned char* UQ = ws + WS_UQ; const float* DS = (const float*)(ws + WS_DSCALE); const float* US = (const float*)(ws + WS_USCALE);
    const float* nfw = a.in[21]; const float* n2w = a.in[16];
    LAS int* le = (LAS int*)(lds + wave * PW_BYTES); LAS float* lg = (LAS float*)(lds + wave * PW_BYTES + 512); LAS float* lc = (LAS float*)(lds + wave * PW_BYTES + 1024);
    for (int m = gw; m < M; m += NGW) {
        const float rs2 = 1.0f / sqrtf(SSQ[m] * (1.0f / D) + 1e-6f);
        LDS_WAIT();
        le[lane] = EIDX[(size_t)m * 128 + lane]; le[lane + 64] = EIDX[(size_t)m * 128 + 64 + lane];
        lg[lane] = GATE[(size_t)m * 128 + lane]; lg[lane + 64] = GATE[(size_t)m * 128 + 64 + lane];
        float xs[64];
#pragma unroll
        for (int k = 0; k < 16; ++k) { const v2u w = *(const GAS v2u*)(HB + (size_t)m * D + k * 256 + lane * 4);
            xs[4 * k + 0] = bflo(w.x); xs[4 * k + 1] = bfhi(w.x); xs[4 * k + 2] = bflo(w.y); xs[4 * k + 3] = bfhi(w.y); }
        LDS_WAIT();
#pragma unroll 1
        for (int g = 0; g < 8; ++g) {
            float pv[16];
#pragma unroll
            for (int k = 0; k < 16; ++k) {
                const int e = __builtin_amdgcn_readfirstlane(le[g * 16 + k]);
                const unsigned char* rp = DQ + (size_t)e * ROWB_DN + lane * 16;
                float ev[64];
#if PEER_DN_FP4
                { const v4u u0 = *(const GAS v4u*)(rp), u1 = *(const GAS v4u*)(rp + 1024);
#pragma unroll
                  for (int w = 0; w < 8; ++w) { const unsigned dw = w < 4 ? u0[w] : u1[w - 4];
#define FP4_DN(b2) { const f32x2 xy = __builtin_amdgcn_cvt_scalef32_pk_f32_fp4(dw, 1.0f, b2); ev[8 * w + 2 * (b2)] = xy.x; ev[8 * w + 2 * (b2) + 1] = xy.y; }
                      FP4_DN(0) FP4_DN(1) FP4_DN(2) FP4_DN(3)
#undef FP4_DN
                  } }
#else
                load_qrow(rp, ev);
#endif
                f32x2 p2a = (f32x2){0.f, 0.f}, p2b = (f32x2){0.f, 0.f};
#pragma unroll
                for (int i = 0; i < 16; ++i) { p2a += (f32x2){ev[4 * i], ev[4 * i + 1]} * (f32x2){xs[4 * i], xs[4 * i + 1]}; p2b += (f32x2){ev[4 * i + 2], ev[4 * i + 3]} * (f32x2){xs[4 * i + 2], xs[4 * i + 3]}; }
                const float p = (p2a.x + p2a.y) + (p2b.x + p2b.y);
                pv[k] = p;
            }
#pragma unroll
            for (int k = 0; k < 8; ++k) { const bool up = (lane & 32) != 0; const float send = up ? pv[k] : pv[k + 8], keep = up ? pv[k + 8] : pv[k]; pv[k] = keep + __shfl_xor(send, 32); }
#pragma unroll
            for (int k = 0; k < 4; ++k) { const bool up = (lane & 16) != 0; const float send = up ? pv[k] : pv[k + 4], keep = up ? pv[k + 4] : pv[k]; pv[k] = keep + __shfl_xor(send, 16); }
#pragma unroll
            for (int k = 0; k < 2; ++k) { const bool up = (lane & 8) != 0; const float send = up ? pv[k] : pv[k + 2], keep = up ? pv[k + 2] : pv[k]; pv[k] = keep + __shfl_xor(send, 8); }
            { const bool up = (lane & 4) != 0; const float send = up ? pv[0] : pv[1], keep = up ? pv[1] : pv[0]; pv[0] = keep + __shfl_xor(send, 4); }
            float tot = pv[0]; tot += __shfl_xor(tot, 1); tot += __shfl_xor(tot, 2);
            const int idx = g * 16 + ((lane >> 2) & 15); const int e = le[idx];
            const float c = lg[idx] * gelu_erf(tot * DS[e] * rs2) * US[e];
            if ((lane & 3) == 0) lc[idx] = c;
        }
        LDS_WAIT();
        float acc[64];
#pragma unroll
        for (int i = 0; i < 64; ++i) acc[i] = 0.f;
#if PEER_UP_FP4
#pragma unroll 2
        for (int idx = 0; idx < 128; ++idx) {
            const int e = __builtin_amdgcn_readfirstlane(le[idx]); const float c = __builtin_bit_cast(float, __builtin_amdgcn_readfirstlane(__builtin_bit_cast(int, lc[idx])));
            const unsigned char* rp = UQ + (size_t)e * ROWB_UP + lane * 16;
            const v4u u0 = *(const GAS v4u*)(rp), u1 = *(const GAS v4u*)(rp + 1024);
            const f32x2 cc = (f32x2){c, c};
#pragma unroll
            for (int w = 0; w < 8; ++w) { const unsigned dw = w < 4 ? u0[w] : u1[w - 4];
#define FP4_UP(b2) { const f32x2 xy = __builtin_amdgcn_cvt_scalef32_pk_f32_fp4(dw, 1.0f, b2); const int t0 = 8 * w + 2 * (b2); acc[t0] += c * xy.x; acc[t0 + 1] += c * xy.y; }
                FP4_UP(0) FP4_UP(1) FP4_UP(2) FP4_UP(3)
#undef FP4_UP
            }
        }
#else
#pragma unroll 4
        for (int idx = 0; idx < 128; ++idx) {
            const int e = __builtin_amdgcn_readfirstlane(le[idx]); const float c = __builtin_bit_cast(float, __builtin_amdgcn_readfirstlane(__builtin_bit_cast(int, lc[idx])));
            const unsigned char* rp = UQ + (size_t)e * ROWB + lane * 16;
            float ev[64]; load_qrow(rp, ev);
#pragma unroll
            for (int i = 0; i < 64; ++i) acc[i] += c * ev[i];
        }
#endif
        float ss = 0.f;
#pragma unroll
        for (int i = 0; i < 4; ++i)
#pragma unroll
            for (int j = 0; j < 4; ++j) { const v2u hw = *(const GAS v2u*)(HB + (size_t)m * D + (i * 4 + j) * 256 + lane * 4); const f32x4 nv = *(const GAS f32x4*)(n2w + (i * 4 + j) * 256 + lane * 4);
                f32x4 hv; hv.x = bflo(hw.x) * __builtin_amdgcn_rcpf(nv.x); hv.y = bfhi(hw.x) * __builtin_amdgcn_rcpf(nv.y); hv.z = bflo(hw.y) * __builtin_amdgcn_rcpf(nv.z); hv.w = bfhi(hw.y) * __builtin_amdgcn_rcpf(nv.w);
                acc[i * 16 + j * 4 + 0] += hv.x; acc[i * 16 + j * 4 + 1] += hv.y; acc[i * 16 + j * 4 + 2] += hv.z; acc[i * 16 + j * 4 + 3] += hv.w;
                ss += (acc[i * 16 + j * 4 + 0] * acc[i * 16 + j * 4 + 0] + acc[i * 16 + j * 4 + 1] * acc[i * 16 + j * 4 + 1]) + (acc[i * 16 + j * 4 + 2] * acc[i * 16 + j * 4 + 2] + acc[i * 16 + j * 4 + 3] * acc[i * 16 + j * 4 + 3]); }
        const float rsf = 1.0f / sqrtf(wave_sum(ss) * (1.0f / D) + 1e-6f);
#pragma unroll
        for (int i = 0; i < 4; ++i)
#pragma unroll
            for (int j = 0; j < 4; ++j) { const f32x4 wv = *(const GAS f32x4*)(nfw + (i * 4 + j) * 256 + lane * 4);
                f32x4 o; o.x = acc[i * 16 + j * 4 + 0] * rsf * wv.x; o.y = acc[i * 16 + j * 4 + 1] * rsf * wv.y; o.z = acc[i * 16 + j * 4 + 2] * rsf * wv.z; o.w = acc[i * 16 + j * 4 + 3] * rsf * wv.w;
                *(GAS f32x4*)(OUT + (size_t)m * D + (i * 4 + j) * 256 + lane * 4) = o; }
    }
}

__global__ void __launch_bounds__(NTHREADS, 2) mega_fwd(Args args) {
    extern __shared__ __attribute__((aligned(16))) unsigned char lds_raw[];
    LAS unsigned char* lds = (LAS unsigned char*)lds_raw;
    volatile LAS unsigned* MISC = (volatile LAS unsigned*)(lds + MISC_OFF);
    const int tid = threadIdx.x, lane = tid & 63, wave = __builtin_amdgcn_readfirstlane(tid >> 6);
    const int G = gridDim.x, bx = blockIdx.x;
    const int vcu = (G % 8 == 0) ? (bx % 8) * (G / 8) + bx / 8 : bx;
    const int gw = vcu * NWAVES + wave, NGW = G * NWAVES, gt = gw * 64 + lane, NGT = NGW * 64;
    unsigned char* ws = args.ws;
    for (int u = tid; u < (LDS_BYTES - LDSCTL_OFF) / 4; u += NTHREADS) ((LAS unsigned*)(lds + LDSCTL_OFF))[u] = 0u;
    __syncthreads();
    XcdBarrier bar; bar.bar = (unsigned*)(ws + WS_CTL) + CW_BAR + args.li * XCD_BAR_WORDS; bar.x = 0; bar.st = nullptr;
    if (MK_N_LAUNCHES == 1) bar = xcd_barrier_post((unsigned*)(ws + WS_CTL) + CW_BAR + args.li * XCD_BAR_WORDS, MISC + 8);
    const int lo = args.ph_lo, hi = args.ph_hi;
#ifndef PHASE_MASK
#define PHASE_MASK 0xfff
#endif
#define IN(k) (((PHASE_MASK >> (k)) & 1) && lo <= (k) && (k) < hi)
#ifndef DUP_MASK
#define DUP_MASK 0
#endif
#define DUP(k) ((DUP_MASK >> (k)) & 1)
#define SEAM(k) do { if (IN(k) && IN((k) + 1)) xcd_barrier(bar); } while (0)

    if (IN(0)) { phase0(args, lds, gw, NGW, wave, lane); if (DUP(0)) { __syncthreads(); phase0(args, lds, gw, NGW, wave, lane); } } SEAM(0);
    if (IN(1)) {
        pg8::Gemm g{(const bf16*)(ws + WS_XN), (const bf16*)(ws + WS_WINT), M, NPROJ, D, D}; pg8::StaticOrder S; S.init(M, NPROJ, G, bx);
        pg8::EpiPlainBf16 E{(bf16*)(ws + WS_PROJ), NPROJ};
        pg8::gemm_phase<pg8::EpiPlainBf16, pg8::StaticOrder, true, true>(lds + RING_OFF, g, S, E);
        if (DUP(1)) { __syncthreads(); pg8::gemm_phase<pg8::EpiPlainBf16, pg8::StaticOrder, true, true>(lds + RING_OFF, g, S, E); }
        for (int u = bx; u < (M / 256) * 2 * KSPLIT; u += G) {
            const int pm = u >> 3, pnl = (u >> 2) & 1, ks = u & 3;
            __syncthreads();
            pg8::Gemm g2{(const bf16*)(ws + WS_XN) + ks * (D / KSPLIT), (const bf16*)(ws + WS_WINT) + (size_t)NPROJ * D + ks * (D / KSPLIT), M, SLABW, D / KSPLIT, D};
            pg8::SingleUnit S2{pm, pnl}; pg8::EpiSlabF32 E2{(float*)(ws + WS_SLAB) + (size_t)ks * M * SLABW, SLABW};
            pg8::gemm_phase<pg8::EpiSlabF32, pg8::SingleUnit, false, true>(lds + RING_OFF, g2, S2, E2);
        }
    } SEAM(1);
    if (IN(2)) { phase2(args, gt, NGT); if (DUP(2)) phase2(args, gt, NGT); } SEAM(2);
    if (IN(3)) {
        pg8::Gemm g{(const bf16*)(ws + WS_LIN), (const bf16*)(ws + WS_WLORA), M, NLORA, KLORA, KLORA}; pg8::StaticOrder S; S.init(M, NLORA, G, bx);
        pg8::EpiLora E{(float*)(ws + WS_WD), (bf16*)(ws + WS_AA), (bf16*)(ws + WS_G), args.in[4], args.in[6]};
        pg8::gemm_phase<pg8::EpiLora, pg8::StaticOrder, true, true>(lds + RING_OFF, g, S, E);
        if (DUP(3)) { __syncthreads(); pg8::gemm_phase<pg8::EpiLora, pg8::StaticOrder, true, true>(lds + RING_OFF, g, S, E); }
    } SEAM(3);
    if (!SCAN_CHUNKED) { if (IN(4)) { phase4(args, gw, NGW, lane); } SEAM(4); }
    if (IN(5)) { if (SCAN_CHUNKED) phase5a(args, lds, gw, NGW, wave, lane); else phase5(args, lds, tid); } SEAM(5);
    if (IN(6)) { if (SCAN_CHUNKED) phase5b(args, lds, bx, G, tid, wave, lane); } SEAM(6);
    if (IN(7)) { phase6(args, gw, NGW, lane); if (DUP(7)) phase6(args, gw, NGW, lane); } SEAM(7);
    if (IN(8)) {
        pg8::Gemm g{(const bf16*)(ws + WS_MIXED), (const bf16*)(ws + WS_WOUTT), M, D, D, D}; pg8::StaticOrder S; S.init(M, D, G, bx);
        pg8::EpiOut<true> E{args.in[0], args.out, (bf16*)(ws + WS_XN), args.in[16], (float*)(ws + WS_SSQ)};
        pg8::gemm_phase<pg8::EpiOut<true>, pg8::StaticOrder, true, true>(lds + RING_OFF, g, S, E);
        if (DUP(8)) { __syncthreads(); pg8::EpiOut<false> E2{args.in[0], args.out, (bf16*)(ws + WS_XN), args.in[16], (float*)(ws + WS_SSQ)}; pg8::gemm_phase<pg8::EpiOut<false>, pg8::StaticOrder, true, true>(lds + RING_OFF, g, S, E2); }
    } SEAM(8);
    if (IN(9)) {
        pg8::Gemm g{(const bf16*)(ws + WS_XN), (const bf16*)(ws + WS_WQT), M, 2048, D, D}; pg8::StaticOrder S; S.init(M, 2048, G, bx);
        pg8::EpiQ E{(bf16*)(ws + WS_Q), (const float*)(ws + WS_SSQ)};
        pg8::gemm_phase<pg8::EpiQ, pg8::StaticOrder, true, true>(lds + RING_OFF, g, S, E);
        if (DUP(9)) { __syncthreads(); pg8::gemm_phase<pg8::EpiQ, pg8::StaticOrder, true, true>(lds + RING_OFF, g, S, E); }
    } SEAM(9);
    if (IN(10)) { phase9(args, gw, NGW, lane); if (DUP(10)) phase9(args, gw, NGW, lane); } SEAM(10);
    if (IN(11)) { if (DUP(11)) phase10(args, lds, gw, NGW, wave, lane, (float*)(ws + WS_PROJ)); phase10(args, lds, gw, NGW, wave, lane, args.out); }
#undef IN
#undef SEAM
}

extern "C" void kernel_launch(void* const* d_in, const int* in_sizes, int n_in, void* d_out, int out_size, void* d_ws, size_t ws_size, hipStream_t stream) {
    static int grid = 0;
    if (grid == 0) {
        if (n_in != 22 || in_sizes[0] != M * D || out_size != M * D || ws_size < WS_END) { fprintf(stderr, "kernel_launch: unexpected shapes: n_in %d in0 %d out %d ws %zu (need %zu)\n", n_in, n_in > 0 ? in_sizes[0] : -1, out_size, ws_size, (size_t)WS_END); grid = -1; return; }
        int dev = 0, cus = 0, per_cu = 0;
        if (hipGetDevice(&dev) != hipSuccess || hipDeviceGetAttribute(&cus, hipDeviceAttributeMultiprocessorCount, dev) != hipSuccess) { grid = -1; return; }
        if (hipFuncSetAttribute((const void*)mega_fwd, hipFuncAttributeMaxDynamicSharedMemorySize, LDS_BYTES) != hipSuccess) { fprintf(stderr, "kernel_launch: hipFuncSetAttribute failed\n"); grid = -1; return; }
        if (hipOccupancyMaxActiveBlocksPerMultiprocessor(&per_cu, (const void*)mega_fwd, NTHREADS, LDS_BYTES) != hipSuccess || per_cu < 1) { fprintf(stderr, "kernel_launch: occupancy query says %d blocks per CU\n", per_cu); }
        (void)hipGetLastError();
        grid = cus;
    }
    if (grid < 0) return;
    (void)hipMemsetAsync((char*)d_ws + WS_CTL, 0, CTL_ZERO_BYTES, stream);
    Args a{};
    for (int i = 0; i < 22; ++i) a.in[i] = (const float*)d_in[i];
    a.out = (float*)d_out; a.ws = (unsigned char*)d_ws;
#ifndef REPEAT_PREFIX
#define REPEAT_PREFIX 0
#endif
    if (MK_N_LAUNCHES == 1) { a.ph_lo = 0; a.ph_hi = NPHASES; hipLaunchKernelGGL(mega_fwd, dim3(grid), dim3(NTHREADS), LDS_BYTES, stream, a);
        if (REPEAT_PREFIX > 0) { a.ph_hi = REPEAT_PREFIX; a.li = 1; hipLaunchKernelGGL(mega_fwd, dim3(grid), dim3(NTHREADS), LDS_BYTES, stream, a); } }
    else for (int p = 0; p < NPHASES; ++p) { a.ph_lo = p; a.ph_hi = p + 1; hipLaunchKernelGGL(mega_fwd, dim3(grid), dim3(NTHREADS), LDS_BYTES, stream, a); }
}
```

```cpp
#include <hip/hip_runtime.h>
#include <cstdio>
#include <cstdint>
namespace pg8 {
#define PG8_LAS __attribute__((address_space(3)))
typedef unsigned short bf16_t;
typedef short bf16x8 __attribute__((ext_vector_type(8)));
typedef float f32x4 __attribute__((ext_vector_type(4)));
typedef unsigned u32x4 __attribute__((ext_vector_type(4)));
constexpr int BM = 256, BK = 64, HALF = 128, HTB = HALF * BK * 2  , STAGE_BYTES = 8 * HTB, NXCD = 8, WGM = 8;

__host__ __device__ __forceinline__ int lds_byte(int r, int c) { const int st = (r >> 4) * 2 + (c >> 5), rr = r & 15, cc = c & 31, ob = rr * 64 + cc * 2; return st * 1024 + (ob ^ (((ob >> 9) & 1) << 5)); }
__host__ __device__ __forceinline__ void stage_rc(int b, int& R, int& C) { const int st = b / 1024, sb = b % 1024, swz = sb ^ (((sb >> 9) & 1) << 5); R = (st >> 1) * 16 + swz / 64; C = (st & 1) * 32 + (swz % 64) / 2; }
__host__ __device__ __forceinline__ int perm32(int rho) { const int n = rho >> 4, i = rho & 15; return 8 * (i >> 2) + 4 * n + (i & 3); }

struct Unit { int pm, pn; };
struct Gemm { const bf16_t* A; const bf16_t* Bt; int M, N, K, ld; };

struct StaticOrder {
    int nM, nN, nwg, G, c;
    __host__ __device__ void init(int M, int N, int G_, int c_) { nM = M / BM; nN = N / BM; nwg = nM * nN; G = G_; c = c_; }
    __host__ __device__ bool next(int i, Unit& u) const {
        const long L = (long)i * G + c; if (L >= nwg) return false;
        int wgid = (int)L; { const int q = nwg / NXCD, r = nwg % NXCD, xcd = wgid % NXCD, off = wgid / NXCD; wgid = (xcd < r ? xcd * (q + 1) : r * (q + 1) + (xcd - r) * q) + off; }
        const int nig = WGM * nN, gid = wgid / nig, fm = gid * WGM, gsz = (nM - fm) < WGM ? (nM - fm) : WGM;
        u.pm = fm + ((wgid % nig) % gsz); u.pn = (wgid % nig) / gsz; return true;
    }
    __device__ __forceinline__ void a_ready(const Unit&) const {}
    __device__ __forceinline__ void done(const Unit&) const {}
};

struct SingleUnit {
    int pm, pn;
    __device__ __forceinline__ bool next(int i, Unit& u) const { if (i != 0) return false; u.pm = pm; u.pn = pn; return true; }
    __device__ __forceinline__ void a_ready(const Unit&) const {}
    __device__ __forceinline__ void done(const Unit&) const {}
};
__device__ __forceinline__ unsigned cvt_pk_bf16(float lo, float hi) { unsigned r; asm volatile("v_cvt_pk_bf16_f32 %0, %1, %2" : "=v"(r) : "v"(lo), "v"(hi)); return r; }
typedef float f32x2 __attribute__((ext_vector_type(2)));
__device__ __forceinline__ f32x2 gelu_pk(f32x2 v) {
    const f32x2 av = __builtin_elementwise_abs(v), d = av * 0.2316418882f + 1.0f;
    f32x2 t; t.x = __builtin_amdgcn_rcpf(d.x); t.y = __builtin_amdgcn_rcpf(d.y);
    f32x2 q = t * 0.5307027145f + (-0.7265760135f); q = q * t + 0.7107068705f; q = q * t + (-0.142248368f); q = q * t + 0.127414796f; q = q * t;
    const f32x2 s = (v * v) * (-0.72134752044f);
    f32x2 e; e.x = __builtin_amdgcn_exp2f(s.x); e.y = __builtin_amdgcn_exp2f(s.y);
    const f32x2 m = v * (q * e), r = v - m;
    f32x2 o; o.x = v.x < 0.f ? m.x : r.x; o.y = v.y < 0.f ? m.y : r.y; return o;
}


typedef unsigned u32x2 __attribute__((ext_vector_type(2)));
__device__ __forceinline__ float fast_sigmoid(float v) { return __builtin_amdgcn_rcpf(1.0f + __expf(-v)); }

struct EpiPlainBf16 {
    static constexpr bool PERM = true, AFTER_DRAIN = false;
    bf16_t* O; int ldc;
    __device__ __forceinline__ void operator()(const f32x4 (&acc)[2][2][4][2], const Unit& u, int wr, int wc, int fr, int fq) const {
        const int row0 = u.pm * BM + wr * 64 + fr, col0 = u.pn * BM + wc * 32 + 8 * fq;
#pragma unroll
        for (int ai = 0; ai < 2; ++ai)
#pragma unroll
            for (int m = 0; m < 4; ++m) { bf16_t* rowp = O + (size_t)(row0 + ai * HALF + m * 16) * ldc + col0;
#pragma unroll
                for (int bj = 0; bj < 2; ++bj) { const f32x4 v0 = acc[ai][bj][m][0], v1 = acc[ai][bj][m][1];
                    u32x4 w; w.x = cvt_pk_bf16(v0[0], v0[1]); w.y = cvt_pk_bf16(v0[2], v0[3]); w.z = cvt_pk_bf16(v1[0], v1[1]); w.w = cvt_pk_bf16(v1[2], v1[3]);
                    *(u32x4*)(rowp + bj * HALF) = w; } }
    }
};

struct EpiSlabF32 {
    static constexpr bool PERM = false, AFTER_DRAIN = false;
    float* O; int ldc;
    __device__ __forceinline__ void operator()(const f32x4 (&acc)[2][2][4][2], const Unit& u, int wr, int wc, int fr, int fq) const {
        const int row0 = u.pm * BM + wr * 64 + fr, col0 = u.pn * BM + wc * 32 + 4 * fq;
#pragma unroll
        for (int ai = 0; ai < 2; ++ai)
#pragma unroll
            for (int m = 0; m < 4; ++m) { float* rowp = O + (size_t)(row0 + ai * HALF + m * 16) * ldc + col0;
#pragma unroll
                for (int bj = 0; bj < 2; ++bj)
#pragma unroll
                    for (int n = 0; n < 2; ++n) *(f32x4*)(rowp + bj * HALF + n * 16) = acc[ai][bj][m][n]; }
    }
};

#ifndef SCAN_CHUNKED
#define SCAN_CHUNKED 1
#endif
struct EpiLora {
    static constexpr bool PERM = true, AFTER_DRAIN = false;
    float* Wd; bf16_t* Aa; bf16_t* Gg; const float* w0; const float* a0;
    template <int KIND> __device__ __forceinline__ void run(const f32x4 (&acc)[2][2][4][2], const Unit& u, int wr, int wc, int fr, int fq) const {
        const int row0 = u.pm * BM + wr * 64 + fr, col0 = (u.pn & 7) * BM + wc * 32 + 8 * fq;
        f32x4 bv[2][2];
#pragma unroll
        for (int bj = 0; bj < 2; ++bj)
#pragma unroll
            for (int n = 0; n < 2; ++n) { if (KIND == 2) bv[bj][n] = (f32x4){0.f, 0.f, 0.f, 0.f}; else bv[bj][n] = *(const f32x4*)((KIND == 0 ? w0 : a0) + col0 + bj * HALF + 4 * n); }
#pragma unroll
        for (int ai = 0; ai < 2; ++ai)
#pragma unroll
            for (int m = 0; m < 4; ++m) { const size_t roff = (size_t)(row0 + ai * HALF + m * 16) * 2048 + col0;
#pragma unroll
                for (int bj = 0; bj < 2; ++bj) { f32x4 v0 = acc[ai][bj][m][0] + bv[bj][0], v1 = acc[ai][bj][m][1] + bv[bj][1];
                    if (KIND == 0) {
                        f32x4 d0, d1;
                        d0.x = -0.60653066f * fast_sigmoid(v0.x); d0.y = -0.60653066f * fast_sigmoid(v0.y); d0.z = -0.60653066f * fast_sigmoid(v0.z); d0.w = -0.60653066f * fast_sigmoid(v0.w);
                        d1.x = -0.60653066f * fast_sigmoid(v1.x); d1.y = -0.60653066f * fast_sigmoid(v1.y); d1.z = -0.60653066f * fast_sigmoid(v1.z); d1.w = -0.60653066f * fast_sigmoid(v1.w);
                        if (!SCAN_CHUNKED) { d0.x = __expf(d0.x); d0.y = __expf(d0.y); d0.z = __expf(d0.z); d0.w = __expf(d0.w); d1.x = __expf(d1.x); d1.y = __expf(d1.y); d1.z = __expf(d1.z); d1.w = __expf(d1.w); }
                        *(f32x4*)(Wd + roff + bj * HALF) = d0; *(f32x4*)(Wd + roff + bj * HALF + 4) = d1;
                    } else {
                        if (KIND == 1) { v0.x = fast_sigmoid(v0.x); v0.y = fast_sigmoid(v0.y); v0.z = fast_sigmoid(v0.z); v0.w = fast_sigmoid(v0.w); v1.x = fast_sigmoid(v1.x); v1.y = fast_sigmoid(v1.y); v1.z = fast_sigmoid(v1.z); v1.w = fast_sigmoid(v1.w); }
                        u32x4 w; w.x = cvt_pk_bf16(v0.x, v0.y); w.y = cvt_pk_bf16(v0.z, v0.w); w.z = cvt_pk_bf16(v1.x, v1.y); w.w = cvt_pk_bf16(v1.z, v1.w);
                        *(u32x4*)((KIND == 1 ? Aa : Gg) + roff + bj * HALF) = w;
                    } } }
    }
    __device__ __forceinline__ void operator()(const f32x4 (&acc)[2][2][4][2], const Unit& u, int wr, int wc, int fr, int fq) const {
        const int kind = u.pn >> 3;
        if (kind == 0) run<0>(acc, u, wr, wc, fr, fq); else if (kind == 1) run<1>(acc, u, wr, wc, fr, fq); else run<2>(acc, u, wr, wc, fr, fq);
    }
};

template <bool ATOM> struct EpiOut {
    static constexpr bool PERM = true, AFTER_DRAIN = false;
    const float* X; float* H1; bf16_t* HB; const float* nw; float* ssq;
    __device__ __forceinline__ void operator()(const f32x4 (&acc)[2][2][4][2], const Unit& u, int wr, int wc, int fr, int fq) const {
        const int row0 = u.pm * BM + wr * 64 + fr, col0 = u.pn * BM + wc * 32 + 8 * fq;
        const float* xp = X + (size_t)row0 * 4096 + col0;
        f32x4 nv[2][2], xb[2][2][2][2];
#pragma unroll
        for (int g = 0; g < 2; ++g)
#pragma unroll
            for (int bj = 0; bj < 2; ++bj)
#pragma unroll
                for (int n = 0; n < 2; ++n) xb[0][g][bj][n] = *(const f32x4*)(xp + (g * 16) * 4096 + bj * HALF + 4 * n);
#pragma unroll
        for (int bj = 0; bj < 2; ++bj)
#pragma unroll
            for (int n = 0; n < 2; ++n) nv[bj][n] = *(const f32x4*)(nw + col0 + bj * HALF + 4 * n);
#pragma unroll
        for (int b = 0; b < 4; ++b) {
            if (b + 1 < 4) {
#pragma unroll
                for (int g = 0; g < 2; ++g) { const int grp = 2 * (b + 1) + g, ai = grp >> 2, m = grp & 3;
#pragma unroll
                    for (int bj = 0; bj < 2; ++bj)
#pragma unroll
                        for (int n = 0; n < 2; ++n) xb[(b + 1) & 1][g][bj][n] = *(const f32x4*)(xp + (ai * HALF + m * 16) * 4096 + bj * HALF + 4 * n); }
            }
            asm volatile("" ::: "memory");
#pragma unroll
            for (int g = 0; g < 2; ++g) { const int grp = 2 * b + g, ai = grp >> 2, m = grp & 3;
                const int row = row0 + ai * HALF + m * 16; const size_t roff = (size_t)row * 4096 + col0; float s = 0.f;
#pragma unroll
                for (int bj = 0; bj < 2; ++bj) {
                    const f32x4 h0 = acc[ai][bj][m][0] + xb[b & 1][g][bj][0], h1 = acc[ai][bj][m][1] + xb[b & 1][g][bj][1];
                    s += (h0[0] * h0[0] + h0[1] * h0[1]) + (h0[2] * h0[2] + h0[3] * h0[3]) + (h1[0] * h1[0] + h1[1] * h1[1]) + (h1[2] * h1[2] + h1[3] * h1[3]);
                    const f32x4 g0 = h0 * nv[bj][0], g1 = h1 * nv[bj][1];
                    u32x4 w; w.x = cvt_pk_bf16(g0[0], g0[1]); w.y = cvt_pk_bf16(g0[2], g0[3]); w.z = cvt_pk_bf16(g1[0], g1[1]); w.w = cvt_pk_bf16(g1[2], g1[3]);
                    *(u32x4*)(HB + roff + bj * HALF) = w; }
                s += __shfl_xor(s, 16); s += __shfl_xor(s, 32);
                if (ATOM && fq == 0) atomicAdd(ssq + row, s); }
            asm volatile("" ::: "memory");
        }
    }
};

struct EpiQ {
    static constexpr bool PERM = true, AFTER_DRAIN = false;
    bf16_t* Q; const float* ssq;
    __device__ __forceinline__ void operator()(const f32x4 (&acc)[2][2][4][2], const Unit& u, int wr, int wc, int fr, int fq) const {
        const int row0 = u.pm * BM + wr * 64 + fr, col0 = u.pn * BM + wc * 32 + 8 * fq;
#pragma unroll
        for (int ai = 0; ai < 2; ++ai)
#pragma unroll
            for (int m = 0; m < 4; ++m) { const int row = row0 + ai * HALF + m * 16; const float rs = __builtin_amdgcn_rsqf(ssq[row] * (1.0f / 4096.0f) + 1e-6f);
                bf16_t* rowp = Q + (size_t)row * 2048 + col0;
#pragma unroll
                for (int bj = 0; bj < 2; ++bj) { const f32x4 v0 = acc[ai][bj][m][0] * rs, v1 = acc[ai][bj][m][1] * rs;
                    u32x4 w; w.x = cvt_pk_bf16(v0[0], v0[1]); w.y = cvt_pk_bf16(v0[2], v0[3]); w.z = cvt_pk_bf16(v1[0], v1[1]); w.w = cvt_pk_bf16(v1[2], v1[3]);
                    *(u32x4*)(rowp + bj * HALF) = w; } }
    }
};

template <class Epi, class Sched, bool ALIGN_EPI = false, bool SP2 = false>
__device__ __forceinline__ void gemm_phase(PG8_LAS unsigned char* lds, const Gemm g, const Sched& S, const Epi& E) {
    const int tid = threadIdx.x, wid = __builtin_amdgcn_readfirstlane(tid >> 6), lane = tid & 63, wr = wid >> 2, wc = wid & 3, fr = lane & 15, fq = lane >> 4;
    const int K = g.ld, nt = g.K / BK;
    unsigned voffA[2], voffB[2];
#pragma unroll
    for (int i = 0; i < 2; ++i) { int R, C; stage_rc(tid * 16 + i * 8192, R, C); const int Rb = Epi::PERM ? ((R & ~31) + perm32(R & 31)) : R;
        voffA[i] = (unsigned)(R * K + C) * 2u; voffB[i] = (unsigned)(Rb * K + C) * 2u; }
    const size_t kstep = (size_t)(BK * 2);
    const size_t hstep = (size_t)HALF * K * 2;
    const size_t tstep = 2 * hstep;
    const unsigned ldsw = (unsigned)wid * 1024u;
    const int aoff = lds_byte(wr * 64 + fr, fq * 8), boff = lds_byte(wc * 32 + fr, fq * 8);
#define PG8_SA(b, h) (((b) * 2 + (h)) * HTB)
#define PG8_SB(b, h) ((4 + (b) * 2 + (h)) * HTB)
#define PG8_STAGE(bufoff, gbase, voff) do { _Pragma("unroll") for (int _i = 0; _i < 2; ++_i) \
        __builtin_amdgcn_global_load_lds((const unsigned*)((const char*)(gbase) + (voff)[_i]), (PG8_LAS unsigned*)(lds + (bufoff) + ldsw + _i * 8192), 16, 0, 0); } while (0)
#define PG8_LDA(dst, b, h) do { _Pragma("unroll") for (int m = 0; m < 4; ++m) _Pragma("unroll") for (int k = 0; k < 2; ++k) dst[m][k] = *(const PG8_LAS bf16x8*)(lds + PG8_SA(b, h) + aoff + m * 2048 + k * 1024); } while (0)
#define PG8_LDB(dst, b, h) do { _Pragma("unroll") for (int n = 0; n < 2; ++n) _Pragma("unroll") for (int k = 0; k < 2; ++k) dst[n][k] = *(const PG8_LAS bf16x8*)(lds + PG8_SB(b, h) + boff + n * 2048 + k * 1024); } while (0)
#define PG8_MMA(ai, bj, At, Bt) do { __builtin_amdgcn_s_setprio(1); _Pragma("unroll") for (int m = 0; m < 4; ++m) _Pragma("unroll") for (int n = 0; n < 2; ++n) _Pragma("unroll") for (int k = 0; k < 2; ++k) \
        acc[ai][bj][m][n] = __builtin_amdgcn_mfma_f32_16x16x32_bf16(Bt[n][k], At[m][k], acc[ai][bj][m][n], 0, 0, 0); __builtin_amdgcn_s_setprio(0); } while (0)
#define PG8_WAIT_V(n) asm volatile("s_waitcnt vmcnt(" #n ")" ::: "memory")
#define PG8_WAIT_L(n) asm volatile("s_waitcnt lgkmcnt(" #n ")" ::: "memory")
#define PG8_BAR __builtin_amdgcn_s_barrier()
#define PG8_SCHED __builtin_amdgcn_sched_barrier(0)
    Unit cur, nxt; int ui = 0;
    if (!S.next(0, cur)) return;
    f32x4 acc[2][2][4][2];
#pragma unroll
    for (int a = 0; a < 2; ++a)
#pragma unroll
        for (int b = 0; b < 2; ++b)
#pragma unroll
            for (int m = 0; m < 4; ++m)
#pragma unroll
                for (int n = 0; n < 2; ++n) acc[a][b][m][n] = (f32x4){0.f, 0.f, 0.f, 0.f};
    bf16x8 At[4][2], B0[2][2], B1[2][2];
    const char* cA = (const char*)g.A + (size_t)cur.pm * tstep; const char* cB = (const char*)g.Bt + (size_t)cur.pn * tstep;
    S.a_ready(cur);
    if constexpr (SP2) {
        PG8_STAGE(PG8_SB(0, 0), cB, voffB); PG8_STAGE(PG8_SB(0, 1), cB + hstep, voffB); PG8_STAGE(PG8_SA(0, 0), cA, voffA); PG8_STAGE(PG8_SA(0, 1), cA + hstep, voffA);
        if (wr == 1) PG8_BAR;
        PG8_WAIT_V(2); PG8_BAR;
        PG8_STAGE(PG8_SB(1, 0), cB + kstep, voffB); PG8_STAGE(PG8_SA(1, 0), cA + kstep, voffA); PG8_STAGE(PG8_SB(1, 1), cB + hstep + kstep, voffB);
        PG8_WAIT_V(6); PG8_BAR;
    } else {
        PG8_STAGE(PG8_SB(0, 0), cB, voffB); PG8_STAGE(PG8_SA(0, 0), cA, voffA); PG8_STAGE(PG8_SB(0, 1), cB + hstep, voffB); PG8_STAGE(PG8_SA(0, 1), cA + hstep, voffA);
        if (wr == 1) PG8_BAR;
        PG8_WAIT_V(4); PG8_BAR;
        PG8_STAGE(PG8_SB(1, 0), cB + kstep, voffB); PG8_STAGE(PG8_SA(1, 0), cA + kstep, voffA); PG8_STAGE(PG8_SB(1, 1), cB + hstep + kstep, voffB);
        PG8_WAIT_V(6); PG8_BAR;
    }
    for (;;) {
        const bool has_next = S.next(ui + 1, nxt);
        const char* nA = has_next ? (const char*)g.A + (size_t)nxt.pm * tstep : cA; const char* nB = has_next ? (const char*)g.Bt + (size_t)nxt.pn * tstep : cB;
        for (int t = 0; t < nt; t += 2) {
            const bool last = (t == nt - 2);
            const char* a1 = cA + (size_t)(t + 1) * kstep;
            const char* a2 = last ? nA : cA + (size_t)(t + 2) * kstep; const char* b2 = last ? nB : cB + (size_t)(t + 2) * kstep;
            const char* a3 = a2 + kstep; const char* b3 = b2 + kstep;
            if (last && has_next) S.a_ready(nxt);
            if constexpr (SP2) {
            PG8_LDB(B0, 0, 0); PG8_LDB(B1, 0, 1); PG8_SCHED; PG8_LDA(At, 0, 0); PG8_STAGE(PG8_SA(1, 1), a1 + hstep, voffA);
            PG8_WAIT_V(8); PG8_WAIT_L(0); PG8_BAR; PG8_MMA(0, 0, At, B0); PG8_MMA(0, 1, At, B1); PG8_BAR; PG8_SCHED;
            PG8_LDA(At, 0, 1); PG8_STAGE(PG8_SB(0, 0), b2, voffB); PG8_STAGE(PG8_SB(0, 1), b2 + hstep, voffB); PG8_STAGE(PG8_SA(0, 0), a2, voffA);
            PG8_WAIT_V(8); PG8_WAIT_L(0); PG8_BAR; PG8_MMA(1, 0, At, B0); PG8_MMA(1, 1, At, B1); PG8_BAR; PG8_SCHED;
            PG8_LDB(B0, 1, 0); PG8_LDB(B1, 1, 1); PG8_SCHED; PG8_LDA(At, 1, 0); PG8_STAGE(PG8_SA(0, 1), a2 + hstep, voffA);
            PG8_WAIT_V(8); PG8_WAIT_L(0); PG8_BAR; PG8_MMA(0, 0, At, B0); PG8_MMA(0, 1, At, B1); PG8_BAR; PG8_SCHED;
            PG8_LDA(At, 1, 1); PG8_STAGE(PG8_SB(1, 0), b3, voffB); PG8_STAGE(PG8_SB(1, 1), b3 + hstep, voffB); PG8_STAGE(PG8_SA(1, 0), a3, voffA);
            PG8_WAIT_V(8); PG8_WAIT_L(0); PG8_BAR; PG8_MMA(1, 0, At, B0); PG8_MMA(1, 1, At, B1); PG8_BAR; PG8_SCHED;
            } else {
            PG8_LDB(B0, 0, 0); PG8_SCHED; PG8_LDA(At, 0, 0); PG8_STAGE(PG8_SA(1, 1), a1 + hstep, voffA);
            PG8_WAIT_L(8); PG8_BAR; PG8_WAIT_L(0); PG8_MMA(0, 0, At, B0); PG8_BAR; PG8_SCHED;
            PG8_LDB(B1, 0, 1); PG8_STAGE(PG8_SB(0, 0), b2, voffB);
            PG8_BAR; PG8_WAIT_L(0); PG8_MMA(0, 1, At, B1); PG8_BAR;
            PG8_LDA(At, 0, 1); PG8_STAGE(PG8_SA(0, 0), a2, voffA);
            PG8_BAR; PG8_WAIT_L(0); PG8_MMA(1, 0, At, B0); PG8_BAR; PG8_SCHED;
            PG8_STAGE(PG8_SB(0, 1), b2 + hstep, voffB);
            PG8_WAIT_V(6); PG8_BAR; PG8_MMA(1, 1, At, B1); PG8_BAR;
            PG8_LDB(B0, 1, 0); PG8_SCHED; PG8_LDA(At, 1, 0); PG8_STAGE(PG8_SA(0, 1), a2 + hstep, voffA);
            PG8_WAIT_L(8); PG8_BAR; PG8_WAIT_L(0); PG8_MMA(0, 0, At, B0); PG8_BAR; PG8_SCHED;
            PG8_LDB(B1, 1, 1); PG8_STAGE(PG8_SB(1, 0), b3, voffB);
            PG8_BAR; PG8_WAIT_L(0); PG8_MMA(0, 1, At, B1); PG8_BAR;
            PG8_LDA(At, 1, 1); PG8_STAGE(PG8_SA(1, 0), a3, voffA);
            PG8_BAR; PG8_WAIT_L(0); PG8_MMA(1, 0, At, B0); PG8_BAR; PG8_SCHED;
            PG8_STAGE(PG8_SB(1, 1), b3 + hstep, voffB);
            PG8_WAIT_V(6); PG8_BAR; PG8_MMA(1, 1, At, B1); PG8_BAR;
            }
        }
        if constexpr (ALIGN_EPI) { if (wr == 0) PG8_BAR; }
        if constexpr (!Epi::AFTER_DRAIN) { E(acc, cur, wr, wc, fr, fq); S.done(cur); }
        if (!has_next) break;
#pragma unroll
        for (int a = 0; a < 2; ++a)
#pragma unroll
            for (int b = 0; b < 2; ++b)
#pragma unroll
                for (int m = 0; m < 4; ++m)
#pragma unroll
                    for (int n = 0; n < 2; ++n) acc[a][b][m][n] = (f32x4){0.f, 0.f, 0.f, 0.f};
        cur = nxt; cA = nA; cB = nB; ++ui;
        if constexpr (ALIGN_EPI) { if (wr == 1) PG8_BAR; }
    }
    PG8_WAIT_V(0);
    if constexpr (!ALIGN_EPI) { if (wr == 0) PG8_BAR; }
    PG8_BAR;
    if constexpr (Epi::AFTER_DRAIN) { E.fused(acc, cur, wr, wc, fr, fq, lds, wid, lane); S.done(cur); }
#undef PG8_SA
#undef PG8_SB
#undef PG8_STAGE
#undef PG8_LDA
#undef PG8_LDB
#undef PG8_MMA
#undef PG8_WAIT_V
#undef PG8_WAIT_L
#undef PG8_BAR
#undef PG8_SCHED
}
}


#define GAS __attribute__((address_space(1)))
#define LAS __attribute__((address_space(3)))
typedef unsigned short bf16;
typedef unsigned v4u __attribute__((ext_vector_type(4)));
typedef unsigned v2u __attribute__((ext_vector_type(2)));
typedef float f32x4 __attribute__((ext_vector_type(4)));
typedef float f32x2 __attribute__((ext_vector_type(2)));
#define RLX_AGENT __ATOMIC_RELAXED, __HIP_MEMORY_SCOPE_AGENT
#define LDS_WAIT() asm volatile("s_waitcnt lgkmcnt(0)" ::: "memory")
#define VM_WAIT() asm volatile("s_waitcnt vmcnt(0)" ::: "memory")

constexpr int NWAVES = 8, NTHREADS = 512;
#ifndef MK_N_LAUNCHES
#define MK_N_LAUNCHES 1
#endif
constexpr int D = 4096, BATCH = 2, SEQ = 4096, M = BATCH * SEQ;
constexpr int RW = 2048, CW = 2048, NH = 32, HD = 64;
constexpr int RWKV_IN = 6592, IN_TOTAL = 12736, NWIN = 12800, NPROJ = 12288;
constexpr int COL_R = 0, COL_K = 2048, COL_V = 4096, COL_CB = 6144, COL_CC = 8192, COL_CH = 10240;
constexpr int SRC_WL = 6144, NLIN = 448, KSPLIT = 4, SLABW = 512;
constexpr int KLORA = 512, NLORA = 6144;
constexpr int PH = 8, NKEYS = 128, NEXP = 16384, PQ = 256, TOPK = 16;
constexpr int NPHASES = 12;

constexpr size_t MiB = 1u << 20;
constexpr size_t WS_CTL = 0, CTL_ZERO_BYTES = 64 * 1024;
constexpr size_t WS_SSQ = 1 * MiB;
constexpr size_t WS_DSCALE = WS_SSQ + 64 * 1024;
constexpr size_t WS_USCALE = WS_DSCALE + 64 * 1024;
constexpr size_t WS_BONUS = 2 * MiB;
constexpr size_t WS_WLORA = 4 * MiB;
constexpr size_t WS_WQT = 10 * MiB;
constexpr size_t WS_WOUTT = 26 * MiB;
constexpr size_t WS_WINT = 58 * MiB;
constexpr size_t WS_XN = 158 * MiB;
constexpr size_t WS_PROJ = 222 * MiB;
constexpr size_t WS_LIN = 422 * MiB;
constexpr size_t WS_WD = 430 * MiB;
constexpr size_t WS_AA = 494 * MiB;
constexpr size_t WS_G = 526 * MiB;
constexpr size_t WS_R = 558 * MiB, WS_K = 590 * MiB, WS_KK = 622 * MiB, WS_BB = 654 * MiB;
constexpr size_t WS_REC = 558 * MiB;
constexpr size_t WS_V = 750 * MiB;
constexpr size_t WS_SLAB = 718 * MiB;
constexpr size_t WS_Y = WS_WD;
constexpr size_t WS_MIXED = 782 * MiB;
constexpr size_t WS_Q = 846 * MiB;
constexpr size_t WS_EIDX = 878 * MiB;
constexpr size_t WS_GATE = 882 * MiB;
constexpr size_t WS_DQ = 886 * MiB;
constexpr size_t WS_UQ = 950 * MiB;
constexpr size_t WS_SKB = 1016 * MiB;
constexpr size_t WS_BR = 1014 * MiB, WS_KR = 1015 * MiB;
constexpr size_t WS_END = 1017 * MiB;

constexpr int CW_BAR = 1024;

constexpr int RING_OFF = 0, RING_BYTES = 131072;
constexpr int LDSCTL_OFF = 147456, MISC_OFF = LDSCTL_OFF + 64;
constexpr int LDS_BYTES = 147456 + 512;

__device__ __forceinline__ unsigned f2bf(float f) { unsigned u = __builtin_bit_cast(unsigned, f); return (u + 0x7fffu + ((u >> 16) & 1u)) >> 16; }
typedef __bf16 bf16x2v __attribute__((ext_vector_type(2)));
__device__ __forceinline__ unsigned pk2(float lo, float hi) { const bf16x2v r = __builtin_convertvector((f32x2){lo, hi}, bf16x2v); return __builtin_bit_cast(unsigned, r); }
__device__ __forceinline__ float bflo(unsigned w) { return __builtin_bit_cast(float, w << 16); }
__device__ __forceinline__ float bfhi(unsigned w) { return __builtin_bit_cast(float, w & 0xffff0000u); }
__device__ __forceinline__ float wave_sum(float v) {
#pragma unroll
    for (int o = 1; o < 64; o <<= 1) v += __shfl_xor(v, o);
    return v;
}
__device__ __forceinline__ float wave_max(float v) {
#pragma unroll
    for (int o = 1; o < 64; o <<= 1) v = fmaxf(v, __shfl_xor(v, o));
    return v;
}
__device__ __forceinline__ float sigmoidf_(float v) { return 1.0f / (1.0f + __expf(-v)); }

#define XB_TMO      128
#define XB_XCNT(j)  (256  + 64 * (j))
#define XB_XSUB(j)  (1280 + 64 * (j))
#define XB_XGEN(j)  (2304 + 64 * (j))
#define XB_TOP      3328
#define XB_TOPGEN   3392
#define XCD_BAR_WORDS 3456
#define XB_SPIN_CAP (1u << 22)
__device__ __forceinline__ unsigned xb_ld(unsigned* p)              { return __hip_atomic_load(p, __ATOMIC_RELAXED, __HIP_MEMORY_SCOPE_AGENT); }
__device__ __forceinline__ unsigned xb_add(unsigned* p, unsigned v) { return __hip_atomic_fetch_add(p, v, __ATOMIC_RELAXED, __HIP_MEMORY_SCOPE_AGENT); }
__device__ __forceinline__ unsigned xb_xcc_id() { return (unsigned)__builtin_amdgcn_s_getreg((3 << 11) | 20) & 0xFu; }
#define XB_SPIN(cond, bar) do { unsigned _sp = 0; while (cond) { __builtin_amdgcn_s_sleep(1); \
    if ((++_sp & 255u) == 0u) { if (xb_ld(&(bar)[XB_TMO])) break; if (_sp > XB_SPIN_CAP) { atomicAdd(&(bar)[XB_TMO], 1u); break; } } } } while (0)
struct XcdBarrier { unsigned* bar; unsigned x; volatile LAS unsigned* st; };
__device__ __forceinline__ XcdBarrier xcd_barrier_post(unsigned* bar, volatile LAS unsigned* st) {
    XcdBarrier b; b.bar = bar; b.x = xb_xcc_id(); b.st = st;
    if (threadIdx.x == 0) (void)xb_add(&bar[XB_XCNT(b.x)], 1u);
    return b;
}
__device__ __forceinline__ void xcd_barrier_complete(unsigned* bar, unsigned x, unsigned& nloc, unsigned& nx) {
    const unsigned G = gridDim.x * gridDim.y * gridDim.z;
    unsigned sum, cnt, mine, sp = 0u;
    for (;;) {
        sum = 0u; cnt = 0u; mine = 0u;
#pragma unroll
        for (unsigned j = 0; j < 16; ++j) { const unsigned c = xb_ld(&bar[XB_XCNT(j)]); sum += c; cnt += (c > 0u) ? 1u : 0u; mine = (j == x) ? c : mine; }
        if (sum == G) break;
        __builtin_amdgcn_s_sleep(1);
        if ((++sp & 255u) == 0u) { if (xb_ld(&bar[XB_TMO])) break; if (sp > XB_SPIN_CAP) { atomicAdd(&bar[XB_TMO], 1u); break; } }
    }
    nloc = mine > 0u ? mine : 1u; nx = cnt > 0u ? cnt : 1u;
}
__device__ __forceinline__ void xcd_barrier(const XcdBarrier& b) {
    asm volatile("s_waitcnt vmcnt(0)" ::: "memory");
    __syncthreads();
    if (threadIdx.x == 0) {
        unsigned* bar = b.bar;
        __builtin_amdgcn_s_waitcnt(0);
        unsigned nloc = b.st[0], nx = b.st[1];
        if (nloc == 0u) { xcd_barrier_complete(bar, b.x, nloc, nx); b.st[0] = nloc; b.st[1] = nx; }
        const unsigned old = xb_add(&bar[XB_XSUB(b.x)], 1u);
        const unsigned gen = old / nloc;
        if (old + 1u == (gen + 1u) * nloc) {
            __builtin_amdgcn_fence(__ATOMIC_RELEASE, "agent");
            asm volatile("s_waitcnt vmcnt(0)" ::: "memory");
            const unsigned og = xb_add(&bar[XB_TOP], 1u);
            const unsigned tg = og / nx;
            if (og + 1u == (tg + 1u) * nx) xb_add(&bar[XB_TOPGEN], 1u);
            else XB_SPIN(xb_ld(&bar[XB_TOPGEN]) == tg, bar);
            __builtin_amdgcn_fence(__ATOMIC_ACQUIRE, "agent");
            xb_add(&bar[XB_XGEN(b.x)], 1u);
            asm volatile("s_waitcnt vmcnt(0)" ::: "memory");
        } else {
            XB_SPIN(xb_ld(&bar[XB_XGEN(b.x)]) == gen, bar);
            __builtin_amdgcn_fence(__ATOMIC_ACQUIRE, "agent");
            asm volatile("s_waitcnt vmcnt(0)" ::: "memory");
        }
    }
    __syncthreads();
}

struct Args {
    const float* in[22]; float* out; unsigned char* ws; int ph_lo, ph_hi, li, pad;
};

template <bool WIN> __device__ __forceinline__ void p0_transpose_item(const float* W, int K, int N, bf16* WT, LAS float* scr, int item, int lane) {
    const int nblk = N / 32, kb = item / nblk, nb = item % nblk, k0 = 64 * kb, n0 = 32 * nb;
    const int d0 = !WIN ? n0 : (n0 < SRC_WL ? n0 : (n0 < RWKV_IN ? NPROJ + (n0 - SRC_WL) : n0 - NLIN));
#pragma unroll 8
    for (int i = 0; i < 32; ++i) { const int kk = 2 * i + (lane >> 5); scr[kk * 33 + (lane & 31)] = W[(size_t)(k0 + kk) * N + n0 + (lane & 31)]; }
    LDS_WAIT(); asm volatile("" ::: "memory");
    const int c = lane & 7;
#pragma unroll
    for (int j = 0; j < 4; ++j) { const int n = (lane >> 3) + 8 * j; const LAS float* s = scr + (8 * c) * 33 + n;
        v4u o; o.x = pk2(s[0 * 33], s[1 * 33]); o.y = pk2(s[2 * 33], s[3 * 33]); o.z = pk2(s[4 * 33], s[5 * 33]); o.w = pk2(s[6 * 33], s[7 * 33]);
        *(GAS v4u*)(WT + (size_t)(d0 + n) * K + k0 + 8 * c) = o; }
    LDS_WAIT(); asm volatile("" ::: "memory");
}

#ifndef PEER_FP6
#define PEER_FP6 1
#endif
#ifndef PEER_UP_FP4
#define PEER_UP_FP4 1
#endif
constexpr int ROWB = PEER_FP6 ? 3072 : 4096;
#ifndef PEER_DN_FP4
#define PEER_DN_FP4 1
#endif
constexpr int ROWB_DN = PEER_DN_FP4 ? 2048 : ROWB;
constexpr int ROWB_UP = PEER_UP_FP4 ? 2048 : ROWB;
typedef float f32x16v __attribute__((ext_vector_type(16)));
typedef float f32x32v __attribute__((ext_vector_type(32)));
typedef unsigned v6u __attribute__((ext_vector_type(6)));
__device__ __forceinline__ void quant_pack_store(const f32x4 (&v)[16], float am, unsigned char* dst, float* scp, int lane, bool fp4 = false) {
    if ((PEER_UP_FP4 || PEER_DN_FP4) && fp4) {
        const float s4 = am > 0.f ? 6.0f / am : 1.0f;
        if (lane == 0) *scp = am > 0.f ? am * (1.0f / 6.0f) : 1.0f;
        unsigned d4[8];
#pragma unroll
        for (int w = 0; w < 8; ++w) { unsigned p = 0u;
#define FP4_PK(b2) { const int t0 = 8 * w + 2 * (b2); p = (unsigned)__builtin_amdgcn_cvt_scalef32_pk_fp4_f32(p, v[t0 >> 2][t0 & 3] * s4, v[(t0 + 1) >> 2][(t0 + 1) & 3] * s4, 1.0f, b2); }
            FP4_PK(0) FP4_PK(1) FP4_PK(2) FP4_PK(3)
#undef FP4_PK
            d4[w] = p; }
        *(GAS v4u*)(dst + lane * 16) = (v4u){d4[0], d4[1], d4[2], d4[3]}; *(GAS v4u*)(dst + 1024 + lane * 16) = (v4u){d4[4], d4[5], d4[6], d4[7]};
        return;
    }
    constexpr float QMAX = PEER_FP6 ? 7.5f : 448.0f;
    const float s = am > 0.f ? QMAX / am : 1.0f;
    if (lane == 0) *scp = am > 0.f ? am * (1.0f / QMAX) : 1.0f;
#if PEER_FP6
    unsigned d[12];
#pragma unroll
    for (int g = 0; g < 2; ++g) { f32x16v x0, x1;
#pragma unroll
        for (int i = 0; i < 16; ++i) { const int t0 = 32 * g + 2 * i, t1 = t0 + 1;
            x0[i] = v[t0 >> 2][t0 & 3] * s; x1[i] = v[t1 >> 2][t1 & 3] * s; }
        const v6u pk = __builtin_amdgcn_cvt_scalef32_2xpk16_fp6_f32(x0, x1, 1.0f);
#pragma unroll
        for (int k = 0; k < 6; ++k) d[g * 6 + k] = pk[k]; }
#pragma unroll
    for (int c = 0; c < 3; ++c) *(GAS v4u*)(dst + c * 1024 + lane * 16) = (v4u){d[4 * c], d[4 * c + 1], d[4 * c + 2], d[4 * c + 3]};
#else
#pragma unroll
    for (int i = 0; i < 4; ++i) { v4u o;
#pragma unroll
        for (int j = 0; j < 4; ++j) { const f32x4 x = v[i * 4 + j] * s; int p = __builtin_amdgcn_cvt_pk_fp8_f32(x.x, x.y, 0, false); p = __builtin_amdgcn_cvt_pk_fp8_f32(x.z, x.w, p, true); o[j] = (unsigned)p; }
        *(GAS v4u*)(dst + i * 1024 + lane * 16) = o; }
#endif
}
__device__ __forceinline__ void load_qrow(const unsigned char* rp  , float (&e)[64]) {
#if PEER_FP6
    const v4u c0 = *(const GAS v4u*)(rp), c1 = *(const GAS v4u*)(rp + 1024), c2 = *(const GAS v4u*)(rp + 2048);
    const v6u pa = (v6u){c0.x, c0.y, c0.z, c0.w, c1.x, c1.y}, pb = (v6u){c1.z, c1.w, c2.x, c2.y, c2.z, c2.w};
    const f32x32v ra = __builtin_amdgcn_cvt_scalef32_pk32_f32_fp6(pa, 1.0f), rb = __builtin_amdgcn_cvt_scalef32_pk32_f32_fp6(pb, 1.0f);
#pragma unroll
    for (int k = 0; k < 32; ++k) { e[k] = ra[k]; e[32 + k] = rb[k]; }
#else
#pragma unroll
    for (int i = 0; i < 4; ++i) { const v4u w = *(const GAS v4u*)(rp + i * 1024);
#pragma unroll
        for (int j = 0; j < 4; ++j) { const f32x2 lo = __builtin_amdgcn_cvt_pk_f32_fp8(w[j], false), hi = __builtin_amdgcn_cvt_pk_f32_fp8(w[j], true);
            e[i * 16 + j * 4 + 0] = lo.x; e[i * 16 + j * 4 + 1] = lo.y; e[i * 16 + j * 4 + 2] = hi.x; e[i * 16 + j * 4 + 3] = hi.y; } }
#endif
}
__device__ __forceinline__ void p0_quant_row(const float* src, unsigned char* dst, float* sc, int lane, bool fp4 = false) {
    f32x4 v[16]; float am = 0.f;
#pragma unroll
    for (int i = 0; i < 4; ++i)
#pragma unroll
        for (int j = 0; j < 4; ++j) { v[i * 4 + j] = *(const GAS f32x4*)(src + (i * 4 + j) * 256 + lane * 4);
            am = fmaxf(am, fmaxf(fmaxf(fabsf(v[i * 4 + j].x), fabsf(v[i * 4 + j].y)), fmaxf(fabsf(v[i * 4 + j].z), fabsf(v[i * 4 + j].w)))); }
    am = wave_max(am);
    quant_pack_store(v, am, dst, sc, lane, fp4);
}

__device__ __forceinline__ void quant_rows(const Args& a, int first, int stride, int lane) {
    unsigned char* ws = a.ws;
    f32x4 cur[16], nxt[16];
    auto srcp = [&](int r) { return r < NEXP ? a.in[19] + (size_t)r * D : a.in[20] + (size_t)(r - NEXP) * D; };
    if (first < 2 * NEXP) { const float* p = srcp(first);
#pragma unroll
        for (int k = 0; k < 16; ++k) cur[k] = *(const GAS f32x4*)(p + k * 256 + lane * 4); }
    for (int r = first; r < 2 * NEXP; r += stride) {
        const int rn = r + stride;
        if (rn < 2 * NEXP) { const float* p = srcp(rn);
#pragma unroll
            for (int k = 0; k < 16; ++k) nxt[k] = *(const GAS f32x4*)(p + k * 256 + lane * 4); }
        float am = 0.f;
#pragma unroll
        for (int k = 0; k < 16; ++k) am = fmaxf(am, fmaxf(fmaxf(fabsf(cur[k].x), fabsf(cur[k].y)), fmaxf(fabsf(cur[k].z), fabsf(cur[k].w))));
        am = wave_max(am);
        if (r < NEXP) quant_pack_store(cur, am, ws + WS_DQ + (size_t)r * ROWB_DN, (float*)(ws + WS_DSCALE) + r, lane, PEER_DN_FP4 != 0);
        else quant_pack_store(cur, am, ws + WS_UQ + (size_t)(r - NEXP) * ROWB_UP, (float*)(ws + WS_USCALE) + (r - NEXP), lane, true);
#pragma unroll
        for (int k = 0; k < 16; ++k) cur[k] = nxt[k];
    }
}

#ifndef QUANT_IN_SCAN
#define QUANT_IN_SCAN 1
#endif
__device__ __forceinline__ void phase0(const Args& a, LAS unsigned char* lds, int gw, int NGW, int wave, int lane) {
    unsigned char* ws = a.ws;
    LAS float* scr = (LAS float*)(lds + RING_OFF + wave * 16384);
    constexpr int I_IN = (D / 64) * (IN_TOTAL / 32), I_OUT = (D / 64) * (D / 32), I_Q = (D / 64) * (2048 / 32);
    for (int it = gw; it < I_IN + I_OUT + I_Q; it += NGW) {
        int r = it;
        if (r < I_IN) { p0_transpose_item<true>(a.in[2], D, IN_TOTAL, (bf16*)(ws + WS_WINT), scr, r, lane); continue; } r -= I_IN;
        if (r < I_OUT) { p0_transpose_item<false>(a.in[15], D, D, (bf16*)(ws + WS_WOUTT), scr, r, lane); continue; } r -= I_OUT;
        p0_transpose_item<false>(a.in[17], D, 2048, (bf16*)(ws + WS_WQT), scr, r, lane);
    }
    const int gt = gw * 64 + lane, NGT = NGW * 64;
    { GAS v4u* p = (GAS v4u*)(ws + WS_WINT + (size_t)IN_TOTAL * D * 2);
      for (int i = gt; i < (NWIN - IN_TOTAL) * D * 2 / 16; i += NGT) p[i] = (v4u){0u, 0u, 0u, 0u}; }
    { const float* sk = a.in[18]; bf16* SKB = (bf16*)(ws + WS_SKB);
      for (int i = gt; i < PH * 2 * NKEYS * 128 / 8; i += NGT) { const f32x4 v0 = *(const GAS f32x4*)(sk + (size_t)i * 8), v1 = *(const GAS f32x4*)(sk + (size_t)i * 8 + 4);
          v4u o; o.x = pk2(v0.x, v0.y); o.y = pk2(v0.z, v0.w); o.z = pk2(v1.x, v1.y); o.w = pk2(v1.z, v1.w); *(GAS v4u*)(SKB + (size_t)i * 8) = o; } }
    { float* p = (float*)(ws + WS_SSQ); for (int i = gt; i < M; i += NGT) p[i] = 0.f; }
    { bf16* WL = (bf16*)(ws + WS_WLORA); const float* w2 = a.in[5]; const float* a2 = a.in[7]; const float* g2 = a.in[8];
      for (int it = gw; it < (KLORA / 64) * (NLORA / 32); it += NGW) {
          const int kb = it / (NLORA / 32), nb = it % (NLORA / 32), k0 = 64 * kb, n0 = 32 * nb, kind = n0 >> 11, cb = (n0 & 2047) + (lane & 31);
          const float* srcw = kind == 0 ? w2 : (kind == 1 ? a2 : g2); const int klo = kind == 0 ? 0 : (kind == 1 ? 96 : 192), khi = kind == 0 ? 96 : (kind == 1 ? 192 : 448);
#pragma unroll 8
          for (int i = 0; i < 32; ++i) { const int kk = 2 * i + (lane >> 5), k = k0 + kk; scr[kk * 33 + (lane & 31)] = (k >= klo && k < khi) ? srcw[(size_t)(k - klo) * 2048 + cb] : 0.f; }
          LDS_WAIT(); asm volatile("" ::: "memory");
          const int c = lane & 7;
#pragma unroll
          for (int j = 0; j < 4; ++j) { const int n = (lane >> 3) + 8 * j; const LAS float* s = scr + (8 * c) * 33 + n;
              v4u o; o.x = pk2(s[0 * 33], s[1 * 33]); o.y = pk2(s[2 * 33], s[3 * 33]); o.z = pk2(s[4 * 33], s[5 * 33]); o.w = pk2(s[6 * 33], s[7 * 33]);
              *(GAS v4u*)(WL + (size_t)(n0 + n) * KLORA + k0 + 8 * c) = o; }
          LDS_WAIT(); asm volatile("" ::: "memory");
      } }
    { const float* x = a.in[0]; const float* nw = a.in[1]; bf16* XN = (bf16*)(ws + WS_XN);
      for (int m = gw; m < M; m += NGW) {
          f32x4 v[16]; float s = 0.f;
#pragma unroll
          for (int c = 0; c < 8; ++c)
#pragma unroll
              for (int j = 0; j < 2; ++j) { const f32x4 t = *(const GAS f32x4*)(x + (size_t)m * D + c * 512 + lane * 8 + j * 4); v[c * 2 + j] = t; s += (t.x * t.x + t.y * t.y) + (t.z * t.z + t.w * t.w); }
          const float rs = 1.0f / sqrtf(wave_sum(s) * (1.0f / D) + 1e-6f);
#pragma unroll
          for (int c = 0; c < 8; ++c) { const f32x4 w0 = *(const GAS f32x4*)(nw + c * 512 + lane * 8), w1 = *(const GAS f32x4*)(nw + c * 512 + lane * 8 + 4);
              const f32x4 p = v[c * 2] * rs * w0, q = v[c * 2 + 1] * rs * w1;
              v4u o; o.x = pk2(p.x, p.y); o.y = pk2(p.z, p.w); o.z = pk2(q.x, q.y); o.w = pk2(q.z, q.w);
              *(GAS v4u*)(XN + (size_t)m * D + c * 512 + lane * 8) = o; }
      } }
    if (!QUANT_IN_SCAN) { const float* ed = a.in[19]; const float* eu = a.in[20];
      for (int r = gw; r < 2 * NEXP; r += NGW) {
          if (r < NEXP) p0_quant_row(ed + (size_t)r * D, ws + WS_DQ + (size_t)r * ROWB_DN, (float*)(ws + WS_DSCALE) + r, lane, PEER_DN_FP4 != 0);
          else { const int e = r - NEXP; p0_quant_row(eu + (size_t)e * D, ws + WS_UQ + (size_t)e * ROWB_UP, (float*)(ws + WS_USCALE) + e, lane, true); } } }
}

__device__ __forceinline__ void unpack8(const v4u w, float (&f)[8]) {
    f[0] = bflo(w.x); f[1] = bfhi(w.x); f[2] = bflo(w.y); f[3] = bfhi(w.y); f[4] = bflo(w.z); f[5] = bfhi(w.z); f[6] = bflo(w.w); f[7] = bfhi(w.w);
}
__device__ __forceinline__ v4u pack8(const float (&f)[8]) { v4u o; o.x = pk2(f[0], f[1]); o.y = pk2(f[2], f[3]); o.z = pk2(f[4], f[5]); o.w = pk2(f[6], f[7]); return o; }

__device__ __forceinline__ void phase2(const Args& a, int gt, int NGT) {
    unsigned char* ws = a.ws;
    const bf16* P = (const bf16*)(ws + WS_PROJ); const float* mu = a.in[3]; const float* cw = a.in[14];
    bf16* LIN = (bf16*)(ws + WS_LIN); bf16* MIX = (bf16*)(ws + WS_MIXED);
    const v4u z4 = (v4u){0u, 0u, 0u, 0u};
    const float* SL = (const float*)(ws + WS_SLAB);
    for (int it = gt; it < M * 64; it += NGT) {
        const int m = it >> 6, j0 = (it & 63) * 8, t = m & (SEQ - 1);
        v4u o = z4;
        if (j0 < NLIN) {
            f32x4 p0 = (f32x4){0.f, 0.f, 0.f, 0.f}, p1 = p0, q0 = p0, q1 = p0;
#pragma unroll
            for (int ks = 0; ks < KSPLIT; ++ks) { const float* sp = SL + ((size_t)ks * M + m) * SLABW + j0;
                p0 += *(const GAS f32x4*)(sp); p1 += *(const GAS f32x4*)(sp + 4);
                if (t > 0) { q0 += *(const GAS f32x4*)(sp - SLABW); q1 += *(const GAS f32x4*)(sp - SLABW + 4); } }
            const f32x4 m0 = *(const GAS f32x4*)(mu + SRC_WL + j0), m1 = *(const GAS f32x4*)(mu + SRC_WL + j0 + 4);
            float r[8];
#pragma unroll
            for (int j = 0; j < 8; ++j) { const float p = j < 4 ? p0[j] : p1[j - 4], q = j < 4 ? q0[j] : q1[j - 4], mm = j < 4 ? m0[j] : m1[j - 4]; const float ps = p + (q - p) * mm;
                r[j] = j0 < 96 ? tanhf(ps) : (j0 < 192 ? ps : sigmoidf_(ps)); }
            o = pack8(r);
        }
        *(GAS v4u*)(LIN + (size_t)m * KLORA + j0) = o;
    }
    for (int it = gt; it < M * 256; it += NGT) {
        const int m = it >> 8, c0 = (it & 255) * 8, t = m & (SEQ - 1);
        const bf16* row = P + (size_t)m * NPROJ;
        float bg[8], c_[8], h_[8], z0[8], z1[8], z2[8], y[8];
        unpack8(*(const GAS v4u*)(row + COL_CB + c0), bg); unpack8(*(const GAS v4u*)(row + COL_CC + c0), c_); unpack8(*(const GAS v4u*)(row + COL_CH + c0), h_);
#pragma unroll
        for (int j = 0; j < 8; ++j) z0[j] = c_[j] * h_[j];
        if (t >= 1) { unpack8(*(const GAS v4u*)(row - NPROJ + COL_CC + c0), c_); unpack8(*(const GAS v4u*)(row - NPROJ + COL_CH + c0), h_);
#pragma unroll
            for (int j = 0; j < 8; ++j) z1[j] = c_[j] * h_[j]; }
        else {
#pragma unroll
            for (int j = 0; j < 8; ++j) z1[j] = 0.f; }
        if (t >= 2) { unpack8(*(const GAS v4u*)(row - 2 * NPROJ + COL_CC + c0), c_); unpack8(*(const GAS v4u*)(row - 2 * NPROJ + COL_CH + c0), h_);
#pragma unroll
            for (int j = 0; j < 8; ++j) z2[j] = c_[j] * h_[j]; }
        else {
#pragma unroll
            for (int j = 0; j < 8; ++j) z2[j] = 0.f; }
        const float* cwp = cw + c0 * 3;
#pragma unroll
        for (int j = 0; j < 8; ++j) y[j] = bg[j] * (cwp[j * 3 + 0] * z2[j] + cwp[j * 3 + 1] * z1[j] + cwp[j * 3 + 2] * z0[j]);
        *(GAS v4u*)(MIX + (size_t)m * D + RW + c0) = pack8(y);
    }
}

__device__ __forceinline__ void phase4(const Args& a, int gw, int NGW, int lane) {
    unsigned char* ws = a.ws;
    const bf16* P = (const bf16*)(ws + WS_PROJ); const float* mu = a.in[3]; const bf16* AA = (const bf16*)(ws + WS_AA);
    const float* k_k = a.in[9]; const float* k_a = a.in[10]; const float* r_k = a.in[11];
    bf16* R = (bf16*)(ws + WS_R); bf16* K = (bf16*)(ws + WS_K); bf16* KK = (bf16*)(ws + WS_KK); bf16* BB = (bf16*)(ws + WS_BB); bf16* V = (bf16*)(ws + WS_V);
    float* BON = (float*)(ws + WS_BONUS);
    const v4u z4 = (v4u){0u, 0u, 0u, 0u};
    for (int it = gw; it < M * 4; it += NGW) {
        const int m = it >> 2, ch = (it & 3) * 512 + lane * 8, t = m & (SEQ - 1);
        const bf16* row = P + (size_t)m * NPROJ;
        float r[8], k[8], v[8], q[8], av[8];
        auto lerp8 = [&](int col, float (&o)[8]) {
            unpack8(*(const GAS v4u*)(row + col + ch), o); unpack8(t > 0 ? *(const GAS v4u*)(row - NPROJ + col + ch) : z4, q);
            const f32x4 m0 = *(const GAS f32x4*)(mu + col + ch), m1 = *(const GAS f32x4*)(mu + col + ch + 4);
#pragma unroll
            for (int j = 0; j < 8; ++j) o[j] = o[j] + (q[j] - o[j]) * (j < 4 ? m0[j] : m1[j - 4]);
        };
        lerp8(COL_R, r); lerp8(COL_K, k); lerp8(COL_V, v);
        unpack8(*(const GAS v4u*)(AA + (size_t)m * RW + ch), av);
        float kk[8], kp[8], bb[8]; float ss = 0.f, bn = 0.f, kr = 0.f, brs = 0.f;
        const f32x4 kk0 = *(const GAS f32x4*)(k_k + ch), kk1 = *(const GAS f32x4*)(k_k + ch + 4), ka0 = *(const GAS f32x4*)(k_a + ch), ka1 = *(const GAS f32x4*)(k_a + ch + 4);
        const f32x4 rk0 = *(const GAS f32x4*)(r_k + ch), rk1 = *(const GAS f32x4*)(r_k + ch + 4);
#pragma unroll
        for (int j = 0; j < 8; ++j) { kk[j] = k[j] * (j < 4 ? kk0[j] : kk1[j - 4]); ss += kk[j] * kk[j];
            kp[j] = k[j] * (1.0f + (av[j] - 1.0f) * (j < 4 ? ka0[j] : ka1[j - 4])); bn += r[j] * kp[j] * (j < 4 ? rk0[j] : rk1[j - 4]); kr += r[j] * kp[j]; }
        ss += __shfl_xor(ss, 1); ss += __shfl_xor(ss, 2); ss += __shfl_xor(ss, 4);
        bn += __shfl_xor(bn, 1); bn += __shfl_xor(bn, 2); bn += __shfl_xor(bn, 4);
        const float inv = 1.0f / sqrtf(fmaxf(ss, 1e-24f));
#pragma unroll
        for (int j = 0; j < 8; ++j) { kk[j] *= inv; bb[j] = kk[j] * av[j]; brs += bb[j] * r[j]; }
        brs += __shfl_xor(brs, 1); brs += __shfl_xor(brs, 2); brs += __shfl_xor(brs, 4);
        kr += __shfl_xor(kr, 1); kr += __shfl_xor(kr, 2); kr += __shfl_xor(kr, 4);
        const size_t o = (size_t)m * RW + ch;
        *(GAS v4u*)(R + o) = pack8(r); *(GAS v4u*)(K + o) = pack8(kp); *(GAS v4u*)(KK + o) = pack8(kk); *(GAS v4u*)(BB + o) = pack8(bb); *(GAS v4u*)(V + o) = pack8(v);
        if ((lane & 7) == 0) { BON[(size_t)m * NH + (ch >> 6)] = bn; ((float*)(ws + WS_BR))[(size_t)m * NH + (ch >> 6)] = brs; ((float*)(ws + WS_KR))[(size_t)m * NH + (ch >> 6)] = kr; }
    }
}

constexpr int TC = 32;
constexpr int SC_A = 0, SC_WR = TC * 256, SC_W = 2 * TC * 256, SC_B = 3 * TC * 256, SC_K = 4 * TC * 256, SC_V = 5 * TC * 256, SC_S = SC_V + TC * 64, SC_BYTES = SC_S + TC * 8;
__device__ __forceinline__ float dpp_f(float v, const int ctrl_sel) {
    const int x = __builtin_bit_cast(int, v); int r;
    if (ctrl_sel == 0) r = __builtin_amdgcn_update_dpp(0, x, 0xB1, 0xF, 0xF, true);
    else if (ctrl_sel == 1) r = __builtin_amdgcn_update_dpp(0, x, 0x4E, 0xF, 0xF, true);
    else if (ctrl_sel == 2) r = __builtin_amdgcn_update_dpp(0, x, 0x141, 0xF, 0xF, true);
    else r = __builtin_amdgcn_update_dpp(0, x, 0x140, 0xF, 0xF, true);
    return __builtin_bit_cast(float, r);
}
__device__ __forceinline__ void phase5(const Args& a, LAS unsigned char* lds, int tid) {
    unsigned char* ws = a.ws;
    const float* WD = (const float*)(ws + WS_WD);
    const bf16* R = (const bf16*)(ws + WS_R); const bf16* K = (const bf16*)(ws + WS_K); const bf16* KK = (const bf16*)(ws + WS_KK); const bf16* BB = (const bf16*)(ws + WS_BB); const bf16* V = (const bf16*)(ws + WS_V);
    const float* BRs = (const float*)(ws + WS_BR); const float* KRs = (const float*)(ws + WS_KR);
    float* Y = (float*)(ws + WS_Y);
    constexpr int NCH = SEQ / TC;
    const int qlane = tid & 63, NLW = gridDim.x * 4; int qnext = blockIdx.x * 4 + ((tid >> 6) & 3), qrow = 2 * NEXP;
    for (int item = blockIdx.x; item < 256; item += gridDim.x) {
        const int bh = item >> 2, rg = item & 3, b = bh >> 5, h = bh & 31;
        const size_t base = (size_t)b * SEQ * RW + h * 64;
        __syncthreads();
        if (tid >= 256) {
            const int lt = tid - 256, st = lt >> 3, c8 = (lt & 7) * 8;
            f32x4 w0, w1; v4u xkk, xbb, xk, xr; unsigned xv; float sbr = 0.f, skr = 0.f;
            auto gload = [&](int c) {
                const size_t o = base + (size_t)(c * TC + st) * RW + c8;
                w0 = *(const GAS f32x4*)(WD + o); w1 = *(const GAS f32x4*)(WD + o + 4);
                xkk = *(const GAS v4u*)(KK + o); xbb = *(const GAS v4u*)(BB + o); xk = *(const GAS v4u*)(K + o); xr = *(const GAS v4u*)(R + o);
                xv = *(const GAS unsigned*)(V + base + (size_t)(c * TC + st) * RW + rg * 16 + (lt & 7) * 2);
                if (lt < TC) { const size_t mm = (size_t)b * SEQ + c * TC + lt; sbr = BRs[mm * NH + h]; skr = KRs[mm * NH + h]; }
            };
            f32x4 qv[16];
            auto quant_load = [&](int r) {
                const float* srcp = (r < NEXP ? a.in[19] + (size_t)r * D : a.in[20] + (size_t)(r - NEXP) * D);
#pragma unroll
                for (int i2 = 0; i2 < 4; ++i2)
#pragma unroll
                    for (int j = 0; j < 4; ++j) qv[i2 * 4 + j] = *(const GAS f32x4*)(srcp + (i2 * 4 + j) * 256 + qlane * 4);
            };
            auto quant_finish = [&](int r) {
                float am = 0.f;
#pragma unroll
                for (int k = 0; k < 16; ++k) am = fmaxf(am, fmaxf(fmaxf(fabsf(qv[k].x), fabsf(qv[k].y)), fmaxf(fabsf(qv[k].z), fabsf(qv[k].w))));
                am = wave_max(am);
                unsigned char* dst = (r < NEXP ? ws + WS_DQ + (size_t)r * ROWB_DN : ws + WS_UQ + (size_t)(r - NEXP) * ROWB_UP);
                float* scp = (r < NEXP ? (float*)(ws + WS_DSCALE) + r : (float*)(ws + WS_USCALE) + (r - NEXP));
                quant_pack_store(qv, am, dst, scp, qlane, r >= NEXP || PEER_DN_FP4 != 0);
            };
            auto lstore = [&](int buf) {
                LAS unsigned char* L = lds + buf * SC_BYTES; const int o = st * 256 + c8 * 4;
                float fk[8], fb[8], fkk[8], fr[8]; unpack8(xkk, fkk); unpack8(xbb, fb); unpack8(xk, fk); unpack8(xr, fr);
                *(LAS f32x4*)(L + SC_A + o) = (f32x4){-fkk[0], -fkk[1], -fkk[2], -fkk[3]}; *(LAS f32x4*)(L + SC_A + o + 16) = (f32x4){-fkk[4], -fkk[5], -fkk[6], -fkk[7]};
                *(LAS f32x4*)(L + SC_WR + o) = (f32x4){w0.x * fr[0], w0.y * fr[1], w0.z * fr[2], w0.w * fr[3]}; *(LAS f32x4*)(L + SC_WR + o + 16) = (f32x4){w1.x * fr[4], w1.y * fr[5], w1.z * fr[6], w1.w * fr[7]};
                *(LAS f32x4*)(L + SC_W + o) = w0; *(LAS f32x4*)(L + SC_W + o + 16) = w1;
                *(LAS f32x4*)(L + SC_B + o) = (f32x4){fb[0], fb[1], fb[2], fb[3]}; *(LAS f32x4*)(L + SC_B + o + 16) = (f32x4){fb[4], fb[5], fb[6], fb[7]};
                *(LAS f32x4*)(L + SC_K + o) = (f32x4){fk[0], fk[1], fk[2], fk[3]}; *(LAS f32x4*)(L + SC_K + o + 16) = (f32x4){fk[4], fk[5], fk[6], fk[7]};
                *(LAS f32x2*)(L + SC_V + st * 64 + (lt & 7) * 8) = (f32x2){bflo(xv), bfhi(xv)};
                if (lt < TC) *(LAS f32x2*)(L + SC_S + lt * 8) = (f32x2){sbr, skr};
            };
            gload(0); lstore(0);
            gload(1);
            __syncthreads();
            for (int c = 0; c < NCH; ++c) {
                if (c + 1 < NCH) lstore((c + 1) & 1);
                if (c + 2 < NCH) gload(c + 2);
                if (QUANT_IN_SCAN) {
                    const int ph = c & 3;
                    if (ph == 0) { qrow = qnext; qnext += NLW; if (qrow < 2 * NEXP) quant_load(qrow); }
                    else if (ph == 2) { if (qrow < 2 * NEXP) quant_finish(qrow); }
                }
                __syncthreads();
            }
        } else {
            const int i = tid >> 4, q = tid & 15;
            f32x2 s01 = (f32x2){0.f, 0.f}, s23 = (f32x2){0.f, 0.f};
            float* yp = Y + base + rg * 16 + i;
            float ykeep = 0.f;
            __builtin_amdgcn_s_setprio(3);
            __syncthreads();
            for (int c = 0; c < NCH; ++c) {
                const LAS unsigned char* L = lds + (c & 1) * SC_BYTES;
                f32x4 a4 = *(const LAS f32x4*)(L + SC_A + q * 16), wr4 = *(const LAS f32x4*)(L + SC_WR + q * 16), w4 = *(const LAS f32x4*)(L + SC_W + q * 16), b4 = *(const LAS f32x4*)(L + SC_B + q * 16), k4 = *(const LAS f32x4*)(L + SC_K + q * 16);
                float vi = *(const LAS float*)(L + SC_V + i * 4); f32x2 sc = *(const LAS f32x2*)(L + SC_S);
#pragma unroll
                for (int tt = 0; tt < TC; ++tt) {
                    const f32x4 ca = a4, cwr = wr4, cw = w4, cb = b4, ck = k4; const float cvi = vi; const f32x2 csc = sc;
                    if (tt + 1 < TC) {
                        a4 = *(const LAS f32x4*)(L + SC_A + (tt + 1) * 256 + q * 16); wr4 = *(const LAS f32x4*)(L + SC_WR + (tt + 1) * 256 + q * 16); w4 = *(const LAS f32x4*)(L + SC_W + (tt + 1) * 256 + q * 16);
                        b4 = *(const LAS f32x4*)(L + SC_B + (tt + 1) * 256 + q * 16); k4 = *(const LAS f32x4*)(L + SC_K + (tt + 1) * 256 + q * 16);
                        vi = *(const LAS float*)(L + SC_V + (tt + 1) * 64 + i * 4); sc = *(const LAS f32x2*)(L + SC_S + (tt + 1) * 8);
                    }
                    f32x2 da = s01 * (f32x2){ca.x, ca.y}; da = s23 * (f32x2){ca.z, ca.w} + da;
                    f32x2 dr = s01 * (f32x2){cwr.x, cwr.y}; dr = s23 * (f32x2){cwr.z, cwr.w} + dr;
                    float sa = da.x + da.y, yy = dr.x + dr.y;
                    const f32x2 vv = (f32x2){cvi, cvi};
                    const f32x2 t01 = s01 * (f32x2){cw.x, cw.y} + vv * (f32x2){ck.x, ck.y}, t23 = s23 * (f32x2){cw.z, cw.w} + vv * (f32x2){ck.z, ck.w};
                    sa += dpp_f(sa, 0); yy += dpp_f(yy, 0);
                    sa += dpp_f(sa, 1); yy += dpp_f(yy, 1);
                    sa += dpp_f(sa, 2); yy += dpp_f(yy, 2);
                    sa += dpp_f(sa, 3); yy += dpp_f(yy, 3);
                    const f32x2 ss = (f32x2){sa, sa};
                    s01 = ss * (f32x2){cb.x, cb.y} + t01; s23 = ss * (f32x2){cb.z, cb.w} + t23;
                    yy += sa * csc.x + cvi * csc.y;
                    ykeep = ((tt & 15) == q) ? yy : ykeep;
                    if ((tt & 15) == 15) yp[(size_t)(c * TC + (tt & 16) + q) * RW] = ykeep;
                }
                __syncthreads();
            }
            __builtin_amdgcn_s_setprio(0);
        }
    }
    if (QUANT_IN_SCAN && tid >= 256) {
        for (; qnext < 2 * NEXP; qnext += NLW) {
            const int r = qnext;
            if (r < NEXP) p0_quant_row(a.in[19] + (size_t)r * D, ws + WS_DQ + (size_t)r * ROWB_DN, (float*)(ws + WS_DSCALE) + r, qlane, PEER_DN_FP4 != 0);
            else p0_quant_row(a.in[20] + (size_t)(r - NEXP) * D, ws + WS_UQ + (size_t)(r - NEXP) * ROWB_UP, (float*)(ws + WS_USCALE) + (r - NEXP), qlane, true);
        }
    }
}

constexpr int CH = 32, NCHK = SEQ / CH;
constexpr int SUM_GT = 0, SUM_QT = 8192, SUM_HT = 12288, SUM_YL = 20480, SUM_BYTES = 24576;
constexpr int CW_BYTES = 18432;
constexpr int CA_OFF = 0, CB_OFF = 8704, CC_OFF = 13312;
constexpr int TMS = 144, CMS = 80;
typedef float f32x16c __attribute__((ext_vector_type(16)));
typedef short bf16x8c __attribute__((ext_vector_type(8)));
__device__ __forceinline__ bf16x8c cvt8(const f32x16c& x, const int base) {
    v4u w; w.x = pk2(x[base + 0], x[base + 1]); w.y = pk2(x[base + 2], x[base + 3]); w.z = pk2(x[base + 4], x[base + 5]); w.w = pk2(x[base + 6], x[base + 7]);
    return __builtin_bit_cast(bf16x8c, w);
}
__device__ __forceinline__ bf16x8c lds_nat(const LAS unsigned char* img, int row, int pitch, int ks, int hf) {
    return __builtin_bit_cast(bf16x8c, *(const LAS v4u*)(img + row * pitch + (16 * ks + 8 * hf) * 2));
}
__device__ __forceinline__ bf16x8c lds_sig(const LAS unsigned char* img, int row, int pitch, int ks, int hf) {
    const v2u lo = *(const LAS v2u*)(img + row * pitch + (16 * ks + 4 * hf) * 2), hi = *(const LAS v2u*)(img + row * pitch + (16 * ks + 8 + 4 * hf) * 2);
    return __builtin_bit_cast(bf16x8c, (v4u){lo.x, lo.y, hi.x, hi.y});
}
#define MFMA32(a, b, c) __builtin_amdgcn_mfma_f32_32x32x16_bf16((a), (b), (c), 0, 0, 0)

__device__ __forceinline__ void diag_add(f32x16c& x, int tl, int hf, float v) {
#pragma unroll
    for (int i = 0; i < 16; ++i) { const int r = (i & 3) + 8 * (i >> 2) + 4 * hf; x[i] += (r == tl) ? v : 0.f; }
}
__device__ __forceinline__ f32x16c xty(const f32x16c& X, const f32x16c& Y, f32x16c c) { c = MFMA32(cvt8(X, 0), cvt8(Y, 0), c); c = MFMA32(cvt8(X, 8), cvt8(Y, 8), c); return c; }
__device__ __forceinline__ void phase5a(const Args& a, LAS unsigned char* lds, int gw, int NGW, int wave, int lane_in) {
    unsigned char* ws = a.ws;
    const float* LWG = (const float*)(ws + WS_WD);
    const bf16* PRJ = (const bf16*)(ws + WS_PROJ); const bf16* AAg = (const bf16*)(ws + WS_AA); bf16* Vw = (bf16*)(ws + WS_V); float* BONw = (float*)(ws + WS_BONUS);
    const float* mu = a.in[3]; const float* k_k = a.in[9]; const float* k_a = a.in[10]; const float* r_k = a.in[11];
    LAS unsigned char* LA = lds + wave * CW_BYTES + CA_OFF; LAS unsigned char* LB = lds + wave * CW_BYTES + CB_OFF; LAS unsigned char* LC = lds + wave * CW_BYTES + CC_OFF;
    f32x16c zero16;
#pragma unroll
    for (int i = 0; i < 16; ++i) zero16[i] = 0.f;
    for (int item = gw; item < 64 * NCHK; item += NGW) {
        int lane_l = lane_in; asm volatile("" : "+v"(lane_l));
        const int lane = lane_l, tl = lane & 31, hf = lane >> 5;
        const int bh = item / NCHK, c = item % NCHK, b = bh >> 5, h = bh & 31;
        const float* lwu = LWG + ((size_t)b * SEQ + c * CH) * RW + h * 64;
        const int tpos = c * CH + tl;
        const bf16* pu = PRJ + ((size_t)b * SEQ + c * CH) * NPROJ + h * 64;
        const int lo_p = tl * NPROJ + 32 * hf, lo_q = (tpos > 0) ? lo_p - NPROJ : lo_p;
        const float pmask = (tpos > 0) ? 1.0f : 0.0f;
        const int lo_c = tl * RW + 32 * hf;
        const size_t ub = ((size_t)b * SEQ + c * CH) * RW + h * 64;
        const bf16* aau = AAg + ub; bf16* vwu = Vw + ub;
        const float* muu = mu + h * 64; const float* kku = k_k + h * 64; const float* kau = k_a + h * 64; const float* rku = r_k + h * 64; const int lo_h = 32 * hf;
        f32x4 lwr[8]; v4u rcw[4], rpw[4], vcw[4], vpw[4], kcw[4], kpw[4], aaw[4];
#pragma unroll
        for (int q = 0; q < 8; ++q) lwr[q] = *(const GAS f32x4*)(lwu + lo_c + 4 * q);
#pragma unroll
        for (int q = 0; q < 4; ++q) { rcw[q] = *(const GAS v4u*)(pu + COL_R + lo_p + 8 * q); rpw[q] = *(const GAS v4u*)(pu + COL_R + lo_q + 8 * q);
            vcw[q] = *(const GAS v4u*)(pu + COL_V + lo_p + 8 * q); vpw[q] = *(const GAS v4u*)(pu + COL_V + lo_q + 8 * q);
        }
        asm volatile("" ::: "memory");
        {
#pragma unroll
          for (int q = 0; q < 8; ++q) *(LAS f32x4*)(LA + (tl * 68 + 32 * hf + 4 * q) * 4) = lwr[q];
          LDS_WAIT();
          float accl = 0.f;
#pragma unroll
          for (int t = 0; t < CH; ++t) { accl += *(const LAS float*)(LA + (t * 68 + lane) * 4); *(LAS float*)(LA + (t * 68 + lane) * 4) = accl; }
          LDS_WAIT();
        }
#pragma unroll
        for (int q = 0; q < 4; ++q) { kcw[q] = *(const GAS v4u*)(pu + COL_K + lo_p + 8 * q); kpw[q] = *(const GAS v4u*)(pu + COL_K + lo_q + 8 * q); aaw[q] = *(const GAS v4u*)(aau + lo_c + 8 * q); }
        asm volatile("" ::: "memory");
        const float pc0 = __expf(*(const LAS float*)(LA + (31 * 68 + tl) * 4)), pc1 = __expf(*(const LAS float*)(LA + (31 * 68 + 32 + tl) * 4));
        v4u kh_[4], rt_[4], at_[4];
        bf16x8c fb[4], fk[4], fr[4], fa[4];
#define TM_WRITE(dst, src) do { _Pragma("unroll") for (int q = 0; q < 4; ++q) *(LAS v4u*)((dst) + tl * TMS + (32 * hf + 8 * q) * 2) = src[q]; LDS_WAIT(); } while (0)
#define TM_FRAGS(dst) do { _Pragma("unroll") for (int ks = 0; ks < 4; ++ks) dst[ks] = lds_nat(LB, tl, TMS, ks, hf); LDS_WAIT(); } while (0)
#define CM_WRITE(dst, src) do { _Pragma("unroll") for (int q = 0; q < 4; ++q) { const v4u _w = src[q]; _Pragma("unroll") for (int e = 0; e < 4; ++e) { \
            *(LAS unsigned short*)((dst) + (32 * hf + 8 * q + 2 * e) * CMS + tl * 2) = (unsigned short)(_w[e] & 0xffffu); *(LAS unsigned short*)((dst) + (32 * hf + 8 * q + 2 * e + 1) * CMS + tl * 2) = (unsigned short)(_w[e] >> 16); } } LDS_WAIT(); } while (0)
#define LROW(q) const f32x4 L0 = *(const LAS f32x4*)(LA + (tl * 68 + 32 * hf + 8 * (q)) * 4), L1 = *(const LAS f32x4*)(LA + (tl * 68 + 32 * hf + 8 * (q) + 4) * 4)
#define EROW(q) const f32x4 E0 = *(const LAS f32x4*)(LA + (31 * 68 + 32 * hf + 8 * (q)) * 4), E1 = *(const LAS f32x4*)(LA + (31 * 68 + 32 * hf + 8 * (q) + 4) * 4)
#define LERP8(cw, pw, col, q, out) do { float _c[8], _p[8]; unpack8(cw[q], _c); unpack8(pw[q], _p); \
            const f32x4 _m0 = *(const GAS f32x4*)(muu + (col) + lo_h + 8 * (q)), _m1 = *(const GAS f32x4*)(muu + (col) + lo_h + 8 * (q) + 4); \
            _Pragma("unroll") for (int j = 0; j < 8; ++j) out[j] = _c[j] + (_p[j] * pmask - _c[j]) * (j < 4 ? _m0[j] : _m1[j - 4]); } while (0)
        {
#pragma unroll
            for (int q = 0; q < 4; ++q) { LROW(q); float x8[8], u1[8]; LERP8(rcw, rpw, COL_R, q, x8);
#pragma unroll
                for (int j = 0; j < 8; ++j) { const float L = j < 4 ? L0[j] : L1[j - 4]; u1[j] = x8[j] * __expf(L); }
                rt_[q] = pack8(u1); }
        }
        {
#pragma unroll
            for (int q = 0; q < 4; ++q) { float x8[8]; LERP8(vcw, vpw, COL_V, q, x8); *(GAS v4u*)(vwu + lo_c + 8 * q) = pack8(x8); }
        }
        float inv_kk; v4u ks_[4];
        {
            float ss = 0.f;
#pragma unroll
            for (int q = 0; q < 4; ++q) { float x8[8]; LERP8(kcw, kpw, COL_K, q, x8); ks_[q] = pack8(x8);
                const f32x4 k0 = *(const GAS f32x4*)(kku + lo_h + 8 * q), k1 = *(const GAS f32x4*)(kku + lo_h + 8 * q + 4);
#pragma unroll
                for (int j = 0; j < 8; ++j) { const float t2 = x8[j] * (j < 4 ? k0[j] : k1[j - 4]); ss += t2 * t2; } }
            ss += __shfl_xor(ss, 32);
            inv_kk = 1.0f / sqrtf(fmaxf(ss, 1e-24f));
        }
        {
            v4u kt_[4]; float bon = 0.f;
#pragma unroll
            for (int q = 0; q < 4; ++q) { LROW(q); EROW(q); float x8[8], av[8], rt8[8]; unpack8(ks_[q], x8); unpack8(aaw[q], av); unpack8(rt_[q], rt8);
                const f32x4 a0v = *(const GAS f32x4*)(kau + lo_h + 8 * q), a1v = *(const GAS f32x4*)(kau + lo_h + 8 * q + 4), q0 = *(const GAS f32x4*)(rku + lo_h + 8 * q), q1 = *(const GAS f32x4*)(rku + lo_h + 8 * q + 4);
                float o_kt[8], o_kh[8];
#pragma unroll
                for (int j = 0; j < 8; ++j) { const float L = j < 4 ? L0[j] : L1[j - 4], Le = j < 4 ? E0[j] : E1[j - 4];
                    const float kp = x8[j] * (1.0f + (av[j] - 1.0f) * (j < 4 ? a0v[j] : a1v[j - 4])), enL = __expf(-L);
                    bon += rt8[j] * enL * (j < 4 ? q0[j] : q1[j - 4]) * kp;
                    o_kt[j] = kp * enL; o_kh[j] = kp * __expf(Le - L); }
                kt_[q] = pack8(o_kt); kh_[q] = pack8(o_kh); if (q == 1) asm volatile("" ::: "memory"); }
            bon += __shfl_xor(bon, 32);
            if (hf == 0) (BONw + ((size_t)b * SEQ + c * CH) * NH + h)[tl * NH] = bon;
            TM_WRITE(LB, kt_); TM_FRAGS(fk);
        }
        asm volatile("" ::: "memory");
        {
            v4u bt_[4], bh_[4];
#pragma unroll
            for (int q = 0; q < 4; ++q) { LROW(q); EROW(q); float x8[8], av[8]; unpack8(ks_[q], x8); unpack8(aaw[q], av);
                const f32x4 k0 = *(const GAS f32x4*)(kku + lo_h + 8 * q), k1 = *(const GAS f32x4*)(kku + lo_h + 8 * q + 4);
                const int rwp = tl > 0 ? tl - 1 : 0; const float pm2 = tl > 0 ? 1.0f : 0.0f;
                const f32x4 W0 = *(const LAS f32x4*)(LA + (rwp * 68 + 32 * hf + 8 * q) * 4) * pm2, W1 = *(const LAS f32x4*)(LA + (rwp * 68 + 32 * hf + 8 * q + 4) * 4) * pm2;
                float o_at[8], o_bt[8], o_bh[8];
#pragma unroll
                for (int j = 0; j < 8; ++j) { const float L = j < 4 ? L0[j] : L1[j - 4], Le = j < 4 ? E0[j] : E1[j - 4], lw1 = j < 4 ? W0[j] : W1[j - 4];
                    const float kk = x8[j] * (j < 4 ? k0[j] : k1[j - 4]) * inv_kk, bb = kk * av[j];
                    o_at[j] = -kk * __expf(lw1); o_bt[j] = bb * __expf(-L); o_bh[j] = bb * __expf(Le - L); }
                at_[q] = pack8(o_at); bt_[q] = pack8(o_bt); bh_[q] = pack8(o_bh); if (q == 1) asm volatile("" ::: "memory"); }
            TM_WRITE(LB, bt_); TM_FRAGS(fb); CM_WRITE(LC, bh_);
        }
        asm volatile("" ::: "memory");
        TM_WRITE(LB, rt_); TM_FRAGS(fr);
        TM_WRITE(LB, at_); TM_FRAGS(fa);
        asm volatile("" ::: "memory");
#undef LERP8
        CM_WRITE(LA, at_);
        TM_WRITE(LB, rt_);
        f32x16c P = zero16, R = zero16, KT = zero16, Mkr = zero16, Mbr = zero16;
#pragma unroll
        for (int ks = 0; ks < 4; ++ks) { P = MFMA32(fb[ks], fa[ks], P); R = MFMA32(fa[ks], fb[ks], R); KT = MFMA32(fa[ks], fk[ks], KT); Mkr = MFMA32(fk[ks], fr[ks], Mkr); Mbr = MFMA32(fb[ks], fr[ks], Mbr); }
#pragma unroll
        for (int i = 0; i < 16; ++i) { const int r = (i & 3) + 8 * (i >> 2) + 4 * hf;
            P[i] = (r < tl) ? P[i] : 0.f; Mkr[i] = (r <= tl) ? Mkr[i] : 0.f; Mbr[i] = (r <= tl) ? Mbr[i] : 0.f;
            R[i] = (tl < r) ? R[i] : 0.f; KT[i] = (tl < r) ? KT[i] : 0.f; }
        f32x16c T = P; diag_add(T, tl, hf, 1.0f);
#pragma unroll
        for (int lev = 0; lev < 4; ++lev) {
            const f32x16c Pn = (lev < 3) ? xty(R, P, zero16) : zero16;
            const f32x16c Rn = xty(P, R, zero16);
            P = Pn; R = Rn;
            f32x16c IR = R; diag_add(IR, tl, hf, 1.0f);
            T = xty(IR, T, zero16);
        }
        f32x16c Xa[2], Wt;
        { const bf16x8c t0 = cvt8(T, 0), t1 = cvt8(T, 8);
#pragma unroll
          for (int jt = 0; jt < 2; ++jt) { Xa[jt] = MFMA32(t0, lds_sig(LA, 32 * jt + tl, CMS, 0, hf), zero16); Xa[jt] = MFMA32(t1, lds_sig(LA, 32 * jt + tl, CMS, 1, hf), Xa[jt]); }
          Wt = MFMA32(t0, cvt8(KT, 0), zero16); Wt = MFMA32(t1, cvt8(KT, 8), Wt); }
        bf16x8c bs[2][2];
#pragma unroll
        for (int rt2 = 0; rt2 < 2; ++rt2)
#pragma unroll
            for (int ks = 0; ks < 2; ++ks) bs[rt2][ks] = lds_sig(LC, 32 * rt2 + tl, CMS, ks, hf);
        LDS_WAIT();
        { v4u vr[4];
#pragma unroll
          for (int q = 0; q < 4; ++q) vr[q] = *(const GAS v4u*)(vwu + lo_c + 8 * q);
          TM_WRITE(LA, kh_);
          CM_WRITE(LC, vr); }
        unsigned char* rec = ws + WS_REC + (size_t)item * SUM_BYTES;
#pragma unroll
        for (int bt2 = 0; bt2 < 2; ++bt2) { const bf16x8c x0 = cvt8(Xa[bt2], 0), x1 = cvt8(Xa[bt2], 8);
#pragma unroll
            for (int at2 = 0; at2 < 2; ++at2) { f32x16c g = MFMA32(x0, bs[at2][0], zero16); g = MFMA32(x1, bs[at2][1], g);
                if (at2 == bt2) diag_add(g, tl, hf, at2 == 0 ? pc0 : pc1);
#pragma unroll
                for (int k2 = 0; k2 < 2; ++k2) *(GAS bf16x8c*)(rec + SUM_GT + (32 * at2 + tl) * 128 + (2 * bt2 + k2) * 32 + hf * 16) = cvt8(g, 8 * k2);
            } }
        { const bf16x8c mb0 = cvt8(Mbr, 0), mb1 = cvt8(Mbr, 8);
#pragma unroll
          for (int jt = 0; jt < 2; ++jt) { f32x16c qv_;
#pragma unroll
              for (int i = 0; i < 16; ++i) { const int j = 32 * jt + (i & 3) + 8 * (i >> 2) + 4 * hf; qv_[i] = __builtin_bit_cast(float, (unsigned)(*(const LAS unsigned short*)(LB + tl * TMS + j * 2)) << 16); }
              qv_ = MFMA32(cvt8(Xa[jt], 0), mb0, qv_); qv_ = MFMA32(cvt8(Xa[jt], 8), mb1, qv_);
#pragma unroll
              for (int k2 = 0; k2 < 2; ++k2) *(GAS bf16x8c*)(rec + SUM_QT + tl * 128 + (2 * jt + k2) * 32 + hf * 16) = cvt8(qv_, 8 * k2);
          } }
        LDS_WAIT();
        bf16x8c vp[2][2];
#pragma unroll
        for (int it = 0; it < 2; ++it)
#pragma unroll
            for (int ks = 0; ks < 2; ++ks) vp[it][ks] = lds_sig(LC, 32 * it + tl, CMS, ks, hf);
        const bf16x8c w0 = cvt8(Wt, 0), w1 = cvt8(Wt, 8);
#pragma unroll
        for (int jt = 0; jt < 2; ++jt) { f32x16c zk;
#pragma unroll
            for (int i = 0; i < 16; ++i) { const int s = (i & 3) + 8 * (i >> 2) + 4 * hf; zk[i] = __builtin_bit_cast(float, (unsigned)(*(const LAS unsigned short*)(LA + s * TMS + (32 * jt + tl) * 2)) << 16); }
            zk = MFMA32(w0, bs[jt][0], zk); zk = MFMA32(w1, bs[jt][1], zk);
            const bf16x8c z0 = cvt8(zk, 0), z1 = cvt8(zk, 8);
#pragma unroll
            for (int it = 0; it < 2; ++it) { f32x16c hv = MFMA32(z0, vp[it][0], zero16); hv = MFMA32(z1, vp[it][1], hv);
                unsigned char* dst = rec + SUM_HT + ((size_t)(it * 64 + lane) * 2 + jt) * 32;
                *(GAS bf16x8c*)(dst) = cvt8(hv, 0); *(GAS bf16x8c*)(dst + 16) = cvt8(hv, 8);
            } }
        { f32x16c zy = MFMA32(w0, cvt8(Mbr, 0), Mkr); zy = MFMA32(w1, cvt8(Mbr, 8), zy);
          const bf16x8c y0 = cvt8(zy, 0), y1 = cvt8(zy, 8);
#pragma unroll
          for (int it = 0; it < 2; ++it) { f32x16c yv = MFMA32(y0, vp[it][0], zero16); yv = MFMA32(y1, vp[it][1], yv);
              unsigned char* dst = rec + SUM_YL + (size_t)(it * 64 + lane) * 32;
              *(GAS bf16x8c*)(dst) = cvt8(yv, 0); *(GAS bf16x8c*)(dst + 16) = cvt8(yv, 8);
          } }
        LDS_WAIT();
#undef TM_WRITE
#undef TM_FRAGS
#undef CM_WRITE
#undef LROW
#undef EROW
    }
}

constexpr int RING_SLOTS = 5, NLOADW = 5, RING_FLAGS = RING_SLOTS * SUM_BYTES;
__device__ __forceinline__ int ring_swz(int o) {
    return (o < SUM_HT) ? ((o & ~127) | ((((o >> 4) ^ (o >> 7)) & 7) << 4)) : o;
}
__device__ __forceinline__ void spin_until(volatile LAS unsigned* p, unsigned want) {
    unsigned sp = 0u;
    while (*p < want) { __builtin_amdgcn_s_sleep(1); if (++sp > (1u << 24)) break; }
}
__device__ __forceinline__ void phase5b(const Args& a, LAS unsigned char* lds, int bx, int G, int tid, int wave, int lane) {
    unsigned char* ws = a.ws;
    const int tl = lane & 31, hf = lane >> 5;
    volatile LAS unsigned* full = (volatile LAS unsigned*)(lds + RING_FLAGS); volatile LAS unsigned* freef = (volatile LAS unsigned*)(lds + RING_FLAGS + 32);
    if (tid < 64) ((LAS unsigned*)(lds + RING_FLAGS))[tid] = 0u;
    __syncthreads();
    const bool chain_block = (G >= 128) && (bx < 128);
    const int bh = bx >> 1, it = bx & 1, b = bh >> 5, h = bh & 31;
    const unsigned char* rec0 = ws + WS_REC + (size_t)bh * NCHK * SUM_BYTES;
    volatile LAS unsigned* freeB = (volatile LAS unsigned*)(lds + RING_FLAGS + 64); volatile LAS unsigned* sfull = (volatile LAS unsigned*)(lds + RING_FLAGS + 96); volatile LAS unsigned* sfree = (volatile LAS unsigned*)(lds + RING_FLAGS + 112);
    LAS unsigned char* sring = lds + RING_FLAGS + 256;
    constexpr int SSLOTS = 2;
    auto unp16 = [&](const bf16x8c lo, const bf16x8c hi2) { f32x16c r; const v4u l4 = __builtin_bit_cast(v4u, lo), h4 = __builtin_bit_cast(v4u, hi2);
#pragma unroll
        for (int e2 = 0; e2 < 4; ++e2) { r[2 * e2] = bflo(l4[e2]); r[2 * e2 + 1] = bfhi(l4[e2]); r[8 + 2 * e2] = bflo(h4[e2]); r[8 + 2 * e2 + 1] = bfhi(h4[e2]); }
        return r; };
    if (chain_block && wave == 0) {
        f32x16c S0, S1;
#pragma unroll
        for (int i = 0; i < 16; ++i) { S0[i] = 0.f; S1[i] = 0.f; }
        for (int c = 0; c < NCHK; ++c) {
            const int slot = c % RING_SLOTS, ss = c % SSLOTS; const LAS unsigned char* R = lds + slot * SUM_BYTES; LAS unsigned char* SR = sring + ss * 4096;
            const bf16x8c bs0 = cvt8(S0, 0), bs1 = cvt8(S0, 8), bs2 = cvt8(S1, 0), bs3 = cvt8(S1, 8);
            if (c >= SSLOTS) spin_until(sfree + ss, (unsigned)(c - SSLOTS + 1));
            asm volatile("" ::: "memory");
            *(LAS bf16x8c*)(SR + lane * 16) = bs0; *(LAS bf16x8c*)(SR + 1024 + lane * 16) = bs1; *(LAS bf16x8c*)(SR + 2048 + lane * 16) = bs2; *(LAS bf16x8c*)(SR + 3072 + lane * 16) = bs3;
            asm volatile("" ::: "memory");
            if (lane == 0) sfull[ss] = (unsigned)(c + 1);
            spin_until(full + slot, (unsigned)(c + 1));
            asm volatile("" ::: "memory");
            bf16x8c ga[2][4], hi_[2][2];
#pragma unroll
            for (int at2 = 0; at2 < 2; ++at2)
#pragma unroll
                for (int ks = 0; ks < 4; ++ks) ga[at2][ks] = *(const LAS bf16x8c*)(R + ring_swz(SUM_GT + (32 * at2 + tl) * 128 + ks * 32 + hf * 16));
#pragma unroll
            for (int jt = 0; jt < 2; ++jt) { const int o = SUM_HT + ((it * 64 + lane) * 2 + jt) * 32; hi_[jt][0] = *(const LAS bf16x8c*)(R + o); hi_[jt][1] = *(const LAS bf16x8c*)(R + o + 16); }
            LDS_WAIT();
            if (lane == 0) freef[slot] = (unsigned)(c + 1);
            f32x16c n0 = unp16(hi_[0][0], hi_[0][1]), n1 = unp16(hi_[1][0], hi_[1][1]);
            n0 = MFMA32(ga[0][0], bs0, n0); n1 = MFMA32(ga[1][0], bs0, n1);
            n0 = MFMA32(ga[0][1], bs1, n0); n1 = MFMA32(ga[1][1], bs1, n1);
            n0 = MFMA32(ga[0][2], bs2, n0); n1 = MFMA32(ga[1][2], bs2, n1);
            n0 = MFMA32(ga[0][3], bs3, n0); n1 = MFMA32(ga[1][3], bs3, n1);
            S0 = n0; S1 = n1;
        }
    } else if (chain_block && wave == 1) {
        float* Y = (float*)(ws + WS_Y);
        for (int c = 0; c < NCHK; ++c) {
            const int slot = c % RING_SLOTS, ss = c % SSLOTS; const LAS unsigned char* R = lds + slot * SUM_BYTES; const LAS unsigned char* SR = sring + ss * 4096;
            spin_until(full + slot, (unsigned)(c + 1)); spin_until(sfull + ss, (unsigned)(c + 1));
            asm volatile("" ::: "memory");
            bf16x8c qa[4], yi_[2];
#pragma unroll
            for (int ks = 0; ks < 4; ++ks) qa[ks] = *(const LAS bf16x8c*)(R + ring_swz(SUM_QT + tl * 128 + ks * 32 + hf * 16));
            { const int o = SUM_YL + (it * 64 + lane) * 32; yi_[0] = *(const LAS bf16x8c*)(R + o); yi_[1] = *(const LAS bf16x8c*)(R + o + 16); }
            const bf16x8c bs0 = *(const LAS bf16x8c*)(SR + lane * 16), bs1 = *(const LAS bf16x8c*)(SR + 1024 + lane * 16), bs2 = *(const LAS bf16x8c*)(SR + 2048 + lane * 16), bs3 = *(const LAS bf16x8c*)(SR + 3072 + lane * 16);
            LDS_WAIT();
            if (lane == 0) { freeB[slot] = (unsigned)(c + 1); sfree[ss] = (unsigned)(c + 1); }
            f32x16c yv = unp16(yi_[0], yi_[1]);
            yv = MFMA32(qa[0], bs0, yv); yv = MFMA32(qa[1], bs1, yv); yv = MFMA32(qa[2], bs2, yv); yv = MFMA32(qa[3], bs3, yv);
            float* yp = Y + ((size_t)b * SEQ + c * CH) * RW + h * 64 + 32 * it + tl;
#pragma unroll
            for (int i = 0; i < 16; ++i) { const int t = (i & 3) + 8 * (i >> 2) + 4 * hf; yp[(size_t)t * RW] = yv[i]; }
        }
    } else if (chain_block && wave >= 2 && wave < 2 + NLOADW) {
        for (int c = wave - 2; c < NCHK; c += NLOADW) {
            const int slot = c % RING_SLOTS; LAS unsigned char* R = lds + slot * SUM_BYTES;
            const unsigned char* rec = rec0 + (size_t)c * SUM_BYTES;
            v4u buf[18];
#pragma unroll
            for (int k = 0; k < 18; ++k) { const int pc = k < 12 ? k : (k < 16 ? 12 + 4 * it + (k - 12) : 20 + 2 * it + (k - 16)); buf[k] = *(const GAS v4u*)(rec + pc * 1024 + lane * 16); }
            if (c >= RING_SLOTS) { spin_until(freef + slot, (unsigned)(c - RING_SLOTS + 1)); spin_until(freeB + slot, (unsigned)(c - RING_SLOTS + 1)); }
            asm volatile("" ::: "memory");
#pragma unroll
            for (int k = 0; k < 18; ++k) { const int pc = k < 12 ? k : (k < 16 ? 12 + 4 * it + (k - 12) : 20 + 2 * it + (k - 16)); *(LAS v4u*)(R + ring_swz(pc * 1024 + lane * 16)) = buf[k]; }
            LDS_WAIT();
            if (lane == 0) full[slot] = (unsigned)(c + 1);
        }
    } else if (QUANT_IN_SCAN) {
        constexpr int NQW = 6 - NLOADW;
        const int nchain = (G >= 128) ? 128 : 0;
        const int nq = NQW * nchain + 8 * (G - nchain);
        const int qid = chain_block ? NQW * bx + (wave - 2 - NLOADW) : NQW * nchain + 8 * (bx - nchain) + wave;
        quant_rows(a, qid, nq, lane);
    }
    if (G < 128 && bx == 0 && wave == 0) {
        float* Y = (float*)(ws + WS_Y); for (int i = lane; i < 4096; i += 64) Y[i] = __builtin_nanf("");
    }
}

__device__ __forceinline__ void phase6(const Args& a, int gw, int NGW, int lane) {
    unsigned char* ws = a.ws;
    const float* Y = (const float*)(ws + WS_Y); const bf16* V = (const bf16*)(ws + WS_V); const bf16* G = (const bf16*)(ws + WS_G); const float* BON = (const float*)(ws + WS_BONUS);
    const float* lw = a.in[12]; const float* lb = a.in[13]; bf16* MIX = (bf16*)(ws + WS_MIXED);
    for (int it = gw; it < M * 4; it += NGW) {
        const int m = it >> 2, ch = (it & 3) * 512 + lane * 8; const size_t o = (size_t)m * RW + ch;
        const f32x4 y0 = *(const GAS f32x4*)(Y + o), y1 = *(const GAS f32x4*)(Y + o + 4);
        float y[8] = {y0.x, y0.y, y0.z, y0.w, y1.x, y1.y, y1.z, y1.w}, v[8], g[8];
        unpack8(*(const GAS v4u*)(V + o), v); unpack8(*(const GAS v4u*)(G + o), g);
        float s = 0.f;
#pragma unroll
        for (int j = 0; j < 8; ++j) s += y[j];
        s += __shfl_xor(s, 1); s += __shfl_xor(s, 2); s += __shfl_xor(s, 4);
        const float mean = s * (1.0f / 64.0f); float q = 0.f;
#pragma unroll
        for (int j = 0; j < 8; ++j) { y[j] -= mean; q += y[j] * y[j]; }
        q += __shfl_xor(q, 1); q += __shfl_xor(q, 2); q += __shfl_xor(q, 4);
        const float rstd = 1.0f / sqrtf(q * (1.0f / 64.0f) + 64e-5f), bn = BON[(size_t)m * NH + (ch >> 6)];
        const f32x4 w0 = *(const GAS f32x4*)(lw + ch), w1 = *(const GAS f32x4*)(lw + ch + 4), b0 = *(const GAS f32x4*)(lb + ch), b1 = *(const GAS f32x4*)(lb + ch + 4);
        float r[8];
#pragma unroll
        for (int j = 0; j < 8; ++j) r[j] = (y[j] * rstd * (j < 4 ? w0[j] : w1[j - 4]) + (j < 4 ? b0[j] : b1[j - 4]) + bn * v[j]) * g[j];
        *(GAS v4u*)(MIX + (size_t)m * D + ch) = pack8(r);
    }
}

typedef short bf16x8_t __attribute__((ext_vector_type(8)));
typedef float f32x16 __attribute__((ext_vector_type(16)));
__device__ __forceinline__ unsigned f2ord(float f) { const unsigned u = __builtin_bit_cast(unsigned, f); return (u & 0x80000000u) ? ~u : (u | 0x80000000u); }
__device__ __forceinline__ float ord2f(unsigned o) { const unsigned u = (o & 0x80000000u) ? (o & 0x7fffffffu) : ~o; return __builtin_bit_cast(float, u); }
__device__ __forceinline__ void ce_desc(unsigned& x, unsigned& y) { const unsigned hi = max(x, y), lo = min(x, y); x = hi; y = lo; }
template <int B> __device__ __forceinline__ void sort16_desc(unsigned (&u)[64]) {
#define CE(i, j) ce_desc(u[B + (i)], u[B + (j)]);
    CE(0,1) CE(2,3) CE(0,2) CE(1,3) CE(1,2) CE(4,5) CE(6,7) CE(4,6) CE(5,7) CE(5,6) CE(0,4) CE(2,6) CE(2,4) CE(1,5) CE(3,7) CE(3,5) CE(1,2) CE(3,4) CE(5,6) CE(8,9) CE(10,11) CE(8,10) CE(9,11) CE(9,10) CE(12,13) CE(14,15) CE(12,14) CE(13,15) CE(13,14) CE(8,12) CE(10,14) CE(10,12) CE(9,13) CE(11,15) CE(11,13) CE(9,10) CE(11,12) CE(13,14) CE(0,8) CE(4,12) CE(4,8) CE(2,10) CE(6,14) CE(6,10) CE(2,4) CE(6,8) CE(10,12) CE(1,9) CE(5,13) CE(5,9) CE(3,11) CE(7,15) CE(7,11) CE(3,5) CE(7,9) CE(11,13) CE(1,2) CE(3,4) CE(5,6) CE(7,8) CE(9,10) CE(11,12) CE(13,14)
#undef CE
}
template <int B> __device__ __forceinline__ void bitonic16_desc(unsigned (&u)[64]) {
#define CE(i, j) ce_desc(u[B + (i)], u[B + (j)]);
    CE(0,8) CE(1,9) CE(2,10) CE(3,11) CE(4,12) CE(5,13) CE(6,14) CE(7,15) CE(0,4) CE(1,5) CE(2,6) CE(3,7) CE(8,12) CE(9,13) CE(10,14) CE(11,15) CE(0,2) CE(1,3) CE(4,6) CE(5,7) CE(8,10) CE(9,11) CE(12,14) CE(13,15) CE(0,1) CE(2,3) CE(4,5) CE(6,7) CE(8,9) CE(10,11) CE(12,13) CE(14,15)
#undef CE
}
template <int BA, int BB> __device__ __forceinline__ void merge_top16(unsigned (&u)[64]) {
#pragma unroll
    for (int i = 0; i < 16; ++i) u[BA + i] = max(u[BA + i], u[BB + 15 - i]);
    bitonic16_desc<BA>(u);
}
__device__ __forceinline__ void top16_of_64(unsigned (&u)[64]) {
    sort16_desc<0>(u); sort16_desc<16>(u); sort16_desc<32>(u); sort16_desc<48>(u);
    merge_top16<0, 16>(u); merge_top16<32, 48>(u); merge_top16<0, 32>(u);
}
__device__ __forceinline__ void phase9(const Args& a, int gw, int NGW, int lane) {
    unsigned char* ws = a.ws;
    const bf16* SKB = (const bf16*)(ws + WS_SKB); const bf16* Q = (const bf16*)(ws + WS_Q);
    int* EIDX = (int*)(ws + WS_EIDX); float* GATE = (float*)(ws + WS_GATE);
    const int tokl = lane & 31, hh = lane >> 5;
    for (int unit = gw; unit < (M / 32) * PH; unit += NGW) {
        const int h = unit & 7, m0 = (unit >> 3) * 32;
        unsigned tc[2][16];
#pragma unroll
        for (int c = 0; c < 2; ++c) {
            f32x16 acc[4];
#pragma unroll
            for (int t = 0; t < 4; ++t)
#pragma unroll
                for (int r = 0; r < 16; ++r) acc[t][r] = 0.f;
            const bf16* qrow = Q + (size_t)(m0 + tokl) * 2048 + h * 256 + c * 128 + 8 * hh;
            const bf16* krow = SKB + ((size_t)(h * 2 + c) * 128 + tokl) * 128 + 8 * hh;
#pragma unroll 4
            for (int ks = 0; ks < 8; ++ks) {
                const bf16x8_t bq = __builtin_bit_cast(bf16x8_t, *(const GAS v4u*)(qrow + ks * 16));
#pragma unroll
                for (int t = 0; t < 4; ++t) { const bf16x8_t ak = __builtin_bit_cast(bf16x8_t, *(const GAS v4u*)(krow + t * 32 * 128 + ks * 16));
                    acc[t] = __builtin_amdgcn_mfma_f32_32x32x16_bf16(ak, bq, acc[t], 0, 0, 0); }
            }
            unsigned u[64];
#pragma unroll
            for (int t = 0; t < 4; ++t)
#pragma unroll
                for (int r = 0; r < 16; ++r) { const int nb = t * 32 + (r & 3) + 8 * (r >> 2);
                    u[t * 16 + r] = (f2ord(acc[t][r]) & ~127u) | (unsigned)(127 - nb - 4 * hh); }
            top16_of_64(u);
#pragma unroll
            for (int i = 0; i < 16; ++i) { const unsigned p = (unsigned)__shfl_xor((int)u[15 - i], 32); u[16 + i] = p; }
#pragma unroll
            for (int i = 0; i < 16; ++i) u[i] = max(u[i], u[16 + i]);
            bitonic16_desc<0>(u);
#pragma unroll
            for (int i = 0; i < 16; ++i) tc[c][i] = u[i];
        }
        float s0[16], s1[16]; unsigned n0[16], n1[16];
#pragma unroll
        for (int i = 0; i < 16; ++i) { s0[i] = ord2f(tc[0][i] & ~127u); s1[i] = ord2f(tc[1][i] & ~127u); n0[i] = (127u - (tc[0][i] & 127u)) << 7; n1[i] = 127u - (tc[1][i] & 127u); }
        unsigned u[64];
#define CAND(k, i, j) u[k] = (f2ord(s0[i] + s1[j]) & ~0x3FFFu) | (n0[i] | n1[j]);
        CAND(0,0,0) CAND(1,0,1) CAND(2,0,2) CAND(3,0,3) CAND(4,0,4) CAND(5,0,5) CAND(6,0,6) CAND(7,0,7) CAND(8,0,8) CAND(9,0,9) CAND(10,0,10) CAND(11,0,11) CAND(12,0,12) CAND(13,0,13) CAND(14,0,14) CAND(15,0,15) CAND(16,1,0) CAND(17,1,1) CAND(18,1,2) CAND(19,1,3) CAND(20,1,4) CAND(21,1,5) CAND(22,1,6) CAND(23,1,7) CAND(24,2,0) CAND(25,2,1) CAND(26,2,2) CAND(27,2,3) CAND(28,2,4) CAND(29,3,0) CAND(30,3,1) CAND(31,3,2) CAND(32,3,3) CAND(33,4,0) CAND(34,4,1) CAND(35,4,2) CAND(36,5,0) CAND(37,5,1) CAND(38,6,0) CAND(39,6,1) CAND(40,7,0) CAND(41,7,1) CAND(42,8,0) CAND(43,9,0) CAND(44,10,0) CAND(45,11,0) CAND(46,12,0) CAND(47,13,0) CAND(48,14,0) CAND(49,15,0)
#undef CAND
#pragma unroll
        for (int k = 50; k < 64; ++k) u[k] = 0u;
        top16_of_64(u);
        float ex[16]; float den = 0.f; const float mx = ord2f(u[0] & ~0x3FFFu);
#pragma unroll
        for (int r = 0; r < 16; ++r) { ex[r] = __expf(ord2f(u[r] & ~0x3FFFu) - mx); den += ex[r]; }
        const float inv = 1.0f / den;
        if (hh == 0) {
            const size_t o = (size_t)(m0 + tokl) * 128 + h * 16;
#pragma unroll
            for (int r4 = 0; r4 < 4; ++r4) {
                *(GAS v4u*)(EIDX + o + r4 * 4) = (v4u){u[r4 * 4] & 0x3FFFu, u[r4 * 4 + 1] & 0x3FFFu, u[r4 * 4 + 2] & 0x3FFFu, u[r4 * 4 + 3] & 0x3FFFu};
                *(GAS f32x4*)(GATE + o + r4 * 4) = (f32x4){ex[r4 * 4] * inv, ex[r4 * 4 + 1] * inv, ex[r4 * 4 + 2] * inv, ex[r4 * 4 + 3] * inv};
            }
        }
    }
}

__device__ __forceinline__ float gelu_erf(float v) { return 0.5f * v * (1.0f + erff(v * 0.70710678118f)); }
constexpr int PW_BYTES = 1536;
__device__ __forceinline__ void phase10(const Args& a, LAS unsigned char* lds, int gw, int NGW, int wave, int lane, float* OUT) {
    unsigned char* ws = a.ws;
    const bf16* HB = (const bf16*)(ws + WS_XN); const float* SSQ = (const float*)(ws + WS_SSQ);
    const int* EIDX = (const int*)(ws + WS_EIDX); const float* GATE = (const float*)(ws + WS_GATE);
    const unsigned char* DQ = ws + WS_DQ; const unsigned char* UQ = ws + WS_UQ; const float* DS = (const float*)(ws + WS_DSCALE); const float* US = (const float*)(ws + WS_USCALE);
    const float* nfw = a.in[21]; const float* n2w = a.in[16];
    LAS int* le = (LAS int*)(lds + wave * PW_BYTES); LAS float* lg = (LAS float*)(lds + wave * PW_BYTES + 512); LAS float* lc = (LAS float*)(lds + wave * PW_BYTES + 1024);
    for (int m = gw; m < M; m += NGW) {
        const float rs2 = 1.0f / sqrtf(SSQ[m] * (1.0f / D) + 1e-6f);
        LDS_WAIT();
        le[lane] = EIDX[(size_t)m * 128 + lane]; le[lane + 64] = EIDX[(size_t)m * 128 + 64 + lane];
        lg[lane] = GATE[(size_t)m * 128 + lane]; lg[lane + 64] = GATE[(size_t)m * 128 + 64 + lane];
        float xs[64];
#pragma unroll
        for (int k = 0; k < 16; ++k) { const v2u w = *(const GAS v2u*)(HB + (size_t)m * D + k * 256 + lane * 4);
            xs[4 * k + 0] = bflo(w.x); xs[4 * k + 1] = bfhi(w.x); xs[4 * k + 2] = bflo(w.y); xs[4 * k + 3] = bfhi(w.y); }
        LDS_WAIT();
#pragma unroll 1
        for (int g = 0; g < 8; ++g) {
            float pv[16];
#pragma unroll
            for (int k = 0; k < 16; ++k) {
                const int e = __builtin_amdgcn_readfirstlane(le[g * 16 + k]);
                const unsigned char* rp = DQ + (size_t)e * ROWB_DN + lane * 16;
                float ev[64];
#if PEER_DN_FP4
                { const v4u u0 = *(const GAS v4u*)(rp), u1 = *(const GAS v4u*)(rp + 1024);
#pragma unroll
                  for (int w = 0; w < 8; ++w) { const unsigned dw = w < 4 ? u0[w] : u1[w - 4];
#define FP4_DN(b2) { const f32x2 xy = __builtin_amdgcn_cvt_scalef32_pk_f32_fp4(dw, 1.0f, b2); ev[8 * w + 2 * (b2)] = xy.x; ev[8 * w + 2 * (b2) + 1] = xy.y; }
                      FP4_DN(0) FP4_DN(1) FP4_DN(2) FP4_DN(3)
#undef FP4_DN
                  } }
#else
                load_qrow(rp, ev);
#endif
                f32x2 p2a = (f32x2){0.f, 0.f}, p2b = (f32x2){0.f, 0.f};
#pragma unroll
                for (int i = 0; i < 16; ++i) { p2a += (f32x2){ev[4 * i], ev[4 * i + 1]} * (f32x2){xs[4 * i], xs[4 * i + 1]}; p2b += (f32x2){ev[4 * i + 2], ev[4 * i + 3]} * (f32x2){xs[4 * i + 2], xs[4 * i + 3]}; }
                const float p = (p2a.x + p2a.y) + (p2b.x + p2b.y);
                pv[k] = p;
            }
#pragma unroll
            for (int k = 0; k < 8; ++k) { const bool up = (lane & 32) != 0; const float send = up ? pv[k] : pv[k + 8], keep = up ? pv[k + 8] : pv[k]; pv[k] = keep + __shfl_xor(send, 32); }
#pragma unroll
            for (int k = 0; k < 4; ++k) { const bool up = (lane & 16) != 0; const float send = up ? pv[k] : pv[k + 4], keep = up ? pv[k + 4] : pv[k]; pv[k] = keep + __shfl_xor(send, 16); }
#pragma unroll
            for (int k = 0; k < 2; ++k) { const bool up = (lane & 8) != 0; const float send = up ? pv[k] : pv[k + 2], keep = up ? pv[k + 2] : pv[k]; pv[k] = keep + __shfl_xor(send, 8); }
            { const bool up = (lane & 4) != 0; const float send = up ? pv[0] : pv[1], keep = up ? pv[1] : pv[0]; pv[0] = keep + __shfl_xor(send, 4); }
            float tot = pv[0]; tot += __shfl_xor(tot, 1); tot += __shfl_xor(tot, 2);
            const int idx = g * 16 + ((lane >> 2) & 15); const int e = le[idx];
            const float c = lg[idx] * gelu_erf(tot * DS[e] * rs2) * US[e];
            if ((lane & 3) == 0) lc[idx] = c;
        }
        LDS_WAIT();
        float acc[64];
#pragma unroll
        for (int i = 0; i < 64; ++i) acc[i] = 0.f;
#if PEER_UP_FP4
#pragma unroll 2
        for (int idx = 0; idx < 128; ++idx) {
            const int e = __builtin_amdgcn_readfirstlane(le[idx]); const float c = __builtin_bit_cast(float, __builtin_amdgcn_readfirstlane(__builtin_bit_cast(int, lc[idx])));
            const unsigned char* rp = UQ + (size_t)e * ROWB_UP + lane * 16;
            const v4u u0 = *(const GAS v4u*)(rp), u1 = *(const GAS v4u*)(rp + 1024);
            const f32x2 cc = (f32x2){c, c};
#pragma unroll
            for (int w = 0; w < 8; ++w) { const unsigned dw = w < 4 ? u0[w] : u1[w - 4];
#define FP4_UP(b2) { const f32x2 xy = __builtin_amdgcn_cvt_scalef32_pk_f32_fp4(dw, 1.0f, b2); const int t0 = 8 * w + 2 * (b2); acc[t0] += c * xy.x; acc[t0 + 1] += c * xy.y; }
                FP4_UP(0) FP4_UP(1) FP4_UP(2) FP4_UP(3)
#undef FP4_UP
            }
        }
#else
#pragma unroll 4
        for (int idx = 0; idx < 128; ++idx) {
            const int e = __builtin_amdgcn_readfirstlane(le[idx]); const float c = __builtin_bit_cast(float, __builtin_amdgcn_readfirstlane(__builtin_bit_cast(int, lc[idx])));
            const unsigned char* rp = UQ + (size_t)e * ROWB + lane * 16;
            float ev[64]; load_qrow(rp, ev);
#pragma unroll
            for (int i = 0; i < 64; ++i) acc[i] += c * ev[i];
        }
#endif
        float ss = 0.f;
#pragma unroll
        for (int i = 0; i < 4; ++i)
#pragma unroll
            for (int j = 0; j < 4; ++j) { const v2u hw = *(const GAS v2u*)(HB + (size_t)m * D + (i * 4 + j) * 256 + lane * 4); const f32x4 nv = *(const GAS f32x4*)(n2w + (i * 4 + j) * 256 + lane * 4);
                f32x4 hv; hv.x = bflo(hw.x) * __builtin_amdgcn_rcpf(nv.x); hv.y = bfhi(hw.x) * __builtin_amdgcn_rcpf(nv.y); hv.z = bflo(hw.y) * __builtin_amdgcn_rcpf(nv.z); hv.w = bfhi(hw.y) * __builtin_amdgcn_rcpf(nv.w);
                acc[i * 16 + j * 4 + 0] += hv.x; acc[i * 16 + j * 4 + 1] += hv.y; acc[i * 16 + j * 4 + 2] += hv.z; acc[i * 16 + j * 4 + 3] += hv.w;
                ss += (acc[i * 16 + j * 4 + 0] * acc[i * 16 + j * 4 + 0] + acc[i * 16 + j * 4 + 1] * acc[i * 16 + j * 4 + 1]) + (acc[i * 16 + j * 4 + 2] * acc[i * 16 + j * 4 + 2] + acc[i * 16 + j * 4 + 3] * acc[i * 16 + j * 4 + 3]); }
        const float rsf = 1.0f / sqrtf(wave_sum(ss) * (1.0f / D) + 1e-6f);
#pragma unroll
        for (int i = 0; i < 4; ++i)
#pragma unroll
            for (int j = 0; j < 4; ++j) { const f32x4 wv = *(const GAS f32x4*)(nfw + (i * 4 + j) * 256 + lane * 4);
                f32x4 o; o.x = acc[i * 16 + j * 4 + 0] * rsf * wv.x; o.y = acc[i * 16 + j * 4 + 1] * rsf * wv.y; o.z = acc[i * 16 + j * 4 + 2] * rsf * wv.z; o.w = acc[i * 16 + j * 4 + 3] * rsf * wv.w;
                *(GAS f32x4*)(OUT + (size_t)m * D + (i * 4 + j) * 256 + lane * 4) = o; }
    }
}

__global__ void __launch_bounds__(NTHREADS, 2) mega_fwd(Args args) {
    extern __shared__ __attribute__((aligned(16))) unsigned char lds_raw[];
    LAS unsigned char* lds = (LAS unsigned char*)lds_raw;
    volatile LAS unsigned* MISC = (volatile LAS unsigned*)(lds + MISC_OFF);
    const int tid = threadIdx.x, lane = tid & 63, wave = __builtin_amdgcn_readfirstlane(tid >> 6);
    const int G = gridDim.x, bx = blockIdx.x;
    const int vcu = (G % 8 == 0) ? (bx % 8) * (G / 8) + bx / 8 : bx;
    const int gw = vcu * NWAVES + wave, NGW = G * NWAVES, gt = gw * 64 + lane, NGT = NGW * 64;
    unsigned char* ws = args.ws;
    for (int u = tid; u < (LDS_BYTES - LDSCTL_OFF) / 4; u += NTHREADS) ((LAS unsigned*)(lds + LDSCTL_OFF))[u] = 0u;
    __syncthreads();
    XcdBarrier bar; bar.bar = (unsigned*)(ws + WS_CTL) + CW_BAR + args.li * XCD_BAR_WORDS; bar.x = 0; bar.st = nullptr;
    if (MK_N_LAUNCHES == 1) bar = xcd_barrier_post((unsigned*)(ws + WS_CTL) + CW_BAR + args.li * XCD_BAR_WORDS, MISC + 8);
    const int lo = args.ph_lo, hi = args.ph_hi;
#ifndef PHASE_MASK
#define PHASE_MASK 0xfff
#endif
#define IN(k) (((PHASE_MASK >> (k)) & 1) && lo <= (k) && (k) < hi)
#ifndef DUP_MASK
#define DUP_MASK 0
#endif
#define DUP(k) ((DUP_MASK >> (k)) & 1)
#define SEAM(k) do { if (IN(k) && IN((k) + 1)) xcd_barrier(bar); } while (0)

    if (IN(0)) { phase0(args, lds, gw, NGW, wave, lane); if (DUP(0)) { __syncthreads(); phase0(args, lds, gw, NGW, wave, lane); } } SEAM(0);
    if (IN(1)) {
        pg8::Gemm g{(const bf16*)(ws + WS_XN), (const bf16*)(ws + WS_WINT), M, NPROJ, D, D}; pg8::StaticOrder S; S.init(M, NPROJ, G, bx);
        pg8::EpiPlainBf16 E{(bf16*)(ws + WS_PROJ), NPROJ};
        pg8::gemm_phase<pg8::EpiPlainBf16, pg8::StaticOrder, true, true>(lds + RING_OFF, g, S, E);
        if (DUP(1)) { __syncthreads(); pg8::gemm_phase<pg8::EpiPlainBf16, pg8::StaticOrder, true, true>(lds + RING_OFF, g, S, E); }
        for (int u = bx; u < (M / 256) * 2 * KSPLIT; u += G) {
            const int pm = u >> 3, pnl = (u >> 2) & 1, ks = u & 3;
            __syncthreads();
            pg8::Gemm g2{(const bf16*)(ws + WS_XN) + ks * (D / KSPLIT), (const bf16*)(ws + WS_WINT) + (size_t)NPROJ * D + ks * (D / KSPLIT), M, SLABW, D / KSPLIT, D};
            pg8::SingleUnit S2{pm, pnl}; pg8::EpiSlabF32 E2{(float*)(ws + WS_SLAB) + (size_t)ks * M * SLABW, SLABW};
            pg8::gemm_phase<pg8::EpiSlabF32, pg8::SingleUnit, false, true>(lds + RING_OFF, g2, S2, E2);
        }
    } SEAM(1);
    if (IN(2)) { phase2(args, gt, NGT); if (DUP(2)) phase2(args, gt, NGT); } SEAM(2);
    if (IN(3)) {
        pg8::Gemm g{(const bf16*)(ws + WS_LIN), (const bf16*)(ws + WS_WLORA), M, NLORA, KLORA, KLORA}; pg8::StaticOrder S; S.init(M, NLORA, G, bx);
        pg8::EpiLora E{(float*)(ws + WS_WD), (bf16*)(ws + WS_AA), (bf16*)(ws + WS_G), args.in[4], args.in[6]};
        pg8::gemm_phase<pg8::EpiLora, pg8::StaticOrder, true, true>(lds + RING_OFF, g, S, E);
        if (DUP(3)) { __syncthreads(); pg8::gemm_phase<pg8::EpiLora, pg8::StaticOrder, true, true>(lds + RING_OFF, g, S, E); }
    } SEAM(3);
    if (!SCAN_CHUNKED) { if (IN(4)) { phase4(args, gw, NGW, lane); } SEAM(4); }
    if (IN(5)) { if (SCAN_CHUNKED) phase5a(args, lds, gw, NGW, wave, lane); else phase5(args, lds, tid); } SEAM(5);
    if (IN(6)) { if (SCAN_CHUNKED) phase5b(args, lds, bx, G, tid, wave, lane); } SEAM(6);
    if (IN(7)) { phase6(args, gw, NGW, lane); if (DUP(7)) phase6(args, gw, NGW, lane); } SEAM(7);
    if (IN(8)) {
        pg8::Gemm g{(const bf16*)(ws + WS_MIXED), (const bf16*)(ws + WS_WOUTT), M, D, D, D}; pg8::StaticOrder S; S.init(M, D, G, bx);
        pg8::EpiOut<true> E{args.in[0], args.out, (bf16*)(ws + WS_XN), args.in[16], (float*)(ws + WS_SSQ)};
        pg8::gemm_phase<pg8::EpiOut<true>, pg8::StaticOrder, true, true>(lds + RING_OFF, g, S, E);
        if (DUP(8)) { __syncthreads(); pg8::EpiOut<false> E2{args.in[0], args.out, (bf16*)(ws + WS_XN), args.in[16], (float*)(ws + WS_SSQ)}; pg8::gemm_phase<pg8::EpiOut<false>, pg8::StaticOrder, true, true>(lds + RING_OFF, g, S, E2); }
    } SEAM(8);
    if (IN(9)) {
        pg8::Gemm g{(const bf16*)(ws + WS_XN), (const bf16*)(ws + WS_WQT), M, 2048, D, D}; pg8::StaticOrder S; S.init(M, 2048, G, bx);
        pg8::EpiQ E{(bf16*)(ws + WS_Q), (const float*)(ws + WS_SSQ)};
        pg8::gemm_phase<pg8::EpiQ, pg8::StaticOrder, true, true>(lds + RING_OFF, g, S, E);
        if (DUP(9)) { __syncthreads(); pg8::gemm_phase<pg8::EpiQ, pg8::StaticOrder, true, true>(lds + RING_OFF, g, S, E); }
    } SEAM(9);
    if (IN(10)) { phase9(args, gw, NGW, lane); if (DUP(10)) phase9(args, gw, NGW, lane); } SEAM(10);
    if (IN(11)) { if (DUP(11)) phase10(args, lds, gw, NGW, wave, lane, (float*)(ws + WS_PROJ)); phase10(args, lds, gw, NGW, wave, lane, args.out); }
#undef IN
#undef SEAM
}

extern "C" void kernel_launch(void* const* d_in, const int* in_sizes, int n_in, void* d_out, int out_size, void* d_ws, size_t ws_size, hipStream_t stream) {
    static int grid = 0;
    if (grid == 0) {
        if (n_in != 22 || in_sizes[0] != M * D || out_size != M * D || ws_size < WS_END) { fprintf(stderr, "kernel_launch: unexpected shapes: n_in %d in0 %d out %d ws %zu (need %zu)\n", n_in, n_in > 0 ? in_sizes[0] : -1, out_size, ws_size, (size_t)WS_END); grid = -1; return; }
        int dev = 0, cus = 0, per_cu = 0;
        if (hipGetDevice(&dev) != hipSuccess || hipDeviceGetAttribute(&cus, hipDeviceAttributeMultiprocessorCount, dev) != hipSuccess) { grid = -1; return; }
        if (hipFuncSetAttribute((const void*)mega_fwd, hipFuncAttributeMaxDynamicSharedMemorySize, LDS_BYTES) != hipSuccess) { fprintf(stderr, "kernel_launch: hipFuncSetAttribute failed\n"); grid = -1; return; }
        if (hipOccupancyMaxActiveBlocksPerMultiprocessor(&per_cu, (const void*)mega_fwd, NTHREADS, LDS_BYTES) != hipSuccess || per_cu < 1) { fprintf(stderr, "kernel_launch: occupancy query says %d blocks per CU\n", per_cu); }
        (void)hipGetLastError();
        grid = cus;
    }
    if (grid < 0) return;
    (void)hipMemsetAsync((char*)d_ws + WS_CTL, 0, CTL_ZERO_BYTES, stream);
    Args a{};
    for (int i = 0; i < 22; ++i) a.in[i] = (const float*)d_in[i];
    a.out = (float*)d_out; a.ws = (unsigned char*)d_ws;
#ifndef REPEAT_PREFIX
#define REPEAT_PREFIX 0
#endif
    if (MK_N_LAUNCHES == 1) { a.ph_lo = 0; a.ph_hi = NPHASES; hipLaunchKernelGGL(mega_fwd, dim3(grid), dim3(NTHREADS), LDS_BYTES, stream, a);
        if (REPEAT_PREFIX > 0) { a.ph_hi = REPEAT_PREFIX; a.li = 1; hipLaunchKernelGGL(mega_fwd, dim3(grid), dim3(NTHREADS), LDS_BYTES, stream, a); } }
    else for (int p = 0; p < NPHASES; ++p) { a.ph_lo = p; a.ph_hi = p + 1; hipLaunchKernelGGL(mega_fwd, dim3(grid), dim3(NTHREADS), LDS_BYTES, stream, a); }
}
```

```cpp
#include <hip/hip_runtime.h>
#include <cstdio>
#include <cstdint>
namespace pg8 {
#define PG8_LAS __attribute__((address_space(3)))
typedef unsigned short bf16_t;
typedef short bf16x8 __attribute__((ext_vector_type(8)));
typedef float f32x4 __attribute__((ext_vector_type(4)));
typedef unsigned u32x4 __attribute__((ext_vector_type(4)));
constexpr int BM = 256, BK = 64, HALF = 128, HTB = HALF * BK * 2  , STAGE_BYTES = 8 * HTB, NXCD = 8, WGM = 8;

__host__ __device__ __forceinline__ int lds_byte(int r, int c) { const int st = (r >> 4) * 2 + (c >> 5), rr = r & 15, cc = c & 31, ob = rr * 64 + cc * 2; return st * 1024 + (ob ^ (((ob >> 9) & 1) << 5)); }
__host__ __device__ __forceinline__ void stage_rc(int b, int& R, int& C) { const int st = b / 1024, sb = b % 1024, swz = sb ^ (((sb >> 9) & 1) << 5); R = (st >> 1) * 16 + swz / 64; C = (st & 1) * 32 + (swz % 64) / 2; }
__host__ __device__ __forceinline__ int perm32(int rho) { const int n = rho >> 4, i = rho & 15; return 8 * (i >> 2) + 4 * n + (i & 3); }

struct Unit { int pm, pn; };
struct Gemm { const bf16_t* A; const bf16_t* Bt; int M, N, K, ld; };

struct StaticOrder {
    int nM, nN, nwg, G, c;
    __host__ __device__ void init(int M, int N, int G_, int c_) { nM = M / BM; nN = N / BM; nwg = nM * nN; G = G_; c = c_; }
    __host__ __device__ bool next(int i, Unit& u) const {
        const long L = (long)i * G + c; if (L >= nwg) return false;
        int wgid = (int)L; { const int q = nwg / NXCD, r = nwg % NXCD, xcd = wgid % NXCD, off = wgid / NXCD; wgid = (xcd < r ? xcd * (q + 1) : r * (q + 1) + (xcd - r) * q) + off; }
        const int nig = WGM * nN, gid = wgid / nig, fm = gid * WGM, gsz = (nM - fm) < WGM ? (nM - fm) : WGM;
        u.pm = fm + ((wgid % nig) % gsz); u.pn = (wgid % nig) / gsz; return true;
    }
    __device__ __forceinline__ void a_ready(const Unit&) const {}
    __device__ __forceinline__ void done(const Unit&) const {}
};

struct SingleUnit {
    int pm, pn;
    __device__ __forceinline__ bool next(int i, Unit& u) const { if (i != 0) return false; u.pm = pm; u.pn = pn; return true; }
    __device__ __forceinline__ void a_ready(const Unit&) const {}
    __device__ __forceinline__ void done(const Unit&) const {}
};
__device__ __forceinline__ unsigned cvt_pk_bf16(float lo, float hi) { unsigned r; asm volatile("v_cvt_pk_bf16_f32 %0, %1, %2" : "=v"(r) : "v"(lo), "v"(hi)); return r; }
typedef float f32x2 __attribute__((ext_vector_type(2)));
__device__ __forceinline__ f32x2 gelu_pk(f32x2 v) {
    const f32x2 av = __builtin_elementwise_abs(v), d = av * 0.2316418882f + 1.0f;
    f32x2 t; t.x = __builtin_amdgcn_rcpf(d.x); t.y = __builtin_amdgcn_rcpf(d.y);
    f32x2 q = t * 0.5307027145f + (-0.7265760135f); q = q * t + 0.7107068705f; q = q * t + (-0.142248368f); q = q * t + 0.127414796f; q = q * t;
    const f32x2 s = (v * v) * (-0.72134752044f);
    f32x2 e; e.x = __builtin_amdgcn_exp2f(s.x); e.y = __builtin_amdgcn_exp2f(s.y);
    const f32x2 m = v * (q * e), r = v - m;
    f32x2 o; o.x = v.x < 0.f ? m.x : r.x; o.y = v.y < 0.f ? m.y : r.y; return o;
}


typedef unsigned u32x2 __attribute__((ext_vector_type(2)));
__device__ __forceinline__ float fast_sigmoid(float v) { return __builtin_amdgcn_rcpf(1.0f + __expf(-v)); }

struct EpiPlainBf16 {
    static constexpr bool PERM = true, AFTER_DRAIN = false;
    bf16_t* O; int ldc;
    __device__ __forceinline__ void operator()(const f32x4 (&acc)[2][2][4][2], const Unit& u, int wr, int wc, int fr, int fq) const {
        const int row0 = u.pm * BM + wr * 64 + fr, col0 = u.pn * BM + wc * 32 + 8 * fq;
#pragma unroll
        for (int ai = 0; ai < 2; ++ai)
#pragma unroll
            for (int m = 0; m < 4; ++m) { bf16_t* rowp = O + (size_t)(row0 + ai * HALF + m * 16) * ldc + col0;
#pragma unroll
                for (int bj = 0; bj < 2; ++bj) { const f32x4 v0 = acc[ai][bj][m][0], v1 = acc[ai][bj][m][1];
                    u32x4 w; w.x = cvt_pk_bf16(v0[0], v0[1]); w.y = cvt_pk_bf16(v0[2], v0[3]); w.z = cvt_pk_bf16(v1[0], v1[1]); w.w = cvt_pk_bf16(v1[2], v1[3]);
                    *(u32x4*)(rowp + bj * HALF) = w; } }
    }
};

struct EpiSlabF32 {
    static constexpr bool PERM = false, AFTER_DRAIN = false;
    float* O; int ldc;
    __device__ __forceinline__ void operator()(const f32x4 (&acc)[2][2][4][2], const Unit& u, int wr, int wc, int fr, int fq) const {
        const int row0 = u.pm * BM + wr * 64 + fr, col0 = u.pn * BM + wc * 32 + 4 * fq;
#pragma unroll
        for (int ai = 0; ai < 2; ++ai)
#pragma unroll
            for (int m = 0; m < 4; ++m) { float* rowp = O + (size_t)(row0 + ai * HALF + m * 16) * ldc + col0;
#pragma unroll
                for (int bj = 0; bj < 2; ++bj)
#pragma unroll
                    for (int n = 0; n < 2; ++n) *(f32x4*)(rowp + bj * HALF + n * 16) = acc[ai][bj][m][n]; }
    }
};

#ifndef SCAN_CHUNKED
#define SCAN_CHUNKED 1
#endif
struct EpiLora {
    static constexpr bool PERM = true, AFTER_DRAIN = false;
    float* Wd; bf16_t* Aa; bf16_t* Gg; const float* w0; const float* a0;
    template <int KIND> __device__ __forceinline__ void run(const f32x4 (&acc)[2][2][4][2], const Unit& u, int wr, int wc, int fr, int fq) const {
        const int row0 = u.pm * BM + wr * 64 + fr, col0 = (u.pn & 7) * BM + wc * 32 + 8 * fq;
        f32x4 bv[2][2];
#pragma unroll
        for (int bj = 0; bj < 2; ++bj)
#pragma unroll
            for (int n = 0; n < 2; ++n) { if (KIND == 2) bv[bj][n] = (f32x4){0.f, 0.f, 0.f, 0.f}; else bv[bj][n] = *(const f32x4*)((KIND == 0 ? w0 : a0) + col0 + bj * HALF + 4 * n); }
#pragma unroll
        for (int ai = 0; ai < 2; ++ai)
#pragma unroll
            for (int m = 0; m < 4; ++m) { const size_t roff = (size_t)(row0 + ai * HALF + m * 16) * 2048 + col0;
#pragma unroll
                for (int bj = 0; bj < 2; ++bj) { f32x4 v0 = acc[ai][bj][m][0] + bv[bj][0], v1 = acc[ai][bj][m][1] + bv[bj][1];
                    if (KIND == 0) {
                        f32x4 d0, d1;
                        d0.x = -0.60653066f * fast_sigmoid(v0.x); d0.y = -0.60653066f * fast_sigmoid(v0.y); d0.z = -0.60653066f * fast_sigmoid(v0.z); d0.w = -0.60653066f * fast_sigmoid(v0.w);
                        d1.x = -0.60653066f * fast_sigmoid(v1.x); d1.y = -0.60653066f * fast_sigmoid(v1.y); d1.z = -0.60653066f * fast_sigmoid(v1.z); d1.w = -0.60653066f * fast_sigmoid(v1.w);
                        if (!SCAN_CHUNKED) { d0.x = __expf(d0.x); d0.y = __expf(d0.y); d0.z = __expf(d0.z); d0.w = __expf(d0.w); d1.x = __expf(d1.x); d1.y = __expf(d1.y); d1.z = __expf(d1.z); d1.w = __expf(d1.w); }
                        *(f32x4*)(Wd + roff + bj * HALF) = d0; *(f32x4*)(Wd + roff + bj * HALF + 4) = d1;
                    } else {
                        if (KIND == 1) { v0.x = fast_sigmoid(v0.x); v0.y = fast_sigmoid(v0.y); v0.z = fast_sigmoid(v0.z); v0.w = fast_sigmoid(v0.w); v1.x = fast_sigmoid(v1.x); v1.y = fast_sigmoid(v1.y); v1.z = fast_sigmoid(v1.z); v1.w = fast_sigmoid(v1.w); }
                        u32x4 w; w.x = cvt_pk_bf16(v0.x, v0.y); w.y = cvt_pk_bf16(v0.z, v0.w); w.z = cvt_pk_bf16(v1.x, v1.y); w.w = cvt_pk_bf16(v1.z, v1.w);
                        *(u32x4*)((KIND == 1 ? Aa : Gg) + roff + bj * HALF) = w;
                    } } }
    }
    __device__ __forceinline__ void operator()(const f32x4 (&acc)[2][2][4][2], const Unit& u, int wr, int wc, int fr, int fq) const {
        const int kind = u.pn >> 3;
        if (kind == 0) run<0>(acc, u, wr, wc, fr, fq); else if (kind == 1) run<1>(acc, u, wr, wc, fr, fq); else run<2>(acc, u, wr, wc, fr, fq);
    }
};

template <bool ATOM> struct EpiOut {
    static constexpr bool PERM = true, AFTER_DRAIN = false;
    const float* X; float* H1; bf16_t* HB; const float* nw; float* ssq;
    __device__ __forceinline__ void operator()(const f32x4 (&acc)[2][2][4][2], const Unit& u, int wr, int wc, int fr, int fq) const {
        const int row0 = u.pm * BM + wr * 64 + fr, col0 = u.pn * BM + wc * 32 + 8 * fq;
        f32x4 nv[2][2];
#pragma unroll
        for (int bj = 0; bj < 2; ++bj)
#pragma unroll
            for (int n = 0; n < 2; ++n) nv[bj][n] = *(const f32x4*)(nw + col0 + bj * HALF + 4 * n);
#pragma unroll
        for (int ai = 0; ai < 2; ++ai)
#pragma unroll
            for (int m = 0; m < 4; ++m) { const int row = row0 + ai * HALF + m * 16; const size_t roff = (size_t)row * 4096 + col0; float s = 0.f;
#pragma unroll
                for (int bj = 0; bj < 2; ++bj) {
                    const f32x4 x0 = *(const f32x4*)(X + roff + bj * HALF), x1 = *(const f32x4*)(X + roff + bj * HALF + 4);
                    const f32x4 h0 = acc[ai][bj][m][0] + x0, h1 = acc[ai][bj][m][1] + x1;
                    s += (h0[0] * h0[0] + h0[1] * h0[1]) + (h0[2] * h0[2] + h0[3] * h0[3]) + (h1[0] * h1[0] + h1[1] * h1[1]) + (h1[2] * h1[2] + h1[3] * h1[3]);
                    const f32x4 g0 = h0 * nv[bj][0], g1 = h1 * nv[bj][1];
                    u32x4 w; w.x = cvt_pk_bf16(g0[0], g0[1]); w.y = cvt_pk_bf16(g0[2], g0[3]); w.z = cvt_pk_bf16(g1[0], g1[1]); w.w = cvt_pk_bf16(g1[2], g1[3]);
                    *(u32x4*)(HB + roff + bj * HALF) = w; }
                s += __shfl_xor(s, 16); s += __shfl_xor(s, 32);
                if (ATOM && fq == 0) atomicAdd(ssq + row, s); }
    }
};

struct EpiQ {
    static constexpr bool PERM = true, AFTER_DRAIN = false;
    bf16_t* Q; const float* ssq;
    __device__ __forceinline__ void operator()(const f32x4 (&acc)[2][2][4][2], const Unit& u, int wr, int wc, int fr, int fq) const {
        const int row0 = u.pm * BM + wr * 64 + fr, col0 = u.pn * BM + wc * 32 + 8 * fq;
#pragma unroll
        for (int ai = 0; ai < 2; ++ai)
#pragma unroll
            for (int m = 0; m < 4; ++m) { const int row = row0 + ai * HALF + m * 16; const float rs = __builtin_amdgcn_rsqf(ssq[row] * (1.0f / 4096.0f) + 1e-6f);
                bf16_t* rowp = Q + (size_t)row * 2048 + col0;
#pragma unroll
                for (int bj = 0; bj < 2; ++bj) { const f32x4 v0 = acc[ai][bj][m][0] * rs, v1 = acc[ai][bj][m][1] * rs;
                    u32x4 w; w.x = cvt_pk_bf16(v0[0], v0[1]); w.y = cvt_pk_bf16(v0[2], v0[3]); w.z = cvt_pk_bf16(v1[0], v1[1]); w.w = cvt_pk_bf16(v1[2], v1[3]);
                    *(u32x4*)(rowp + bj * HALF) = w; } }
    }
};

template <class Epi, class Sched, bool ALIGN_EPI = false, bool SP2 = false>
__device__ __forceinline__ void gemm_phase(PG8_LAS unsigned char* lds, const Gemm g, const Sched& S, const Epi& E) {
    const int tid = threadIdx.x, wid = __builtin_amdgcn_readfirstlane(tid >> 6), lane = tid & 63, wr = wid >> 2, wc = wid & 3, fr = lane & 15, fq = lane >> 4;
    const int K = g.ld, nt = g.K / BK;
    unsigned voffA[2], voffB[2];
#pragma unroll
    for (int i = 0; i < 2; ++i) { int R, C; stage_rc(tid * 16 + i * 8192, R, C); const int Rb = Epi::PERM ? ((R & ~31) + perm32(R & 31)) : R;
        voffA[i] = (unsigned)(R * K + C) * 2u; voffB[i] = (unsigned)(Rb * K + C) * 2u; }
    const size_t kstep = (size_t)(BK * 2);
    const size_t hstep = (size_t)HALF * K * 2;
    const size_t tstep = 2 * hstep;
    const unsigned ldsw = (unsigned)wid * 1024u;
    const int aoff = lds_byte(wr * 64 + fr, fq * 8), boff = lds_byte(wc * 32 + fr, fq * 8);
#define PG8_SA(b, h) (((b) * 2 + (h)) * HTB)
#define PG8_SB(b, h) ((4 + (b) * 2 + (h)) * HTB)
#define PG8_STAGE(bufoff, gbase, voff) do { _Pragma("unroll") for (int _i = 0; _i < 2; ++_i) \
        __builtin_amdgcn_global_load_lds((const unsigned*)((const char*)(gbase) + (voff)[_i]), (PG8_LAS unsigned*)(lds + (bufoff) + ldsw + _i * 8192), 16, 0, 0); } while (0)
#define PG8_LDA(dst, b, h) do { _Pragma("unroll") for (int m = 0; m < 4; ++m) _Pragma("unroll") for (int k = 0; k < 2; ++k) dst[m][k] = *(const PG8_LAS bf16x8*)(lds + PG8_SA(b, h) + aoff + m * 2048 + k * 1024); } while (0)
#define PG8_LDB(dst, b, h) do { _Pragma("unroll") for (int n = 0; n < 2; ++n) _Pragma("unroll") for (int k = 0; k < 2; ++k) dst[n][k] = *(const PG8_LAS bf16x8*)(lds + PG8_SB(b, h) + boff + n * 2048 + k * 1024); } while (0)
#define PG8_MMA(ai, bj, At, Bt) do { __builtin_amdgcn_s_setprio(1); _Pragma("unroll") for (int m = 0; m < 4; ++m) _Pragma("unroll") for (int n = 0; n < 2; ++n) _Pragma("unroll") for (int k = 0; k < 2; ++k) \
        acc[ai][bj][m][n] = __builtin_amdgcn_mfma_f32_16x16x32_bf16(Bt[n][k], At[m][k], acc[ai][bj][m][n], 0, 0, 0); __builtin_amdgcn_s_setprio(0); } while (0)
#define PG8_WAIT_V(n) asm volatile("s_waitcnt vmcnt(" #n ")" ::: "memory")
#define PG8_WAIT_L(n) asm volatile("s_waitcnt lgkmcnt(" #n ")" ::: "memory")
#define PG8_BAR __builtin_amdgcn_s_barrier()
#define PG8_SCHED __builtin_amdgcn_sched_barrier(0)
    Unit cur, nxt; int ui = 0;
    if (!S.next(0, cur)) return;
    f32x4 acc[2][2][4][2];
#pragma unroll
    for (int a = 0; a < 2; ++a)
#pragma unroll
        for (int b = 0; b < 2; ++b)
#pragma unroll
            for (int m = 0; m < 4; ++m)
#pragma unroll
                for (int n = 0; n < 2; ++n) acc[a][b][m][n] = (f32x4){0.f, 0.f, 0.f, 0.f};
    bf16x8 At[4][2], B0[2][2], B1[2][2];
    const char* cA = (const char*)g.A + (size_t)cur.pm * tstep; const char* cB = (const char*)g.Bt + (size_t)cur.pn * tstep;
    S.a_ready(cur);
    if constexpr (SP2) {
        PG8_STAGE(PG8_SB(0, 0), cB, voffB); PG8_STAGE(PG8_SB(0, 1), cB + hstep, voffB); PG8_STAGE(PG8_SA(0, 0), cA, voffA); PG8_STAGE(PG8_SA(0, 1), cA + hstep, voffA);
        if (wr == 1) PG8_BAR;
        PG8_WAIT_V(2); PG8_BAR;
        PG8_STAGE(PG8_SB(1, 0), cB + kstep, voffB); PG8_STAGE(PG8_SA(1, 0), cA + kstep, voffA); PG8_STAGE(PG8_SB(1, 1), cB + hstep + kstep, voffB);
        PG8_WAIT_V(6); PG8_BAR;
    } else {
        PG8_STAGE(PG8_SB(0, 0), cB, voffB); PG8_STAGE(PG8_SA(0, 0), cA, voffA); PG8_STAGE(PG8_SB(0, 1), cB + hstep, voffB); PG8_STAGE(PG8_SA(0, 1), cA + hstep, voffA);
        if (wr == 1) PG8_BAR;
        PG8_WAIT_V(4); PG8_BAR;
        PG8_STAGE(PG8_SB(1, 0), cB + kstep, voffB); PG8_STAGE(PG8_SA(1, 0), cA + kstep, voffA); PG8_STAGE(PG8_SB(1, 1), cB + hstep + kstep, voffB);
        PG8_WAIT_V(6); PG8_BAR;
    }
    for (;;) {
        const bool has_next = S.next(ui + 1, nxt);
        const char* nA = has_next ? (const char*)g.A + (size_t)nxt.pm * tstep : cA; const char* nB = has_next ? (const char*)g.Bt + (size_t)nxt.pn * tstep : cB;
        for (int t = 0; t < nt; t += 2) {
            const bool last = (t == nt - 2);
            const char* a1 = cA + (size_t)(t + 1) * kstep;
            const char* a2 = last ? nA : cA + (size_t)(t + 2) * kstep; const char* b2 = last ? nB : cB + (size_t)(t + 2) * kstep;
            const char* a3 = a2 + kstep; const char* b3 = b2 + kstep;
            if (last && has_next) S.a_ready(nxt);
            if constexpr (SP2) {
            PG8_LDB(B0, 0, 0); PG8_LDB(B1, 0, 1); PG8_SCHED; PG8_LDA(At, 0, 0); PG8_STAGE(PG8_SA(1, 1), a1 + hstep, voffA);
            PG8_WAIT_V(8); PG8_WAIT_L(0); PG8_BAR; PG8_MMA(0, 0, At, B0); PG8_MMA(0, 1, At, B1); PG8_BAR; PG8_SCHED;
            PG8_LDA(At, 0, 1); PG8_STAGE(PG8_SB(0, 0), b2, voffB); PG8_STAGE(PG8_SB(0, 1), b2 + hstep, voffB); PG8_STAGE(PG8_SA(0, 0), a2, voffA);
            PG8_WAIT_V(8); PG8_WAIT_L(0); PG8_BAR; PG8_MMA(1, 0, At, B0); PG8_MMA(1, 1, At, B1); PG8_BAR; PG8_SCHED;
            PG8_LDB(B0, 1, 0); PG8_LDB(B1, 1, 1); PG8_SCHED; PG8_LDA(At, 1, 0); PG8_STAGE(PG8_SA(0, 1), a2 + hstep, voffA);
            PG8_WAIT_V(8); PG8_WAIT_L(0); PG8_BAR; PG8_MMA(0, 0, At, B0); PG8_MMA(0, 1, At, B1); PG8_BAR; PG8_SCHED;
            PG8_LDA(At, 1, 1); PG8_STAGE(PG8_SB(1, 0), b3, voffB); PG8_STAGE(PG8_SB(1, 1), b3 + hstep, voffB); PG8_STAGE(PG8_SA(1, 0), a3, voffA);
            PG8_WAIT_V(8); PG8_WAIT_L(0); PG8_BAR; PG8_MMA(1, 0, At, B0); PG8_MMA(1, 1, At, B1); PG8_BAR; PG8_SCHED;
            } else {
            PG8_LDB(B0, 0, 0); PG8_SCHED; PG8_LDA(At, 0, 0); PG8_STAGE(PG8_SA(1, 1), a1 + hstep, voffA);
            PG8_WAIT_L(8); PG8_BAR; PG8_WAIT_L(0); PG8_MMA(0, 0, At, B0); PG8_BAR; PG8_SCHED;
            PG8_LDB(B1, 0, 1); PG8_STAGE(PG8_SB(0, 0), b2, voffB);
            PG8_BAR; PG8_WAIT_L(0); PG8_MMA(0, 1, At, B1); PG8_BAR;
            PG8_LDA(At, 0, 1); PG8_STAGE(PG8_SA(0, 0), a2, voffA);
            PG8_BAR; PG8_WAIT_L(0); PG8_MMA(1, 0, At, B0); PG8_BAR; PG8_SCHED;
            PG8_STAGE(PG8_SB(0, 1), b2 + hstep, voffB);
            PG8_WAIT_V(6); PG8_BAR; PG8_MMA(1, 1, At, B1); PG8_BAR;
            PG8_LDB(B0, 1, 0); PG8_SCHED; PG8_LDA(At, 1, 0); PG8_STAGE(PG8_SA(0, 1), a2 + hstep, voffA);
            PG8_WAIT_L(8); PG8_BAR; PG8_WAIT_L(0); PG8_MMA(0, 0, At, B0); PG8_BAR; PG8_SCHED;
            PG8_LDB(B1, 1, 1); PG8_STAGE(PG8_SB(1, 0), b3, voffB);
            PG8_BAR; PG8_WAIT_L(0); PG8_MMA(0, 1, At, B1); PG8_BAR;
            PG8_LDA(At, 1, 1); PG8_STAGE(PG8_SA(1, 0), a3, voffA);
            PG8_BAR; PG8_WAIT_L(0); PG8_MMA(1, 0, At, B0); PG8_BAR; PG8_SCHED;
            PG8_STAGE(PG8_SB(1, 1), b3 + hstep, voffB);
            PG8_WAIT_V(6); PG8_BAR; PG8_MMA(1, 1, At, B1); PG8_BAR;
            }
        }
        if constexpr (ALIGN_EPI) { if (wr == 0) PG8_BAR; }
        if constexpr (!Epi::AFTER_DRAIN) { E(acc, cur, wr, wc, fr, fq); S.done(cur); }
        if (!has_next) break;
#pragma unroll
        for (int a = 0; a < 2; ++a)
#pragma unroll
            for (int b = 0; b < 2; ++b)
#pragma unroll
                for (int m = 0; m < 4; ++m)
#pragma unroll
                    for (int n = 0; n < 2; ++n) acc[a][b][m][n] = (f32x4){0.f, 0.f, 0.f, 0.f};
        cur = nxt; cA = nA; cB = nB; ++ui;
        if constexpr (ALIGN_EPI) { if (wr == 1) PG8_BAR; }
    }
    PG8_WAIT_V(0);
    if constexpr (!ALIGN_EPI) { if (wr == 0) PG8_BAR; }
    PG8_BAR;
    if constexpr (Epi::AFTER_DRAIN) { E.fused(acc, cur, wr, wc, fr, fq, lds, wid, lane); S.done(cur); }
#undef PG8_SA
#undef PG8_SB
#undef PG8_STAGE
#undef PG8_LDA
#undef PG8_LDB
#undef PG8_MMA
#undef PG8_WAIT_V
#undef PG8_WAIT_L
#undef PG8_BAR
#undef PG8_SCHED
}
}


#define GAS __attribute__((address_space(1)))
#define LAS __attribute__((address_space(3)))
typedef unsigned short bf16;
typedef unsigned v4u __attribute__((ext_vector_type(4)));
typedef int v8i __attribute__((ext_vector_type(8)));
typedef unsigned v2u __attribute__((ext_vector_type(2)));
typedef float f32x4 __attribute__((ext_vector_type(4)));
typedef float f32x2 __attribute__((ext_vector_type(2)));
#define RLX_AGENT __ATOMIC_RELAXED, __HIP_MEMORY_SCOPE_AGENT
#define LDS_WAIT() asm volatile("s_waitcnt lgkmcnt(0)" ::: "memory")
#define VM_WAIT() asm volatile("s_waitcnt vmcnt(0)" ::: "memory")

constexpr int NWAVES = 8, NTHREADS = 512;
#ifndef MK_N_LAUNCHES
#define MK_N_LAUNCHES 1
#endif
constexpr int D = 4096, BATCH = 2, SEQ = 4096, M = BATCH * SEQ;
constexpr int RW = 2048, CW = 2048, NH = 32, HD = 64;
constexpr int RWKV_IN = 6592, IN_TOTAL = 12736, NWIN = 12800, NPROJ = 12288;
constexpr int COL_R = 0, COL_K = 2048, COL_V = 4096, COL_CB = 6144, COL_CC = 8192, COL_CH = 10240;
constexpr int SRC_WL = 6144, NLIN = 448, KSPLIT = 4, SLABW = 512;
constexpr int KLORA = 512, NLORA = 6144;
constexpr int PH = 8, NKEYS = 128, NEXP = 16384, PQ = 256, TOPK = 16;
constexpr int NPHASES = 12;

constexpr size_t MiB = 1u << 20;
constexpr size_t WS_CTL = 0, CTL_ZERO_BYTES = 64 * 1024;
constexpr size_t WS_SSQ = 1 * MiB;
constexpr size_t WS_DSCALE = WS_SSQ + 64 * 1024;
constexpr size_t WS_USCALE = WS_DSCALE + 64 * 1024;
constexpr size_t WS_BONUS = 2 * MiB;
constexpr size_t WS_WLORA = 4 * MiB;
constexpr size_t WS_WQT = 10 * MiB;
constexpr size_t WS_WOUTT = 26 * MiB;
constexpr size_t WS_WINT = 58 * MiB;
constexpr size_t WS_XN = 158 * MiB;
constexpr size_t WS_PROJ = 222 * MiB;
constexpr size_t WS_LIN = 422 * MiB;
constexpr size_t WS_WD = 430 * MiB;
constexpr size_t WS_AA = 494 * MiB;
constexpr size_t WS_G = 526 * MiB;
constexpr size_t WS_R = 558 * MiB, WS_K = 590 * MiB, WS_KK = 622 * MiB, WS_BB = 654 * MiB;
constexpr size_t WS_REC = 558 * MiB;
constexpr size_t WS_V = 750 * MiB;
constexpr size_t WS_SLAB = 718 * MiB;
constexpr size_t WS_Y = WS_WD;
constexpr size_t WS_MIXED = 782 * MiB;
constexpr size_t WS_Q = 846 * MiB;
constexpr size_t WS_EIDX = 878 * MiB;
constexpr size_t WS_GATE = 882 * MiB;
constexpr size_t WS_DQ = 886 * MiB;
constexpr size_t WS_UQ = 950 * MiB;
constexpr size_t WS_SKB = 1016 * MiB;
constexpr size_t WS_BR = 1014 * MiB, WS_KR = 1015 * MiB;
constexpr size_t WS_END = 1017 * MiB;

constexpr int CW_BAR = 1024;

constexpr int RING_OFF = 0, RING_BYTES = 131072;
constexpr int LDSCTL_OFF = 147456, MISC_OFF = LDSCTL_OFF + 64;
constexpr int LDS_BYTES = 147456 + 512;

__device__ __forceinline__ unsigned f2bf(float f) { unsigned u = __builtin_bit_cast(unsigned, f); return (u + 0x7fffu + ((u >> 16) & 1u)) >> 16; }
typedef __bf16 bf16x2v __attribute__((ext_vector_type(2)));
__device__ __forceinline__ unsigned pk2(float lo, float hi) { const bf16x2v r = __builtin_convertvector((f32x2){lo, hi}, bf16x2v); return __builtin_bit_cast(unsigned, r); }
__device__ __forceinline__ float bflo(unsigned w) { return __builtin_bit_cast(float, w << 16); }
__device__ __forceinline__ float bfhi(unsigned w) { return __builtin_bit_cast(float, w & 0xffff0000u); }
__device__ __forceinline__ float wave_sum(float v) {
#pragma unroll
    for (int o = 1; o < 64; o <<= 1) v += __shfl_xor(v, o);
    return v;
}
__device__ __forceinline__ float wave_max(float v) {
#pragma unroll
    for (int o = 1; o < 64; o <<= 1) v = fmaxf(v, __shfl_xor(v, o));
    return v;
}
__device__ __forceinline__ float sigmoidf_(float v) { return 1.0f / (1.0f + __expf(-v)); }

#define XB_TMO      128
#define XB_XCNT(j)  (256  + 64 * (j))
#define XB_XSUB(j)  (1280 + 64 * (j))
#define XB_XGEN(j)  (2304 + 64 * (j))
#define XB_TOP      3328
#define XB_TOPGEN   3392
#define XCD_BAR_WORDS 3456
#define XB_SPIN_CAP (1u << 22)
__device__ __forceinline__ unsigned xb_ld(unsigned* p)              { return __hip_atomic_load(p, __ATOMIC_RELAXED, __HIP_MEMORY_SCOPE_AGENT); }
__device__ __forceinline__ unsigned xb_add(unsigned* p, unsigned v) { return __hip_atomic_fetch_add(p, v, __ATOMIC_RELAXED, __HIP_MEMORY_SCOPE_AGENT); }
__device__ __forceinline__ unsigned xb_xcc_id() { return (unsigned)__builtin_amdgcn_s_getreg((3 << 11) | 20) & 0xFu; }
#define XB_SPIN(cond, bar) do { unsigned _sp = 0; while (cond) { __builtin_amdgcn_s_sleep(1); \
    if ((++_sp & 255u) == 0u) { if (xb_ld(&(bar)[XB_TMO])) break; if (_sp > XB_SPIN_CAP) { atomicAdd(&(bar)[XB_TMO], 1u); break; } } } } while (0)
struct XcdBarrier { unsigned* bar; unsigned x; volatile LAS unsigned* st; };
__device__ __forceinline__ XcdBarrier xcd_barrier_post(unsigned* bar, volatile LAS unsigned* st) {
    XcdBarrier b; b.bar = bar; b.x = xb_xcc_id(); b.st = st;
    if (threadIdx.x == 0) (void)xb_add(&bar[XB_XCNT(b.x)], 1u);
    return b;
}
__device__ __forceinline__ void xcd_barrier_complete(unsigned* bar, unsigned x, unsigned& nloc, unsigned& nx) {
    const unsigned G = gridDim.x * gridDim.y * gridDim.z;
    unsigned sum, cnt, mine, sp = 0u;
    for (;;) {
        sum = 0u; cnt = 0u; mine = 0u;
#pragma unroll
        for (unsigned j = 0; j < 16; ++j) { const unsigned c = xb_ld(&bar[XB_XCNT(j)]); sum += c; cnt += (c > 0u) ? 1u : 0u; mine = (j == x) ? c : mine; }
        if (sum == G) break;
        __builtin_amdgcn_s_sleep(1);
        if ((++sp & 255u) == 0u) { if (xb_ld(&bar[XB_TMO])) break; if (sp > XB_SPIN_CAP) { atomicAdd(&bar[XB_TMO], 1u); break; } }
    }
    nloc = mine > 0u ? mine : 1u; nx = cnt > 0u ? cnt : 1u;
}
__device__ __forceinline__ void xcd_barrier(const XcdBarrier& b) {
    asm volatile("s_waitcnt vmcnt(0)" ::: "memory");
    __syncthreads();
    if (threadIdx.x == 0) {
        unsigned* bar = b.bar;
        __builtin_amdgcn_s_waitcnt(0);
        unsigned nloc = b.st[0], nx = b.st[1];
        if (nloc == 0u) { xcd_barrier_complete(bar, b.x, nloc, nx); b.st[0] = nloc; b.st[1] = nx; }
        const unsigned old = xb_add(&bar[XB_XSUB(b.x)], 1u);
        const unsigned gen = old / nloc;
        if (old + 1u == (gen + 1u) * nloc) {
            __builtin_amdgcn_fence(__ATOMIC_RELEASE, "agent");
            asm volatile("s_waitcnt vmcnt(0)" ::: "memory");
            const unsigned og = xb_add(&bar[XB_TOP], 1u);
            const unsigned tg = og / nx;
            if (og + 1u == (tg + 1u) * nx) xb_add(&bar[XB_TOPGEN], 1u);
            else XB_SPIN(xb_ld(&bar[XB_TOPGEN]) == tg, bar);
            __builtin_amdgcn_fence(__ATOMIC_ACQUIRE, "agent");
            xb_add(&bar[XB_XGEN(b.x)], 1u);
            asm volatile("s_waitcnt vmcnt(0)" ::: "memory");
        } else {
            XB_SPIN(xb_ld(&bar[XB_XGEN(b.x)]) == gen, bar);
            __builtin_amdgcn_fence(__ATOMIC_ACQUIRE, "agent");
            asm volatile("s_waitcnt vmcnt(0)" ::: "memory");
        }
    }
    __syncthreads();
}

struct Args {
    const float* in[22]; float* out; unsigned char* ws; int ph_lo, ph_hi, li, pad;
};

template <bool WIN> __device__ __forceinline__ void p0_transpose_item(const float* W, int K, int N, bf16* WT, LAS float* scr, int item, int lane) {
    const int nblk = N / 32, kb = item / nblk, nb = item % nblk, k0 = 64 * kb, n0 = 32 * nb;
    const int d0 = !WIN ? n0 : (n0 < SRC_WL ? n0 : (n0 < RWKV_IN ? NPROJ + (n0 - SRC_WL) : n0 - NLIN));
#pragma unroll 8
    for (int i = 0; i < 32; ++i) { const int kk = 2 * i + (lane >> 5); scr[kk * 33 + (lane & 31)] = W[(size_t)(k0 + kk) * N + n0 + (lane & 31)]; }
    LDS_WAIT(); asm volatile("" ::: "memory");
    const int c = lane & 7;
#pragma unroll
    for (int j = 0; j < 4; ++j) { const int n = (lane >> 3) + 8 * j; const LAS float* s = scr + (8 * c) * 33 + n;
        v4u o; o.x = pk2(s[0 * 33], s[1 * 33]); o.y = pk2(s[2 * 33], s[3 * 33]); o.z = pk2(s[4 * 33], s[5 * 33]); o.w = pk2(s[6 * 33], s[7 * 33]);
        *(GAS v4u*)(WT + (size_t)(d0 + n) * K + k0 + 8 * c) = o; }
    LDS_WAIT(); asm volatile("" ::: "memory");
}

#ifndef PEER_FP6
#define PEER_FP6 1
#endif
#ifndef PEER_UP_FP4
#define PEER_UP_FP4 1
#endif
constexpr int ROWB = PEER_FP6 ? 3072 : 4096;
#ifndef PEER_DN_FP4
#define PEER_DN_FP4 1
#define PEER_DN_MFMA 1
#endif
constexpr int ROWB_DN = PEER_DN_FP4 ? 2048 : ROWB;
constexpr int ROWB_UP = PEER_UP_FP4 ? 2048 : ROWB;
typedef float f32x16v __attribute__((ext_vector_type(16)));
typedef float f32x32v __attribute__((ext_vector_type(32)));
typedef unsigned v6u __attribute__((ext_vector_type(6)));
__device__ __forceinline__ void quant_pack_store(const f32x4 (&v)[16], float am, unsigned char* dst, float* scp, int lane, bool fp4 = false) {
    if ((PEER_UP_FP4 || PEER_DN_FP4) && fp4) {
        const float s4 = am > 0.f ? 6.0f / am : 1.0f;
        if (lane == 0) *scp = am > 0.f ? am * (1.0f / 6.0f) : 1.0f;
        unsigned d4[8];
#pragma unroll
        for (int w = 0; w < 8; ++w) { unsigned p = 0u;
#define FP4_PK(b2) { const int t0 = 8 * w + 2 * (b2); p = (unsigned)__builtin_amdgcn_cvt_scalef32_pk_fp4_f32(p, v[t0 >> 2][t0 & 3] * s4, v[(t0 + 1) >> 2][(t0 + 1) & 3] * s4, 1.0f, b2); }
            FP4_PK(0) FP4_PK(1) FP4_PK(2) FP4_PK(3)
#undef FP4_PK
            d4[w] = p; }
        *(GAS v4u*)(dst + lane * 16) = (v4u){d4[0], d4[1], d4[2], d4[3]}; *(GAS v4u*)(dst + 1024 + lane * 16) = (v4u){d4[4], d4[5], d4[6], d4[7]};
        return;
    }
    constexpr float QMAX = PEER_FP6 ? 7.5f : 448.0f;
    const float s = am > 0.f ? QMAX / am : 1.0f;
    if (lane == 0) *scp = am > 0.f ? am * (1.0f / QMAX) : 1.0f;
#if PEER_FP6
    unsigned d[12];
#pragma unroll
    for (int g = 0; g < 2; ++g) { f32x16v x0, x1;
#pragma unroll
        for (int i = 0; i < 16; ++i) { const int t0 = 32 * g + 2 * i, t1 = t0 + 1;
            x0[i] = v[t0 >> 2][t0 & 3] * s; x1[i] = v[t1 >> 2][t1 & 3] * s; }
        const v6u pk = __builtin_amdgcn_cvt_scalef32_2xpk16_fp6_f32(x0, x1, 1.0f);
#pragma unroll
        for (int k = 0; k < 6; ++k) d[g * 6 + k] = pk[k]; }
#pragma unroll
    for (int c = 0; c < 3; ++c) *(GAS v4u*)(dst + c * 1024 + lane * 16) = (v4u){d[4 * c], d[4 * c + 1], d[4 * c + 2], d[4 * c + 3]};
#else
#pragma unroll
    for (int i = 0; i < 4; ++i) { v4u o;
#pragma unroll
        for (int j = 0; j < 4; ++j) { const f32x4 x = v[i * 4 + j] * s; int p = __builtin_amdgcn_cvt_pk_fp8_f32(x.x, x.y, 0, false); p = __builtin_amdgcn_cvt_pk_fp8_f32(x.z, x.w, p, true); o[j] = (unsigned)p; }
        *(GAS v4u*)(dst + i * 1024 + lane * 16) = o; }
#endif
}
__device__ __forceinline__ void load_qrow(const unsigned char* rp  , float (&e)[64]) {
#if PEER_FP6
    const v4u c0 = *(const GAS v4u*)(rp), c1 = *(const GAS v4u*)(rp + 1024), c2 = *(const GAS v4u*)(rp + 2048);
    const v6u pa = (v6u){c0.x, c0.y, c0.z, c0.w, c1.x, c1.y}, pb = (v6u){c1.z, c1.w, c2.x, c2.y, c2.z, c2.w};
    const f32x32v ra = __builtin_amdgcn_cvt_scalef32_pk32_f32_fp6(pa, 1.0f), rb = __builtin_amdgcn_cvt_scalef32_pk32_f32_fp6(pb, 1.0f);
#pragma unroll
    for (int k = 0; k < 32; ++k) { e[k] = ra[k]; e[32 + k] = rb[k]; }
#else
#pragma unroll
    for (int i = 0; i < 4; ++i) { const v4u w = *(const GAS v4u*)(rp + i * 1024);
#pragma unroll
        for (int j = 0; j < 4; ++j) { const f32x2 lo = __builtin_amdgcn_cvt_pk_f32_fp8(w[j], false), hi = __builtin_amdgcn_cvt_pk_f32_fp8(w[j], true);
            e[i * 16 + j * 4 + 0] = lo.x; e[i * 16 + j * 4 + 1] = lo.y; e[i * 16 + j * 4 + 2] = hi.x; e[i * 16 + j * 4 + 3] = hi.y; } }
#endif
}
__device__ __forceinline__ void p0_quant_row(const float* src, unsigned char* dst, float* sc, int lane, bool fp4 = false) {
    f32x4 v[16]; float am = 0.f;
#pragma unroll
    for (int i = 0; i < 4; ++i)
#pragma unroll
        for (int j = 0; j < 4; ++j) { v[i * 4 + j] = *(const GAS f32x4*)(src + (i * 4 + j) * 256 + lane * 4);
            am = fmaxf(am, fmaxf(fmaxf(fabsf(v[i * 4 + j].x), fabsf(v[i * 4 + j].y)), fmaxf(fabsf(v[i * 4 + j].z), fabsf(v[i * 4 + j].w)))); }
    am = wave_max(am);
    quant_pack_store(v, am, dst, sc, lane, fp4);
}

__device__ __forceinline__ void quant_rows(const Args& a, int first, int stride, int lane) {
    unsigned char* ws = a.ws;
    f32x4 cur[16], nxt[16];
    auto srcp = [&](int r) { return r < NEXP ? a.in[19] + (size_t)r * D : a.in[20] + (size_t)(r - NEXP) * D; };
    if (first < 2 * NEXP) { const float* p = srcp(first);
#pragma unroll
        for (int k = 0; k < 16; ++k) cur[k] = *(const GAS f32x4*)(p + k * 256 + lane * 4); }
    for (int r = first; r < 2 * NEXP; r += stride) {
        const int rn = r + stride;
        if (rn < 2 * NEXP) { const float* p = srcp(rn);
#pragma unroll
            for (int k = 0; k < 16; ++k) nxt[k] = *(const GAS f32x4*)(p + k * 256 + lane * 4); }
        float am = 0.f;
#pragma unroll
        for (int k = 0; k < 16; ++k) am = fmaxf(am, fmaxf(fmaxf(fabsf(cur[k].x), fabsf(cur[k].y)), fmaxf(fabsf(cur[k].z), fabsf(cur[k].w))));
        am = wave_max(am);
        if (r < NEXP) quant_pack_store(cur, am, ws + WS_DQ + (size_t)r * ROWB_DN, (float*)(ws + WS_DSCALE) + r, lane, PEER_DN_FP4 != 0);
        else quant_pack_store(cur, am, ws + WS_UQ + (size_t)(r - NEXP) * ROWB_UP, (float*)(ws + WS_USCALE) + (r - NEXP), lane, true);
#pragma unroll
        for (int k = 0; k < 16; ++k) cur[k] = nxt[k];
    }
}

#ifndef QUANT_IN_SCAN
#define QUANT_IN_SCAN 1
#endif
__device__ __forceinline__ void phase0(const Args& a, LAS unsigned char* lds, int gw, int NGW, int wave, int lane) {
    unsigned char* ws = a.ws;
    LAS float* scr = (LAS float*)(lds + RING_OFF + wave * 16384);
    constexpr int I_IN = (D / 64) * (IN_TOTAL / 32), I_OUT = (D / 64) * (D / 32), I_Q = (D / 64) * (2048 / 32);
    for (int it = gw; it < I_IN + I_OUT + I_Q; it += NGW) {
        int r = it;
        if (r < I_IN) { p0_transpose_item<true>(a.in[2], D, IN_TOTAL, (bf16*)(ws + WS_WINT), scr, r, lane); continue; } r -= I_IN;
        if (r < I_OUT) { p0_transpose_item<false>(a.in[15], D, D, (bf16*)(ws + WS_WOUTT), scr, r, lane); continue; } r -= I_OUT;
        p0_transpose_item<false>(a.in[17], D, 2048, (bf16*)(ws + WS_WQT), scr, r, lane);
    }
    const int gt = gw * 64 + lane, NGT = NGW * 64;
    { GAS v4u* p = (GAS v4u*)(ws + WS_WINT + (size_t)IN_TOTAL * D * 2);
      for (int i = gt; i < (NWIN - IN_TOTAL) * D * 2 / 16; i += NGT) p[i] = (v4u){0u, 0u, 0u, 0u}; }
    { const float* sk = a.in[18]; bf16* SKB = (bf16*)(ws + WS_SKB);
      for (int i = gt; i < PH * 2 * NKEYS * 128 / 8; i += NGT) { const f32x4 v0 = *(const GAS f32x4*)(sk + (size_t)i * 8), v1 = *(const GAS f32x4*)(sk + (size_t)i * 8 + 4);
          v4u o; o.x = pk2(v0.x, v0.y); o.y = pk2(v0.z, v0.w); o.z = pk2(v1.x, v1.y); o.w = pk2(v1.z, v1.w); *(GAS v4u*)(SKB + (size_t)i * 8) = o; } }
    { float* p = (float*)(ws + WS_SSQ); for (int i = gt; i < M; i += NGT) p[i] = 0.f; }
    { bf16* WL = (bf16*)(ws + WS_WLORA); const float* w2 = a.in[5]; const float* a2 = a.in[7]; const float* g2 = a.in[8];
      for (int it = gw; it < (KLORA / 64) * (NLORA / 32); it += NGW) {
          const int kb = it / (NLORA / 32), nb = it % (NLORA / 32), k0 = 64 * kb, n0 = 32 * nb, kind = n0 >> 11, cb = (n0 & 2047) + (lane & 31);
          const float* srcw = kind == 0 ? w2 : (kind == 1 ? a2 : g2); const int klo = kind == 0 ? 0 : (kind == 1 ? 96 : 192), khi = kind == 0 ? 96 : (kind == 1 ? 192 : 448);
#pragma unroll 8
          for (int i = 0; i < 32; ++i) { const int kk = 2 * i + (lane >> 5), k = k0 + kk; scr[kk * 33 + (lane & 31)] = (k >= klo && k < khi) ? srcw[(size_t)(k - klo) * 2048 + cb] : 0.f; }
          LDS_WAIT(); asm volatile("" ::: "memory");
          const int c = lane & 7;
#pragma unroll
          for (int j = 0; j < 4; ++j) { const int n = (lane >> 3) + 8 * j; const LAS float* s = scr + (8 * c) * 33 + n;
              v4u o; o.x = pk2(s[0 * 33], s[1 * 33]); o.y = pk2(s[2 * 33], s[3 * 33]); o.z = pk2(s[4 * 33], s[5 * 33]); o.w = pk2(s[6 * 33], s[7 * 33]);
              *(GAS v4u*)(WL + (size_t)(n0 + n) * KLORA + k0 + 8 * c) = o; }
          LDS_WAIT(); asm volatile("" ::: "memory");
      } }
    { const float* x = a.in[0]; const float* nw = a.in[1]; bf16* XN = (bf16*)(ws + WS_XN);
      for (int m = gw; m < M; m += NGW) {
          f32x4 v[16]; float s = 0.f;
#pragma unroll
          for (int c = 0; c < 8; ++c)
#pragma unroll
              for (int j = 0; j < 2; ++j) { const f32x4 t = *(const GAS f32x4*)(x + (size_t)m * D + c * 512 + lane * 8 + j * 4); v[c * 2 + j] = t; s += (t.x * t.x + t.y * t.y) + (t.z * t.z + t.w * t.w); }
          const float rs = 1.0f / sqrtf(wave_sum(s) * (1.0f / D) + 1e-6f);
#pragma unroll
          for (int c = 0; c < 8; ++c) { const f32x4 w0 = *(const GAS f32x4*)(nw + c * 512 + lane * 8), w1 = *(const GAS f32x4*)(nw + c * 512 + lane * 8 + 4);
              const f32x4 p = v[c * 2] * rs * w0, q = v[c * 2 + 1] * rs * w1;
              v4u o; o.x = pk2(p.x, p.y); o.y = pk2(p.z, p.w); o.z = pk2(q.x, q.y); o.w = pk2(q.z, q.w);
              *(GAS v4u*)(XN + (size_t)m * D + c * 512 + lane * 8) = o; }
      } }
    if (!QUANT_IN_SCAN) { const float* ed = a.in[19]; const float* eu = a.in[20];
      for (int r = gw; r < 2 * NEXP; r += NGW) {
          if (r < NEXP) p0_quant_row(ed + (size_t)r * D, ws + WS_DQ + (size_t)r * ROWB_DN, (float*)(ws + WS_DSCALE) + r, lane, PEER_DN_FP4 != 0);
          else { const int e = r - NEXP; p0_quant_row(eu + (size_t)e * D, ws + WS_UQ + (size_t)e * ROWB_UP, (float*)(ws + WS_USCALE) + e, lane, true); } } }
}

__device__ __forceinline__ void unpack8(const v4u w, float (&f)[8]) {
    f[0] = bflo(w.x); f[1] = bfhi(w.x); f[2] = bflo(w.y); f[3] = bfhi(w.y); f[4] = bflo(w.z); f[5] = bfhi(w.z); f[6] = bflo(w.w); f[7] = bfhi(w.w);
}
__device__ __forceinline__ v4u pack8(const float (&f)[8]) { v4u o; o.x = pk2(f[0], f[1]); o.y = pk2(f[2], f[3]); o.z = pk2(f[4], f[5]); o.w = pk2(f[6], f[7]); return o; }

__device__ __forceinline__ void phase2(const Args& a, int gt, int NGT) {
    unsigned char* ws = a.ws;
    const bf16* P = (const bf16*)(ws + WS_PROJ); const float* mu = a.in[3]; const float* cw = a.in[14];
    bf16* LIN = (bf16*)(ws + WS_LIN); bf16* MIX = (bf16*)(ws + WS_MIXED);
    const v4u z4 = (v4u){0u, 0u, 0u, 0u};
    const float* SL = (const float*)(ws + WS_SLAB);
    for (int it = gt; it < M * 64; it += NGT) {
        const int m = it >> 6, j0 = (it & 63) * 8, t = m & (SEQ - 1);
        v4u o = z4;
        if (j0 < NLIN) {
            f32x4 p0 = (f32x4){0.f, 0.f, 0.f, 0.f}, p1 = p0, q0 = p0, q1 = p0;
#pragma unroll
            for (int ks = 0; ks < KSPLIT; ++ks) { const float* sp = SL + ((size_t)ks * M + m) * SLABW + j0;
                p0 += *(const GAS f32x4*)(sp); p1 += *(const GAS f32x4*)(sp + 4);
                if (t > 0) { q0 += *(const GAS f32x4*)(sp - SLABW); q1 += *(const GAS f32x4*)(sp - SLABW + 4); } }
            const f32x4 m0 = *(const GAS f32x4*)(mu + SRC_WL + j0), m1 = *(const GAS f32x4*)(mu + SRC_WL + j0 + 4);
            float r[8];
#pragma unroll
            for (int j = 0; j < 8; ++j) { const float p = j < 4 ? p0[j] : p1[j - 4], q = j < 4 ? q0[j] : q1[j - 4], mm = j < 4 ? m0[j] : m1[j - 4]; const float ps = p + (q - p) * mm;
                r[j] = j0 < 96 ? tanhf(ps) : (j0 < 192 ? ps : sigmoidf_(ps)); }
            o = pack8(r);
        }
        *(GAS v4u*)(LIN + (size_t)m * KLORA + j0) = o;
    }
    for (int it = gt; it < M * 256; it += NGT) {
        const int m = it >> 8, c0 = (it & 255) * 8, t = m & (SEQ - 1);
        const bf16* row = P + (size_t)m * NPROJ;
        float bg[8], c_[8], h_[8], z0[8], z1[8], z2[8], y[8];
        unpack8(*(const GAS v4u*)(row + COL_CB + c0), bg); unpack8(*(const GAS v4u*)(row + COL_CC + c0), c_); unpack8(*(const GAS v4u*)(row + COL_CH + c0), h_);
#pragma unroll
        for (int j = 0; j < 8; ++j) z0[j] = c_[j] * h_[j];
        if (t >= 1) { unpack8(*(const GAS v4u*)(row - NPROJ + COL_CC + c0), c_); unpack8(*(const GAS v4u*)(row - NPROJ + COL_CH + c0), h_);
#pragma unroll
            for (int j = 0; j < 8; ++j) z1[j] = c_[j] * h_[j]; }
        else {
#pragma unroll
            for (int j = 0; j < 8; ++j) z1[j] = 0.f; }
        if (t >= 2) { unpack8(*(const GAS v4u*)(row - 2 * NPROJ + COL_CC + c0), c_); unpack8(*(const GAS v4u*)(row - 2 * NPROJ + COL_CH + c0), h_);
#pragma unroll
            for (int j = 0; j < 8; ++j) z2[j] = c_[j] * h_[j]; }
        else {
#pragma unroll
            for (int j = 0; j < 8; ++j) z2[j] = 0.f; }
        const float* cwp = cw + c0 * 3;
#pragma unroll
        for (int j = 0; j < 8; ++j) y[j] = bg[j] * (cwp[j * 3 + 0] * z2[j] + cwp[j * 3 + 1] * z1[j] + cwp[j * 3 + 2] * z0[j]);
        *(GAS v4u*)(MIX + (size_t)m * D + RW + c0) = pack8(y);
    }
}

__device__ __forceinline__ void phase4(const Args& a, int gw, int NGW, int lane) {
    unsigned char* ws = a.ws;
    const bf16* P = (const bf16*)(ws + WS_PROJ); const float* mu = a.in[3]; const bf16* AA = (const bf16*)(ws + WS_AA);
    const float* k_k = a.in[9]; const float* k_a = a.in[10]; const float* r_k = a.in[11];
    bf16* R = (bf16*)(ws + WS_R); bf16* K = (bf16*)(ws + WS_K); bf16* KK = (bf16*)(ws + WS_KK); bf16* BB = (bf16*)(ws + WS_BB); bf16* V = (bf16*)(ws + WS_V);
    float* BON = (float*)(ws + WS_BONUS);
    const v4u z4 = (v4u){0u, 0u, 0u, 0u};
    for (int it = gw; it < M * 4; it += NGW) {
        const int m = it >> 2, ch = (it & 3) * 512 + lane * 8, t = m & (SEQ - 1);
        const bf16* row = P + (size_t)m * NPROJ;
        float r[8], k[8], v[8], q[8], av[8];
        auto lerp8 = [&](int col, float (&o)[8]) {
            unpack8(*(const GAS v4u*)(row + col + ch), o); unpack8(t > 0 ? *(const GAS v4u*)(row - NPROJ + col + ch) : z4, q);
            const f32x4 m0 = *(const GAS f32x4*)(mu + col + ch), m1 = *(const GAS f32x4*)(mu + col + ch + 4);
#pragma unroll
            for (int j = 0; j < 8; ++j) o[j] = o[j] + (q[j] - o[j]) * (j < 4 ? m0[j] : m1[j - 4]);
        };
        lerp8(COL_R, r); lerp8(COL_K, k); lerp8(COL_V, v);
        unpack8(*(const GAS v4u*)(AA + (size_t)m * RW + ch), av);
        float kk[8], kp[8], bb[8]; float ss = 0.f, bn = 0.f, kr = 0.f, brs = 0.f;
        const f32x4 kk0 = *(const GAS f32x4*)(k_k + ch), kk1 = *(const GAS f32x4*)(k_k + ch + 4), ka0 = *(const GAS f32x4*)(k_a + ch), ka1 = *(const GAS f32x4*)(k_a + ch + 4);
        const f32x4 rk0 = *(const GAS f32x4*)(r_k + ch), rk1 = *(const GAS f32x4*)(r_k + ch + 4);
#pragma unroll
        for (int j = 0; j < 8; ++j) { kk[j] = k[j] * (j < 4 ? kk0[j] : kk1[j - 4]); ss += kk[j] * kk[j];
            kp[j] = k[j] * (1.0f + (av[j] - 1.0f) * (j < 4 ? ka0[j] : ka1[j - 4])); bn += r[j] * kp[j] * (j < 4 ? rk0[j] : rk1[j - 4]); kr += r[j] * kp[j]; }
        ss += __shfl_xor(ss, 1); ss += __shfl_xor(ss, 2); ss += __shfl_xor(ss, 4);
        bn += __shfl_xor(bn, 1); bn += __shfl_xor(bn, 2); bn += __shfl_xor(bn, 4);
        const float inv = 1.0f / sqrtf(fmaxf(ss, 1e-24f));
#pragma unroll
        for (int j = 0; j < 8; ++j) { kk[j] *= inv; bb[j] = kk[j] * av[j]; brs += bb[j] * r[j]; }
        brs += __shfl_xor(brs, 1); brs += __shfl_xor(brs, 2); brs += __shfl_xor(brs, 4);
        kr += __shfl_xor(kr, 1); kr += __shfl_xor(kr, 2); kr += __shfl_xor(kr, 4);
        const size_t o = (size_t)m * RW + ch;
        *(GAS v4u*)(R + o) = pack8(r); *(GAS v4u*)(K + o) = pack8(kp); *(GAS v4u*)(KK + o) = pack8(kk); *(GAS v4u*)(BB + o) = pack8(bb); *(GAS v4u*)(V + o) = pack8(v);
        if ((lane & 7) == 0) { BON[(size_t)m * NH + (ch >> 6)] = bn; ((float*)(ws + WS_BR))[(size_t)m * NH + (ch >> 6)] = brs; ((float*)(ws + WS_KR))[(size_t)m * NH + (ch >> 6)] = kr; }
    }
}

constexpr int TC = 32;
constexpr int SC_A = 0, SC_WR = TC * 256, SC_W = 2 * TC * 256, SC_B = 3 * TC * 256, SC_K = 4 * TC * 256, SC_V = 5 * TC * 256, SC_S = SC_V + TC * 64, SC_BYTES = SC_S + TC * 8;
__device__ __forceinline__ float dpp_f(float v, const int ctrl_sel) {
    const int x = __builtin_bit_cast(int, v); int r;
    if (ctrl_sel == 0) r = __builtin_amdgcn_update_dpp(0, x, 0xB1, 0xF, 0xF, true);
    else if (ctrl_sel == 1) r = __builtin_amdgcn_update_dpp(0, x, 0x4E, 0xF, 0xF, true);
    else if (ctrl_sel == 2) r = __builtin_amdgcn_update_dpp(0, x, 0x141, 0xF, 0xF, true);
    else r = __builtin_amdgcn_update_dpp(0, x, 0x140, 0xF, 0xF, true);
    return __builtin_bit_cast(float, r);
}
__device__ __forceinline__ void phase5(const Args& a, LAS unsigned char* lds, int tid) {
    unsigned char* ws = a.ws;
    const float* WD = (const float*)(ws + WS_WD);
    const bf16* R = (const bf16*)(ws + WS_R); const bf16* K = (const bf16*)(ws + WS_K); const bf16* KK = (const bf16*)(ws + WS_KK); const bf16* BB = (const bf16*)(ws + WS_BB); const bf16* V = (const bf16*)(ws + WS_V);
    const float* BRs = (const float*)(ws + WS_BR); const float* KRs = (const float*)(ws + WS_KR);
    float* Y = (float*)(ws + WS_Y);
    constexpr int NCH = SEQ / TC;
    const int qlane = tid & 63, NLW = gridDim.x * 4; int qnext = blockIdx.x * 4 + ((tid >> 6) & 3), qrow = 2 * NEXP;
    for (int item = blockIdx.x; item < 256; item += gridDim.x) {
        const int bh = item >> 2, rg = item & 3, b = bh >> 5, h = bh & 31;
        const size_t base = (size_t)b * SEQ * RW + h * 64;
        __syncthreads();
        if (tid >= 256) {
            const int lt = tid - 256, st = lt >> 3, c8 = (lt & 7) * 8;
            f32x4 w0, w1; v4u xkk, xbb, xk, xr; unsigned xv; float sbr = 0.f, skr = 0.f;
            auto gload = [&](int c) {
                const size_t o = base + (size_t)(c * TC + st) * RW + c8;
                w0 = *(const GAS f32x4*)(WD + o); w1 = *(const GAS f32x4*)(WD + o + 4);
                xkk = *(const GAS v4u*)(KK + o); xbb = *(const GAS v4u*)(BB + o); xk = *(const GAS v4u*)(K + o); xr = *(const GAS v4u*)(R + o);
                xv = *(const GAS unsigned*)(V + base + (size_t)(c * TC + st) * RW + rg * 16 + (lt & 7) * 2);
                if (lt < TC) { const size_t mm = (size_t)b * SEQ + c * TC + lt; sbr = BRs[mm * NH + h]; skr = KRs[mm * NH + h]; }
            };
            f32x4 qv[16];
            auto quant_load = [&](int r) {
                const float* srcp = (r < NEXP ? a.in[19] + (size_t)r * D : a.in[20] + (size_t)(r - NEXP) * D);
#pragma unroll
                for (int i2 = 0; i2 < 4; ++i2)
#pragma unroll
                    for (int j = 0; j < 4; ++j) qv[i2 * 4 + j] = *(const GAS f32x4*)(srcp + (i2 * 4 + j) * 256 + qlane * 4);
            };
            auto quant_finish = [&](int r) {
                float am = 0.f;
#pragma unroll
                for (int k = 0; k < 16; ++k) am = fmaxf(am, fmaxf(fmaxf(fabsf(qv[k].x), fabsf(qv[k].y)), fmaxf(fabsf(qv[k].z), fabsf(qv[k].w))));
                am = wave_max(am);
                unsigned char* dst = (r < NEXP ? ws + WS_DQ + (size_t)r * ROWB_DN : ws + WS_UQ + (size_t)(r - NEXP) * ROWB_UP);
                float* scp = (r < NEXP ? (float*)(ws + WS_DSCALE) + r : (float*)(ws + WS_USCALE) + (r - NEXP));
                quant_pack_store(qv, am, dst, scp, qlane, r >= NEXP || PEER_DN_FP4 != 0);
            };
            auto lstore = [&](int buf) {
                LAS unsigned char* L = lds + buf * SC_BYTES; const int o = st * 256 + c8 * 4;
                float fk[8], fb[8], fkk[8], fr[8]; unpack8(xkk, fkk); unpack8(xbb, fb); unpack8(xk, fk); unpack8(xr, fr);
                *(LAS f32x4*)(L + SC_A + o) = (f32x4){-fkk[0], -fkk[1], -fkk[2], -fkk[3]}; *(LAS f32x4*)(L + SC_A + o + 16) = (f32x4){-fkk[4], -fkk[5], -fkk[6], -fkk[7]};
                *(LAS f32x4*)(L + SC_WR + o) = (f32x4){w0.x * fr[0], w0.y * fr[1], w0.z * fr[2], w0.w * fr[3]}; *(LAS f32x4*)(L + SC_WR + o + 16) = (f32x4){w1.x * fr[4], w1.y * fr[5], w1.z * fr[6], w1.w * fr[7]};
                *(LAS f32x4*)(L + SC_W + o) = w0; *(LAS f32x4*)(L + SC_W + o + 16) = w1;
                *(LAS f32x4*)(L + SC_B + o) = (f32x4){fb[0], fb[1], fb[2], fb[3]}; *(LAS f32x4*)(L + SC_B + o + 16) = (f32x4){fb[4], fb[5], fb[6], fb[7]};
                *(LAS f32x4*)(L + SC_K + o) = (f32x4){fk[0], fk[1], fk[2], fk[3]}; *(LAS f32x4*)(L + SC_K + o + 16) = (f32x4){fk[4], fk[5], fk[6], fk[7]};
                *(LAS f32x2*)(L + SC_V + st * 64 + (lt & 7) * 8) = (f32x2){bflo(xv), bfhi(xv)};
                if (lt < TC) *(LAS f32x2*)(L + SC_S + lt * 8) = (f32x2){sbr, skr};
            };
            gload(0); lstore(0);
            gload(1);
            __syncthreads();
            for (int c = 0; c < NCH; ++c) {
                if (c + 1 < NCH) lstore((c + 1) & 1);
                if (c + 2 < NCH) gload(c + 2);
                if (QUANT_IN_SCAN) {
                    const int ph = c & 3;
                    if (ph == 0) { qrow = qnext; qnext += NLW; if (qrow < 2 * NEXP) quant_load(qrow); }
                    else if (ph == 2) { if (qrow < 2 * NEXP) quant_finish(qrow); }
                }
                __syncthreads();
            }
        } else {
            const int i = tid >> 4, q = tid & 15;
            f32x2 s01 = (f32x2){0.f, 0.f}, s23 = (f32x2){0.f, 0.f};
            float* yp = Y + base + rg * 16 + i;
            float ykeep = 0.f;
            __builtin_amdgcn_s_setprio(3);
            __syncthreads();
            for (int c = 0; c < NCH; ++c) {
                const LAS unsigned char* L = lds + (c & 1) * SC_BYTES;
                f32x4 a4 = *(const LAS f32x4*)(L + SC_A + q * 16), wr4 = *(const LAS f32x4*)(L + SC_WR + q * 16), w4 = *(const LAS f32x4*)(L + SC_W + q * 16), b4 = *(const LAS f32x4*)(L + SC_B + q * 16), k4 = *(const LAS f32x4*)(L + SC_K + q * 16);
                float vi = *(const LAS float*)(L + SC_V + i * 4); f32x2 sc = *(const LAS f32x2*)(L + SC_S);
#pragma unroll
                for (int tt = 0; tt < TC; ++tt) {
                    const f32x4 ca = a4, cwr = wr4, cw = w4, cb = b4, ck = k4; const float cvi = vi; const f32x2 csc = sc;
                    if (tt + 1 < TC) {
                        a4 = *(const LAS f32x4*)(L + SC_A + (tt + 1) * 256 + q * 16); wr4 = *(const LAS f32x4*)(L + SC_WR + (tt + 1) * 256 + q * 16); w4 = *(const LAS f32x4*)(L + SC_W + (tt + 1) * 256 + q * 16);
                        b4 = *(const LAS f32x4*)(L + SC_B + (tt + 1) * 256 + q * 16); k4 = *(const LAS f32x4*)(L + SC_K + (tt + 1) * 256 + q * 16);
                        vi = *(const LAS float*)(L + SC_V + (tt + 1) * 64 + i * 4); sc = *(const LAS f32x2*)(L + SC_S + (tt + 1) * 8);
                    }
                    f32x2 da = s01 * (f32x2){ca.x, ca.y}; da = s23 * (f32x2){ca.z, ca.w} + da;
                    f32x2 dr = s01 * (f32x2){cwr.x, cwr.y}; dr = s23 * (f32x2){cwr.z, cwr.w} + dr;
                    float sa = da.x + da.y, yy = dr.x + dr.y;
                    const f32x2 vv = (f32x2){cvi, cvi};
                    const f32x2 t01 = s01 * (f32x2){cw.x, cw.y} + vv * (f32x2){ck.x, ck.y}, t23 = s23 * (f32x2){cw.z, cw.w} + vv * (f32x2){ck.z, ck.w};
                    sa += dpp_f(sa, 0); yy += dpp_f(yy, 0);
                    sa += dpp_f(sa, 1); yy += dpp_f(yy, 1);
                    sa += dpp_f(sa, 2); yy += dpp_f(yy, 2);
                    sa += dpp_f(sa, 3); yy += dpp_f(yy, 3);
                    const f32x2 ss = (f32x2){sa, sa};
                    s01 = ss * (f32x2){cb.x, cb.y} + t01; s23 = ss * (f32x2){cb.z, cb.w} + t23;
                    yy += sa * csc.x + cvi * csc.y;
                    ykeep = ((tt & 15) == q) ? yy : ykeep;
                    if ((tt & 15) == 15) yp[(size_t)(c * TC + (tt & 16) + q) * RW] = ykeep;
                }
                __syncthreads();
            }
            __builtin_amdgcn_s_setprio(0);
        }
    }
    if (QUANT_IN_SCAN && tid >= 256) {
        for (; qnext < 2 * NEXP; qnext += NLW) {
            const int r = qnext;
            if (r < NEXP) p0_quant_row(a.in[19] + (size_t)r * D, ws + WS_DQ + (size_t)r * ROWB_DN, (float*)(ws + WS_DSCALE) + r, qlane, PEER_DN_FP4 != 0);
            else p0_quant_row(a.in[20] + (size_t)(r - NEXP) * D, ws + WS_UQ + (size_t)(r - NEXP) * ROWB_UP, (float*)(ws + WS_USCALE) + (r - NEXP), qlane, true);
        }
    }
}

constexpr int CH = 32, NCHK = SEQ / CH;
constexpr int SUM_GT = 0, SUM_QT = 8192, SUM_HT = 12288, SUM_YL = 20480, SUM_BYTES = 24576;
constexpr int CW_BYTES = 18432;
constexpr int CA_OFF = 0, CB_OFF = 8704, CC_OFF = 13312;
constexpr int TMS = 144, CMS = 80;
typedef float f32x16c __attribute__((ext_vector_type(16)));
typedef short bf16x8c __attribute__((ext_vector_type(8)));
__device__ __forceinline__ bf16x8c cvt8(const f32x16c& x, const int base) {
    v4u w; w.x = pk2(x[base + 0], x[base + 1]); w.y = pk2(x[base + 2], x[base + 3]); w.z = pk2(x[base + 4], x[base + 5]); w.w = pk2(x[base + 6], x[base + 7]);
    return __builtin_bit_cast(bf16x8c, w);
}
__device__ __forceinline__ bf16x8c lds_nat(const LAS unsigned char* img, int row, int pitch, int ks, int hf) {
    return __builtin_bit_cast(bf16x8c, *(const LAS v4u*)(img + row * pitch + (16 * ks + 8 * hf) * 2));
}
__device__ __forceinline__ bf16x8c lds_sig(const LAS unsigned char* img, int row, int pitch, int ks, int hf) {
    const v2u lo = *(const LAS v2u*)(img + row * pitch + (16 * ks + 4 * hf) * 2), hi = *(const LAS v2u*)(img + row * pitch + (16 * ks + 8 + 4 * hf) * 2);
    return __builtin_bit_cast(bf16x8c, (v4u){lo.x, lo.y, hi.x, hi.y});
}
#define MFMA32(a, b, c) __builtin_amdgcn_mfma_f32_32x32x16_bf16((a), (b), (c), 0, 0, 0)

__device__ __forceinline__ void diag_add(f32x16c& x, int tl, int hf, float v) {
#pragma unroll
    for (int i = 0; i < 16; ++i) { const int r = (i & 3) + 8 * (i >> 2) + 4 * hf; x[i] += (r == tl) ? v : 0.f; }
}
__device__ __forceinline__ f32x16c xty(const f32x16c& X, const f32x16c& Y, f32x16c c) { c = MFMA32(cvt8(X, 0), cvt8(Y, 0), c); c = MFMA32(cvt8(X, 8), cvt8(Y, 8), c); return c; }
__device__ __forceinline__ void phase5a(const Args& a, LAS unsigned char* lds, int gw, int NGW, int wave, int lane_in) {
    unsigned char* ws = a.ws;
    const float* LWG = (const float*)(ws + WS_WD);
    const bf16* PRJ = (const bf16*)(ws + WS_PROJ); const bf16* AAg = (const bf16*)(ws + WS_AA); bf16* Vw = (bf16*)(ws + WS_V); float* BONw = (float*)(ws + WS_BONUS);
    const float* mu = a.in[3]; const float* k_k = a.in[9]; const float* k_a = a.in[10]; const float* r_k = a.in[11];
    LAS unsigned char* LA = lds + wave * CW_BYTES + CA_OFF; LAS unsigned char* LB = lds + wave * CW_BYTES + CB_OFF; LAS unsigned char* LC = lds + wave * CW_BYTES + CC_OFF;
    f32x16c zero16;
#pragma unroll
    for (int i = 0; i < 16; ++i) zero16[i] = 0.f;
    for (int item = gw; item < 64 * NCHK; item += NGW) {
        int lane_l = lane_in; asm volatile("" : "+v"(lane_l));
        const int lane = lane_l, tl = lane & 31, hf = lane >> 5;
        const int bh = item / NCHK, c = item % NCHK, b = bh >> 5, h = bh & 31;
        const float* lwu = LWG + ((size_t)b * SEQ + c * CH) * RW + h * 64;
        const int tpos = c * CH + tl;
        const bf16* pu = PRJ + ((size_t)b * SEQ + c * CH) * NPROJ + h * 64;
        const int lo_p = tl * NPROJ + 32 * hf, lo_q = (tpos > 0) ? lo_p - NPROJ : lo_p;
        const float pmask = (tpos > 0) ? 1.0f : 0.0f;
        const int lo_c = tl * RW + 32 * hf;
        const size_t ub = ((size_t)b * SEQ + c * CH) * RW + h * 64;
        const bf16* aau = AAg + ub; bf16* vwu = Vw + ub;
        const float* muu = mu + h * 64; const float* kku = k_k + h * 64; const float* kau = k_a + h * 64; const float* rku = r_k + h * 64; const int lo_h = 32 * hf;
        f32x4 lwr[8]; v4u rcw[4], rpw[4], vcw[4], vpw[4], kcw[4], kpw[4], aaw[4];
#pragma unroll
        for (int q = 0; q < 8; ++q) lwr[q] = *(const GAS f32x4*)(lwu + lo_c + 4 * q);
#pragma unroll
        for (int q = 0; q < 4; ++q) { rcw[q] = *(const GAS v4u*)(pu + COL_R + lo_p + 8 * q); rpw[q] = *(const GAS v4u*)(pu + COL_R + lo_q + 8 * q);
            vcw[q] = *(const GAS v4u*)(pu + COL_V + lo_p + 8 * q); vpw[q] = *(const GAS v4u*)(pu + COL_V + lo_q + 8 * q);
        }
        asm volatile("" ::: "memory");
        {
#pragma unroll
          for (int q = 0; q < 8; ++q) *(LAS f32x4*)(LA + (tl * 68 + 32 * hf + 4 * q) * 4) = lwr[q];
          LDS_WAIT();
          float accl = 0.f;
#pragma unroll
          for (int t = 0; t < CH; ++t) { accl += *(const LAS float*)(LA + (t * 68 + lane) * 4); *(LAS float*)(LA + (t * 68 + lane) * 4) = accl; }
          LDS_WAIT();
        }
#pragma unroll
        for (int q = 0; q < 4; ++q) { kcw[q] = *(const GAS v4u*)(pu + COL_K + lo_p + 8 * q); kpw[q] = *(const GAS v4u*)(pu + COL_K + lo_q + 8 * q); aaw[q] = *(const GAS v4u*)(aau + lo_c + 8 * q); }
        asm volatile("" ::: "memory");
        const float pc0 = __expf(*(const LAS float*)(LA + (31 * 68 + tl) * 4)), pc1 = __expf(*(const LAS float*)(LA + (31 * 68 + 32 + tl) * 4));
        v4u kh_[4], rt_[4], at_[4];
        bf16x8c fb[4], fk[4], fr[4], fa[4];
#define TM_WRITE(dst, src) do { _Pragma("unroll") for (int q = 0; q < 4; ++q) *(LAS v4u*)((dst) + tl * TMS + (32 * hf + 8 * q) * 2) = src[q]; LDS_WAIT(); } while (0)
#define TM_FRAGS(dst) do { _Pragma("unroll") for (int ks = 0; ks < 4; ++ks) dst[ks] = lds_nat(LB, tl, TMS, ks, hf); LDS_WAIT(); } while (0)
#define CM_WRITE(dst, src) do { _Pragma("unroll") for (int q = 0; q < 4; ++q) { const v4u _w = src[q]; _Pragma("unroll") for (int e = 0; e < 4; ++e) { \
            *(LAS unsigned short*)((dst) + (32 * hf + 8 * q + 2 * e) * CMS + tl * 2) = (unsigned short)(_w[e] & 0xffffu); *(LAS unsigned short*)((dst) + (32 * hf + 8 * q + 2 * e + 1) * CMS + tl * 2) = (unsigned short)(_w[e] >> 16); } } LDS_WAIT(); } while (0)
#define LROW(q) const f32x4 L0 = *(const LAS f32x4*)(LA + (tl * 68 + 32 * hf + 8 * (q)) * 4), L1 = *(const LAS f32x4*)(LA + (tl * 68 + 32 * hf + 8 * (q) + 4) * 4)
#define EROW(q) const f32x4 E0 = *(const LAS f32x4*)(LA + (31 * 68 + 32 * hf + 8 * (q)) * 4), E1 = *(const LAS f32x4*)(LA + (31 * 68 + 32 * hf + 8 * (q) + 4) * 4)
#define LERP8(cw, pw, col, q, out) do { float _c[8], _p[8]; unpack8(cw[q], _c); unpack8(pw[q], _p); \
            const f32x4 _m0 = *(const GAS f32x4*)(muu + (col) + lo_h + 8 * (q)), _m1 = *(const GAS f32x4*)(muu + (col) + lo_h + 8 * (q) + 4); \
            _Pragma("unroll") for (int j = 0; j < 8; ++j) out[j] = _c[j] + (_p[j] * pmask - _c[j]) * (j < 4 ? _m0[j] : _m1[j - 4]); } while (0)
        {
#pragma unroll
            for (int q = 0; q < 4; ++q) { LROW(q); float x8[8], u1[8]; LERP8(rcw, rpw, COL_R, q, x8);
#pragma unroll
                for (int j = 0; j < 8; ++j) { const float L = j < 4 ? L0[j] : L1[j - 4]; u1[j] = x8[j] * __expf(L); }
                rt_[q] = pack8(u1); }
        }
        {
#pragma unroll
            for (int q = 0; q < 4; ++q) { float x8[8]; LERP8(vcw, vpw, COL_V, q, x8); *(GAS v4u*)(vwu + lo_c + 8 * q) = pack8(x8); }
        }
        float inv_kk; v4u ks_[4];
        {
            float ss = 0.f;
#pragma unroll
            for (int q = 0; q < 4; ++q) { float x8[8]; LERP8(kcw, kpw, COL_K, q, x8); ks_[q] = pack8(x8);
                const f32x4 k0 = *(const GAS f32x4*)(kku + lo_h + 8 * q), k1 = *(const GAS f32x4*)(kku + lo_h + 8 * q + 4);
#pragma unroll
                for (int j = 0; j < 8; ++j) { const float t2 = x8[j] * (j < 4 ? k0[j] : k1[j - 4]); ss += t2 * t2; } }
            ss += __shfl_xor(ss, 32);
            inv_kk = 1.0f / sqrtf(fmaxf(ss, 1e-24f));
        }
        {
            v4u kt_[4]; float bon = 0.f;
#pragma unroll
            for (int q = 0; q < 4; ++q) { LROW(q); EROW(q); float x8[8], av[8], rt8[8]; unpack8(ks_[q], x8); unpack8(aaw[q], av); unpack8(rt_[q], rt8);
                const f32x4 a0v = *(const GAS f32x4*)(kau + lo_h + 8 * q), a1v = *(const GAS f32x4*)(kau + lo_h + 8 * q + 4), q0 = *(const GAS f32x4*)(rku + lo_h + 8 * q), q1 = *(const GAS f32x4*)(rku + lo_h + 8 * q + 4);
                float o_kt[8], o_kh[8];
#pragma unroll
                for (int j = 0; j < 8; ++j) { const float L = j < 4 ? L0[j] : L1[j - 4], Le = j < 4 ? E0[j] : E1[j - 4];
                    const float kp = x8[j] * (1.0f + (av[j] - 1.0f) * (j < 4 ? a0v[j] : a1v[j - 4])), enL = __expf(-L);
                    bon += rt8[j] * enL * (j < 4 ? q0[j] : q1[j - 4]) * kp;
                    o_kt[j] = kp * enL; o_kh[j] = kp * __expf(Le - L); }
                kt_[q] = pack8(o_kt); kh_[q] = pack8(o_kh); if (q == 1) asm volatile("" ::: "memory"); }
            bon += __shfl_xor(bon, 32);
            if (hf == 0) (BONw + ((size_t)b * SEQ + c * CH) * NH + h)[tl * NH] = bon;
            TM_WRITE(LB, kt_); TM_FRAGS(fk);
        }
        asm volatile("" ::: "memory");
        {
            v4u bt_[4], bh_[4];
#pragma unroll
            for (int q = 0; q < 4; ++q) { LROW(q); EROW(q); float x8[8], av[8]; unpack8(ks_[q], x8); unpack8(aaw[q], av);
                const f32x4 k0 = *(const GAS f32x4*)(kku + lo_h + 8 * q), k1 = *(const GAS f32x4*)(kku + lo_h + 8 * q + 4);
                const int rwp = tl > 0 ? tl - 1 : 0; const float pm2 = tl > 0 ? 1.0f : 0.0f;
                const f32x4 W0 = *(const LAS f32x4*)(LA + (rwp * 68 + 32 * hf + 8 * q) * 4) * pm2, W1 = *(const LAS f32x4*)(LA + (rwp * 68 + 32 * hf + 8 * q + 4) * 4) * pm2;
                float o_at[8], o_bt[8], o_bh[8];
#pragma unroll
                for (int j = 0; j < 8; ++j) { const float L = j < 4 ? L0[j] : L1[j - 4], Le = j < 4 ? E0[j] : E1[j - 4], lw1 = j < 4 ? W0[j] : W1[j - 4];
                    const float kk = x8[j] * (j < 4 ? k0[j] : k1[j - 4]) * inv_kk, bb = kk * av[j];
                    o_at[j] = -kk * __expf(lw1); o_bt[j] = bb * __expf(-L); o_bh[j] = bb * __expf(Le - L); }
                at_[q] = pack8(o_at); bt_[q] = pack8(o_bt); bh_[q] = pack8(o_bh); if (q == 1) asm volatile("" ::: "memory"); }
            TM_WRITE(LB, bt_); TM_FRAGS(fb); CM_WRITE(LC, bh_);
        }
        asm volatile("" ::: "memory");
        TM_WRITE(LB, rt_); TM_FRAGS(fr);
        TM_WRITE(LB, at_); TM_FRAGS(fa);
        asm volatile("" ::: "memory");
#undef LERP8
        CM_WRITE(LA, at_);
        TM_WRITE(LB, rt_);
        f32x16c P = zero16, R = zero16, KT = zero16, Mkr = zero16, Mbr = zero16;
#pragma unroll
        for (int ks = 0; ks < 4; ++ks) { P = MFMA32(fb[ks], fa[ks], P); R = MFMA32(fa[ks], fb[ks], R); KT = MFMA32(fa[ks], fk[ks], KT); Mkr = MFMA32(fk[ks], fr[ks], Mkr); Mbr = MFMA32(fb[ks], fr[ks], Mbr); }
#pragma unroll
        for (int i = 0; i < 16; ++i) { const int r = (i & 3) + 8 * (i >> 2) + 4 * hf;
            P[i] = (r < tl) ? P[i] : 0.f; Mkr[i] = (r <= tl) ? Mkr[i] : 0.f; Mbr[i] = (r <= tl) ? Mbr[i] : 0.f;
            R[i] = (tl < r) ? R[i] : 0.f; KT[i] = (tl < r) ? KT[i] : 0.f; }
        f32x16c T = P; diag_add(T, tl, hf, 1.0f);
#pragma unroll
        for (int lev = 0; lev < 4; ++lev) {
            const f32x16c Pn = (lev < 3) ? xty(R, P, zero16) : zero16;
            const f32x16c Rn = xty(P, R, zero16);
            P = Pn; R = Rn;
            f32x16c IR = R; diag_add(IR, tl, hf, 1.0f);
            T = xty(IR, T, zero16);
        }
        f32x16c Xa[2], Wt;
        { const bf16x8c t0 = cvt8(T, 0), t1 = cvt8(T, 8);
#pragma unroll
          for (int jt = 0; jt < 2; ++jt) { Xa[jt] = MFMA32(t0, lds_sig(LA, 32 * jt + tl, CMS, 0, hf), zero16); Xa[jt] = MFMA32(t1, lds_sig(LA, 32 * jt + tl, CMS, 1, hf), Xa[jt]); }
          Wt = MFMA32(t0, cvt8(KT, 0), zero16); Wt = MFMA32(t1, cvt8(KT, 8), Wt); }
        bf16x8c bs[2][2];
#pragma unroll
        for (int rt2 = 0; rt2 < 2; ++rt2)
#pragma unroll
            for (int ks = 0; ks < 2; ++ks) bs[rt2][ks] = lds_sig(LC, 32 * rt2 + tl, CMS, ks, hf);
        LDS_WAIT();
        { v4u vr[4];
#pragma unroll
          for (int q = 0; q < 4; ++q) vr[q] = *(const GAS v4u*)(vwu + lo_c + 8 * q);
          TM_WRITE(LA, kh_);
          CM_WRITE(LC, vr); }
        unsigned char* rec = ws + WS_REC + (size_t)item * SUM_BYTES;
#pragma unroll
        for (int bt2 = 0; bt2 < 2; ++bt2) { const bf16x8c x0 = cvt8(Xa[bt2], 0), x1 = cvt8(Xa[bt2], 8);
#pragma unroll
            for (int at2 = 0; at2 < 2; ++at2) { f32x16c g = MFMA32(x0, bs[at2][0], zero16); g = MFMA32(x1, bs[at2][1], g);
                if (at2 == bt2) diag_add(g, tl, hf, at2 == 0 ? pc0 : pc1);
#pragma unroll
                for (int k2 = 0; k2 < 2; ++k2) *(GAS bf16x8c*)(rec + SUM_GT + (32 * at2 + tl) * 128 + (2 * bt2 + k2) * 32 + hf * 16) = cvt8(g, 8 * k2);
            } }
        { const bf16x8c mb0 = cvt8(Mbr, 0), mb1 = cvt8(Mbr, 8);
#pragma unroll
          for (int jt = 0; jt < 2; ++jt) { f32x16c qv_;
#pragma unroll
              for (int i = 0; i < 16; ++i) { const int j = 32 * jt + (i & 3) + 8 * (i >> 2) + 4 * hf; qv_[i] = __builtin_bit_cast(float, (unsigned)(*(const LAS unsigned short*)(LB + tl * TMS + j * 2)) << 16); }
              qv_ = MFMA32(cvt8(Xa[jt], 0), mb0, qv_); qv_ = MFMA32(cvt8(Xa[jt], 8), mb1, qv_);
#pragma unroll
              for (int k2 = 0; k2 < 2; ++k2) *(GAS bf16x8c*)(rec + SUM_QT + tl * 128 + (2 * jt + k2) * 32 + hf * 16) = cvt8(qv_, 8 * k2);
          } }
        LDS_WAIT();
        bf16x8c vp[2][2];
#pragma unroll
        for (int it = 0; it < 2; ++it)
#pragma unroll
            for (int ks = 0; ks < 2; ++ks) vp[it][ks] = lds_sig(LC, 32 * it + tl, CMS, ks, hf);
        const bf16x8c w0 = cvt8(Wt, 0), w1 = cvt8(Wt, 8);
#pragma unroll
        for (int jt = 0; jt < 2; ++jt) { f32x16c zk;
#pragma unroll
            for (int i = 0; i < 16; ++i) { const int s = (i & 3) + 8 * (i >> 2) + 4 * hf; zk[i] = __builtin_bit_cast(float, (unsigned)(*(const LAS unsigned short*)(LA + s * TMS + (32 * jt + tl) * 2)) << 16); }
            zk = MFMA32(w0, bs[jt][0], zk); zk = MFMA32(w1, bs[jt][1], zk);
            const bf16x8c z0 = cvt8(zk, 0), z1 = cvt8(zk, 8);
#pragma unroll
            for (int it = 0; it < 2; ++it) { f32x16c hv = MFMA32(z0, vp[it][0], zero16); hv = MFMA32(z1, vp[it][1], hv);
                unsigned char* dst = rec + SUM_HT + ((size_t)(it * 64 + lane) * 2 + jt) * 32;
                *(GAS bf16x8c*)(dst) = cvt8(hv, 0); *(GAS bf16x8c*)(dst + 16) = cvt8(hv, 8);
            } }
        { f32x16c zy = MFMA32(w0, cvt8(Mbr, 0), Mkr); zy = MFMA32(w1, cvt8(Mbr, 8), zy);
          const bf16x8c y0 = cvt8(zy, 0), y1 = cvt8(zy, 8);
#pragma unroll
          for (int it = 0; it < 2; ++it) { f32x16c yv = MFMA32(y0, vp[it][0], zero16); yv = MFMA32(y1, vp[it][1], yv);
              unsigned char* dst = rec + SUM_YL + (size_t)(it * 64 + lane) * 32;
              *(GAS bf16x8c*)(dst) = cvt8(yv, 0); *(GAS bf16x8c*)(dst + 16) = cvt8(yv, 8);
          } }
        LDS_WAIT();
#undef TM_WRITE
#undef TM_FRAGS
#undef CM_WRITE
#undef LROW
#undef EROW
    }
}

constexpr int RING_SLOTS = 5, NLOADW = 5, RING_FLAGS = RING_SLOTS * SUM_BYTES;
__device__ __forceinline__ int ring_swz(int o) {
    return (o < SUM_HT) ? ((o & ~127) | ((((o >> 4) ^ (o >> 7)) & 7) << 4)) : o;
}
__device__ __forceinline__ void spin_until(volatile LAS unsigned* p, unsigned want) {
    unsigned sp = 0u;
    while (*p < want) { __builtin_amdgcn_s_sleep(1); if (++sp > (1u << 24)) break; }
}
__device__ __forceinline__ void phase5b(const Args& a, LAS unsigned char* lds, int bx, int G, int tid, int wave, int lane) {
    unsigned char* ws = a.ws;
    const int tl = lane & 31, hf = lane >> 5;
    volatile LAS unsigned* full = (volatile LAS unsigned*)(lds + RING_FLAGS); volatile LAS unsigned* freef = (volatile LAS unsigned*)(lds + RING_FLAGS + 32);
    if (tid < 64) ((LAS unsigned*)(lds + RING_FLAGS))[tid] = 0u;
    __syncthreads();
    const bool chain_block = (G >= 128) && (bx < 128);
    const int bh = bx >> 1, it = bx & 1, b = bh >> 5, h = bh & 31;
    const unsigned char* rec0 = ws + WS_REC + (size_t)bh * NCHK * SUM_BYTES;
    volatile LAS unsigned* freeB = (volatile LAS unsigned*)(lds + RING_FLAGS + 64); volatile LAS unsigned* sfull = (volatile LAS unsigned*)(lds + RING_FLAGS + 96); volatile LAS unsigned* sfree = (volatile LAS unsigned*)(lds + RING_FLAGS + 112);
    LAS unsigned char* sring = lds + RING_FLAGS + 256;
    constexpr int SSLOTS = 2;
    auto unp16 = [&](const bf16x8c lo, const bf16x8c hi2) { f32x16c r; const v4u l4 = __builtin_bit_cast(v4u, lo), h4 = __builtin_bit_cast(v4u, hi2);
#pragma unroll
        for (int e2 = 0; e2 < 4; ++e2) { r[2 * e2] = bflo(l4[e2]); r[2 * e2 + 1] = bfhi(l4[e2]); r[8 + 2 * e2] = bflo(h4[e2]); r[8 + 2 * e2 + 1] = bfhi(h4[e2]); }
        return r; };
    if (chain_block && wave == 0) {
        f32x16c S0, S1;
#pragma unroll
        for (int i = 0; i < 16; ++i) { S0[i] = 0.f; S1[i] = 0.f; }
        for (int c = 0; c < NCHK; ++c) {
            const int slot = c % RING_SLOTS, ss = c % SSLOTS; const LAS unsigned char* R = lds + slot * SUM_BYTES; LAS unsigned char* SR = sring + ss * 4096;
            const bf16x8c bs0 = cvt8(S0, 0), bs1 = cvt8(S0, 8), bs2 = cvt8(S1, 0), bs3 = cvt8(S1, 8);
            if (c >= SSLOTS) spin_until(sfree + ss, (unsigned)(c - SSLOTS + 1));
            asm volatile("" ::: "memory");
            *(LAS bf16x8c*)(SR + lane * 16) = bs0; *(LAS bf16x8c*)(SR + 1024 + lane * 16) = bs1; *(LAS bf16x8c*)(SR + 2048 + lane * 16) = bs2; *(LAS bf16x8c*)(SR + 3072 + lane * 16) = bs3;
            asm volatile("" ::: "memory");
            if (lane == 0) sfull[ss] = (unsigned)(c + 1);
            spin_until(full + slot, (unsigned)(c + 1));
            asm volatile("" ::: "memory");
            bf16x8c ga[2][4], hi_[2][2];
#pragma unroll
            for (int at2 = 0; at2 < 2; ++at2)
#pragma unroll
                for (int ks = 0; ks < 4; ++ks) ga[at2][ks] = *(const LAS bf16x8c*)(R + ring_swz(SUM_GT + (32 * at2 + tl) * 128 + ks * 32 + hf * 16));
#pragma unroll
            for (int jt = 0; jt < 2; ++jt) { const int o = SUM_HT + ((it * 64 + lane) * 2 + jt) * 32; hi_[jt][0] = *(const LAS bf16x8c*)(R + o); hi_[jt][1] = *(const LAS bf16x8c*)(R + o + 16); }
            LDS_WAIT();
            if (lane == 0) freef[slot] = (unsigned)(c + 1);
            f32x16c n0 = unp16(hi_[0][0], hi_[0][1]), n1 = unp16(hi_[1][0], hi_[1][1]);
            n0 = MFMA32(ga[0][0], bs0, n0); n1 = MFMA32(ga[1][0], bs0, n1);
            n0 = MFMA32(ga[0][1], bs1, n0); n1 = MFMA32(ga[1][1], bs1, n1);
            n0 = MFMA32(ga[0][2], bs2, n0); n1 = MFMA32(ga[1][2], bs2, n1);
            n0 = MFMA32(ga[0][3], bs3, n0); n1 = MFMA32(ga[1][3], bs3, n1);
            S0 = n0; S1 = n1;
        }
    } else if (chain_block && wave == 1) {
        float* Y = (float*)(ws + WS_Y);
        for (int c = 0; c < NCHK; ++c) {
            const int slot = c % RING_SLOTS, ss = c % SSLOTS; const LAS unsigned char* R = lds + slot * SUM_BYTES; const LAS unsigned char* SR = sring + ss * 4096;
            spin_until(full + slot, (unsigned)(c + 1)); spin_until(sfull + ss, (unsigned)(c + 1));
            asm volatile("" ::: "memory");
            bf16x8c qa[4], yi_[2];
#pragma unroll
            for (int ks = 0; ks < 4; ++ks) qa[ks] = *(const LAS bf16x8c*)(R + ring_swz(SUM_QT + tl * 128 + ks * 32 + hf * 16));
            { const int o = SUM_YL + (it * 64 + lane) * 32; yi_[0] = *(const LAS bf16x8c*)(R + o); yi_[1] = *(const LAS bf16x8c*)(R + o + 16); }
            const bf16x8c bs0 = *(const LAS bf16x8c*)(SR + lane * 16), bs1 = *(const LAS bf16x8c*)(SR + 1024 + lane * 16), bs2 = *(const LAS bf16x8c*)(SR + 2048 + lane * 16), bs3 = *(const LAS bf16x8c*)(SR + 3072 + lane * 16);
            LDS_WAIT();
            if (lane == 0) { freeB[slot] = (unsigned)(c + 1); sfree[ss] = (unsigned)(c + 1); }
            f32x16c yv = unp16(yi_[0], yi_[1]);
            yv = MFMA32(qa[0], bs0, yv); yv = MFMA32(qa[1], bs1, yv); yv = MFMA32(qa[2], bs2, yv); yv = MFMA32(qa[3], bs3, yv);
            float* yp = Y + ((size_t)b * SEQ + c * CH) * RW + h * 64 + 32 * it + tl;
#pragma unroll
            for (int i = 0; i < 16; ++i) { const int t = (i & 3) + 8 * (i >> 2) + 4 * hf; yp[(size_t)t * RW] = yv[i]; }
        }
    } else if (chain_block && wave >= 2 && wave < 2 + NLOADW) {
        for (int c = wave - 2; c < NCHK; c += NLOADW) {
            const int slot = c % RING_SLOTS; LAS unsigned char* R = lds + slot * SUM_BYTES;
            const unsigned char* rec = rec0 + (size_t)c * SUM_BYTES;
            v4u buf[18];
#pragma unroll
            for (int k = 0; k < 18; ++k) { const int pc = k < 12 ? k : (k < 16 ? 12 + 4 * it + (k - 12) : 20 + 2 * it + (k - 16)); buf[k] = *(const GAS v4u*)(rec + pc * 1024 + lane * 16); }
            if (c >= RING_SLOTS) { spin_until(freef + slot, (unsigned)(c - RING_SLOTS + 1)); spin_until(freeB + slot, (unsigned)(c - RING_SLOTS + 1)); }
            asm volatile("" ::: "memory");
#pragma unroll
            for (int k = 0; k < 18; ++k) { const int pc = k < 12 ? k : (k < 16 ? 12 + 4 * it + (k - 12) : 20 + 2 * it + (k - 16)); *(LAS v4u*)(R + ring_swz(pc * 1024 + lane * 16)) = buf[k]; }
            LDS_WAIT();
            if (lane == 0) full[slot] = (unsigned)(c + 1);
        }
    } else if (QUANT_IN_SCAN) {
        constexpr int NQW = 6 - NLOADW;
        const int nchain = (G >= 128) ? 128 : 0;
        const int nq = NQW * nchain + 8 * (G - nchain);
        const int qid = chain_block ? NQW * bx + (wave - 2 - NLOADW) : NQW * nchain + 8 * (bx - nchain) + wave;
        quant_rows(a, qid, nq, lane);
    }
    if (G < 128 && bx == 0 && wave == 0) {
        float* Y = (float*)(ws + WS_Y); for (int i = lane; i < 4096; i += 64) Y[i] = __builtin_nanf("");
    }
}

__device__ __forceinline__ void phase6(const Args& a, int gw, int NGW, int lane) {
    unsigned char* ws = a.ws;
    const float* Y = (const float*)(ws + WS_Y); const bf16* V = (const bf16*)(ws + WS_V); const bf16* G = (const bf16*)(ws + WS_G); const float* BON = (const float*)(ws + WS_BONUS);
    const float* lw = a.in[12]; const float* lb = a.in[13]; bf16* MIX = (bf16*)(ws + WS_MIXED);
    for (int it = gw; it < M * 4; it += NGW) {
        const int m = it >> 2, ch = (it & 3) * 512 + lane * 8; const size_t o = (size_t)m * RW + ch;
        const f32x4 y0 = *(const GAS f32x4*)(Y + o), y1 = *(const GAS f32x4*)(Y + o + 4);
        float y[8] = {y0.x, y0.y, y0.z, y0.w, y1.x, y1.y, y1.z, y1.w}, v[8], g[8];
        unpack8(*(const GAS v4u*)(V + o), v); unpack8(*(const GAS v4u*)(G + o), g);
        float s = 0.f;
#pragma unroll
        for (int j = 0; j < 8; ++j) s += y[j];
        s += __shfl_xor(s, 1); s += __shfl_xor(s, 2); s += __shfl_xor(s, 4);
        const float mean = s * (1.0f / 64.0f); float q = 0.f;
#pragma unroll
        for (int j = 0; j < 8; ++j) { y[j] -= mean; q += y[j] * y[j]; }
        q += __shfl_xor(q, 1); q += __shfl_xor(q, 2); q += __shfl_xor(q, 4);
        const float rstd = 1.0f / sqrtf(q * (1.0f / 64.0f) + 64e-5f), bn = BON[(size_t)m * NH + (ch >> 6)];
        const f32x4 w0 = *(const GAS f32x4*)(lw + ch), w1 = *(const GAS f32x4*)(lw + ch + 4), b0 = *(const GAS f32x4*)(lb + ch), b1 = *(const GAS f32x4*)(lb + ch + 4);
        float r[8];
#pragma unroll
        for (int j = 0; j < 8; ++j) r[j] = (y[j] * rstd * (j < 4 ? w0[j] : w1[j - 4]) + (j < 4 ? b0[j] : b1[j - 4]) + bn * v[j]) * g[j];
        *(GAS v4u*)(MIX + (size_t)m * D + ch) = pack8(r);
    }
}

typedef short bf16x8_t __attribute__((ext_vector_type(8)));
typedef float f32x16 __attribute__((ext_vector_type(16)));
__device__ __forceinline__ unsigned f2ord(float f) { const unsigned u = __builtin_bit_cast(unsigned, f); return (u & 0x80000000u) ? ~u : (u | 0x80000000u); }
__device__ __forceinline__ float ord2f(unsigned o) { const unsigned u = (o & 0x80000000u) ? (o & 0x7fffffffu) : ~o; return __builtin_bit_cast(float, u); }
__device__ __forceinline__ void ce_desc(unsigned& x, unsigned& y) { const unsigned hi = max(x, y), lo = min(x, y); x = hi; y = lo; }
template <int B> __device__ __forceinline__ void sort16_desc(unsigned (&u)[64]) {
#define CE(i, j) ce_desc(u[B + (i)], u[B + (j)]);
    CE(0,1) CE(2,3) CE(0,2) CE(1,3) CE(1,2) CE(4,5) CE(6,7) CE(4,6) CE(5,7) CE(5,6) CE(0,4) CE(2,6) CE(2,4) CE(1,5) CE(3,7) CE(3,5) CE(1,2) CE(3,4) CE(5,6) CE(8,9) CE(10,11) CE(8,10) CE(9,11) CE(9,10) CE(12,13) CE(14,15) CE(12,14) CE(13,15) CE(13,14) CE(8,12) CE(10,14) CE(10,12) CE(9,13) CE(11,15) CE(11,13) CE(9,10) CE(11,12) CE(13,14) CE(0,8) CE(4,12) CE(4,8) CE(2,10) CE(6,14) CE(6,10) CE(2,4) CE(6,8) CE(10,12) CE(1,9) CE(5,13) CE(5,9) CE(3,11) CE(7,15) CE(7,11) CE(3,5) CE(7,9) CE(11,13) CE(1,2) CE(3,4) CE(5,6) CE(7,8) CE(9,10) CE(11,12) CE(13,14)
#undef CE
}
template <int B> __device__ __forceinline__ void bitonic16_desc(unsigned (&u)[64]) {
#define CE(i, j) ce_desc(u[B + (i)], u[B + (j)]);
    CE(0,8) CE(1,9) CE(2,10) CE(3,11) CE(4,12) CE(5,13) CE(6,14) CE(7,15) CE(0,4) CE(1,5) CE(2,6) CE(3,7) CE(8,12) CE(9,13) CE(10,14) CE(11,15) CE(0,2) CE(1,3) CE(4,6) CE(5,7) CE(8,10) CE(9,11) CE(12,14) CE(13,15) CE(0,1) CE(2,3) CE(4,5) CE(6,7) CE(8,9) CE(10,11) CE(12,13) CE(14,15)
#undef CE
}
template <int BA, int BB> __device__ __forceinline__ void merge_top16(unsigned (&u)[64]) {
#pragma unroll
    for (int i = 0; i < 16; ++i) u[BA + i] = max(u[BA + i], u[BB + 15 - i]);
    bitonic16_desc<BA>(u);
}
__device__ __forceinline__ void top16_of_64(unsigned (&u)[64]) {
    sort16_desc<0>(u); sort16_desc<16>(u); sort16_desc<32>(u); sort16_desc<48>(u);
    merge_top16<0, 16>(u); merge_top16<32, 48>(u); merge_top16<0, 32>(u);
}
__device__ __forceinline__ void phase9(const Args& a, int gw, int NGW, int lane) {
    unsigned char* ws = a.ws;
    const bf16* SKB = (const bf16*)(ws + WS_SKB); const bf16* Q = (const bf16*)(ws + WS_Q);
    int* EIDX = (int*)(ws + WS_EIDX); float* GATE = (float*)(ws + WS_GATE);
    const int tokl = lane & 31, hh = lane >> 5;
    for (int unit = gw; unit < (M / 32) * PH; unit += NGW) {
        const int h = unit & 7, m0 = (unit >> 3) * 32;
        unsigned tc[2][16];
#pragma unroll
        for (int c = 0; c < 2; ++c) {
            f32x16 acc[4];
#pragma unroll
            for (int t = 0; t < 4; ++t)
#pragma unroll
                for (int r = 0; r < 16; ++r) acc[t][r] = 0.f;
            const bf16* qrow = Q + (size_t)(m0 + tokl) * 2048 + h * 256 + c * 128 + 8 * hh;
            const bf16* krow = SKB + ((size_t)(h * 2 + c) * 128 + tokl) * 128 + 8 * hh;
#pragma unroll 4
            for (int ks = 0; ks < 8; ++ks) {
                const bf16x8_t bq = __builtin_bit_cast(bf16x8_t, *(const GAS v4u*)(qrow + ks * 16));
#pragma unroll
                for (int t = 0; t < 4; ++t) { const bf16x8_t ak = __builtin_bit_cast(bf16x8_t, *(const GAS v4u*)(krow + t * 32 * 128 + ks * 16));
                    acc[t] = __builtin_amdgcn_mfma_f32_32x32x16_bf16(ak, bq, acc[t], 0, 0, 0); }
            }
            unsigned u[64];
#pragma unroll
            for (int t = 0; t < 4; ++t)
#pragma unroll
                for (int r = 0; r < 16; ++r) { const int nb = t * 32 + (r & 3) + 8 * (r >> 2);
                    u[t * 16 + r] = (f2ord(acc[t][r]) & ~127u) | (unsigned)(127 - nb - 4 * hh); }
            top16_of_64(u);
#pragma unroll
            for (int i = 0; i < 16; ++i) { const unsigned p = (unsigned)__shfl_xor((int)u[15 - i], 32); u[16 + i] = p; }
#pragma unroll
            for (int i = 0; i < 16; ++i) u[i] = max(u[i], u[16 + i]);
            bitonic16_desc<0>(u);
#pragma unroll
            for (int i = 0; i < 16; ++i) tc[c][i] = u[i];
        }
        float s0[16], s1[16]; unsigned n0[16], n1[16];
#pragma unroll
        for (int i = 0; i < 16; ++i) { s0[i] = ord2f(tc[0][i] & ~127u); s1[i] = ord2f(tc[1][i] & ~127u); n0[i] = (127u - (tc[0][i] & 127u)) << 7; n1[i] = 127u - (tc[1][i] & 127u); }
        unsigned u[64];
#define CAND(k, i, j) u[k] = (f2ord(s0[i] + s1[j]) & ~0x3FFFu) | (n0[i] | n1[j]);
        CAND(0,0,0) CAND(1,0,1) CAND(2,0,2) CAND(3,0,3) CAND(4,0,4) CAND(5,0,5) CAND(6,0,6) CAND(7,0,7) CAND(8,0,8) CAND(9,0,9) CAND(10,0,10) CAND(11,0,11) CAND(12,0,12) CAND(13,0,13) CAND(14,0,14) CAND(15,0,15) CAND(16,1,0) CAND(17,1,1) CAND(18,1,2) CAND(19,1,3) CAND(20,1,4) CAND(21,1,5) CAND(22,1,6) CAND(23,1,7) CAND(24,2,0) CAND(25,2,1) CAND(26,2,2) CAND(27,2,3) CAND(28,2,4) CAND(29,3,0) CAND(30,3,1) CAND(31,3,2) CAND(32,3,3) CAND(33,4,0) CAND(34,4,1) CAND(35,4,2) CAND(36,5,0) CAND(37,5,1) CAND(38,6,0) CAND(39,6,1) CAND(40,7,0) CAND(41,7,1) CAND(42,8,0) CAND(43,9,0) CAND(44,10,0) CAND(45,11,0) CAND(46,12,0) CAND(47,13,0) CAND(48,14,0) CAND(49,15,0)
#undef CAND
#pragma unroll
        for (int k = 50; k < 64; ++k) u[k] = 0u;
        top16_of_64(u);
        float ex[16]; float den = 0.f; const float mx = ord2f(u[0] & ~0x3FFFu);
#pragma unroll
        for (int r = 0; r < 16; ++r) { ex[r] = __expf(ord2f(u[r] & ~0x3FFFu) - mx); den += ex[r]; }
        const float inv = 1.0f / den;
        if (hh == 0) {
            const size_t o = (size_t)(m0 + tokl) * 128 + h * 16;
#pragma unroll
            for (int r4 = 0; r4 < 4; ++r4) {
                *(GAS v4u*)(EIDX + o + r4 * 4) = (v4u){u[r4 * 4] & 0x3FFFu, u[r4 * 4 + 1] & 0x3FFFu, u[r4 * 4 + 2] & 0x3FFFu, u[r4 * 4 + 3] & 0x3FFFu};
                *(GAS f32x4*)(GATE + o + r4 * 4) = (f32x4){ex[r4 * 4] * inv, ex[r4 * 4 + 1] * inv, ex[r4 * 4 + 2] * inv, ex[r4 * 4 + 3] * inv};
            }
        }
    }
}

__device__ __forceinline__ float gelu_erf(float v) { return 0.5f * v * (1.0f + erff(v * 0.70710678118f)); }
constexpr int PW_BYTES = 1536;
__device__ __forceinline__ void phase10(const Args& a, LAS unsigned char* lds, int gw, int NGW, int wave, int lane, float* OUT) {
    unsigned char* ws = a.ws;
    const bf16* HB = (const bf16*)(ws + WS_XN); const float* SSQ = (const float*)(ws + WS_SSQ);
    const int* EIDX = (const int*)(ws + WS_EIDX); const float* GATE = (const float*)(ws + WS_GATE);
    const unsigned char* DQ = ws + WS_DQ; const unsigned char* UQ = ws + WS_UQ; const float* DS = (const float*)(ws + WS_DSCALE); const float* US = (const float*)(ws + WS_USCALE);
    const float* nfw = a.in[21]; const float* n2w = a.in[16];
    LAS int* le = (LAS int*)(lds + wave * PW_BYTES); LAS float* lg = (LAS float*)(lds + wave * PW_BYTES + 512); LAS float* lc = (LAS float*)(lds + wave * PW_BYTES + 1024);
    for (int m = gw; m < M; m += NGW) {
        int ln = lane; asm volatile("" : "+v"(ln));
        const float rs2 = 1.0f / sqrtf(SSQ[m] * (1.0f / D) + 1e-6f);
        LDS_WAIT();
        le[lane] = EIDX[(size_t)m * 128 + lane]; le[lane + 64] = EIDX[(size_t)m * 128 + 64 + lane];
        lg[lane] = GATE[(size_t)m * 128 + lane]; lg[lane + 64] = GATE[(size_t)m * 128 + 64 + lane];
        float xs[64];
#pragma unroll
        for (int k = 0; k < 16; ++k) { const v2u w = *(const GAS v2u*)(HB + (size_t)m * D + k * 256 + ln * 4);
            xs[4 * k + 0] = bflo(w.x); xs[4 * k + 1] = bfhi(w.x); xs[4 * k + 2] = bflo(w.y); xs[4 * k + 3] = bfhi(w.y); }
        LDS_WAIT();
#if PEER_DN_MFMA
        float amx = 0.f;
#pragma unroll
        for (int i = 0; i < 64; ++i) amx = fmaxf(amx, fabsf(xs[i]));
        amx = fmaxf(wave_max(amx), 1e-30f);
        const float sx = 224.0f * __builtin_amdgcn_rcpf(amx), isx = amx * (1.0f / 224.0f);
        v8i xn0, xn1, xq0, xq1;
#pragma unroll
        for (int w = 0; w < 8; ++w) {
            int p0 = __builtin_amdgcn_cvt_pk_fp8_f32(xs[4 * w] * sx, xs[4 * w + 1] * sx, 0, false); p0 = __builtin_amdgcn_cvt_pk_fp8_f32(xs[4 * w + 2] * sx, xs[4 * w + 3] * sx, p0, true); xn0[w] = p0;
            int p1 = __builtin_amdgcn_cvt_pk_fp8_f32(xs[32 + 4 * w] * sx, xs[32 + 4 * w + 1] * sx, 0, false); p1 = __builtin_amdgcn_cvt_pk_fp8_f32(xs[32 + 4 * w + 2] * sx, xs[32 + 4 * w + 3] * sx, p1, true); xn1[w] = p1; }
        { const int srcA = (ln & 15) + 16 * (ln >> 5), srcB = srcA + 32; const bool odd = (ln & 16) != 0;
#pragma unroll
          for (int r = 0; r < 4; ++r) {
              int lo = __shfl(xn0[r], srcA), hi = __shfl(xn0[4 + r], srcA); xq0[r] = odd ? hi : lo; lo = __shfl(xn0[r], srcB); hi = __shfl(xn0[4 + r], srcB); xq0[4 + r] = odd ? hi : lo;
              lo = __shfl(xn1[r], srcA); hi = __shfl(xn1[4 + r], srcA); xq1[r] = odd ? hi : lo; lo = __shfl(xn1[r], srcB); hi = __shfl(xn1[4 + r], srcB); xq1[4 + r] = odd ? hi : lo; } }
        const bool dgv = ((lane & 15) >> 2) == (lane >> 4);
        const float dm0 = (dgv && (lane & 3) == 0) ? 1.f : 0.f, dm1 = (dgv && (lane & 3) == 1) ? 1.f : 0.f, dm2 = (dgv && (lane & 3) == 2) ? 1.f : 0.f, dm3 = (dgv && (lane & 3) == 3) ? 1.f : 0.f;
#else
        const float isx = 1.0f;
#endif
#pragma unroll 1
        for (int g = 0; g < 8; ++g) {
            float pv[16];
#pragma unroll
            for (int k = 0; k < 16; ++k) {
                const int e = __builtin_amdgcn_readfirstlane(le[g * 16 + k]);
                const unsigned char* rp = DQ + (size_t)e * ROWB_DN + lane * 16;
#if PEER_DN_MFMA
                { const v4u u0 = *(const GAS v4u*)(rp), u1 = *(const GAS v4u*)(rp + 1024);
                  const v8i a0 = {(int)u0.x, (int)u0.y, (int)u0.z, (int)u0.w, 0, 0, 0, 0}, a1 = {(int)u1.x, (int)u1.y, (int)u1.z, (int)u1.w, 0, 0, 0, 0};
                  f32x4 c4 = __builtin_amdgcn_mfma_scale_f32_16x16x128_f8f6f4(a0, xq0, (f32x4){0.f, 0.f, 0.f, 0.f}, 4, 0, 0, 0, 0, 0);
                  c4 = __builtin_amdgcn_mfma_scale_f32_16x16x128_f8f6f4(a1, xq1, c4, 4, 0, 0, 0, 0, 0);
                  pv[k] = (dm0 * c4[0] + dm1 * c4[1]) + (dm2 * c4[2] + dm3 * c4[3]); }
                continue;
#endif
                float ev[64];
#if PEER_DN_FP4
                { const v4u u0 = *(const GAS v4u*)(rp), u1 = *(const GAS v4u*)(rp + 1024);
#pragma unroll
                  for (int w = 0; w < 8; ++w) { const unsigned dw = w < 4 ? u0[w] : u1[w - 4];
#define FP4_DN(b2) { const f32x2 xy = __builtin_amdgcn_cvt_scalef32_pk_f32_fp4(dw, 1.0f, b2); ev[8 * w + 2 * (b2)] = xy.x; ev[8 * w + 2 * (b2) + 1] = xy.y; }
                      FP4_DN(0) FP4_DN(1) FP4_DN(2) FP4_DN(3)
#undef FP4_DN
                  } }
#else
                load_qrow(rp, ev);
#endif
                f32x2 p2a = (f32x2){0.f, 0.f}, p2b = (f32x2){0.f, 0.f};
#pragma unroll
                for (int i = 0; i < 16; ++i) { p2a += (f32x2){ev[4 * i], ev[4 * i + 1]} * (f32x2){xs[4 * i], xs[4 * i + 1]}; p2b += (f32x2){ev[4 * i + 2], ev[4 * i + 3]} * (f32x2){xs[4 * i + 2], xs[4 * i + 3]}; }
                const float p = (p2a.x + p2a.y) + (p2b.x + p2b.y);
                pv[k] = p;
            }
#pragma unroll
            for (int k = 0; k < 8; ++k) { const bool up = (lane & 32) != 0; const float send = up ? pv[k] : pv[k + 8], keep = up ? pv[k + 8] : pv[k]; pv[k] = keep + __shfl_xor(send, 32); }
#pragma unroll
            for (int k = 0; k < 4; ++k) { const bool up = (lane & 16) != 0; const float send = up ? pv[k] : pv[k + 4], keep = up ? pv[k + 4] : pv[k]; pv[k] = keep + __shfl_xor(send, 16); }
#pragma unroll
            for (int k = 0; k < 2; ++k) { const bool up = (lane & 8) != 0; const float send = up ? pv[k] : pv[k + 2], keep = up ? pv[k + 2] : pv[k]; pv[k] = keep + __shfl_xor(send, 8); }
            { const bool up = (lane & 4) != 0; const float send = up ? pv[0] : pv[1], keep = up ? pv[1] : pv[0]; pv[0] = keep + __shfl_xor(send, 4); }
            float tot = pv[0]; tot += __shfl_xor(tot, 1); tot += __shfl_xor(tot, 2);
            const int idx = g * 16 + ((lane >> 2) & 15); const int e = le[idx];
            const float c = lg[idx] * gelu_erf(tot * DS[e] * (rs2 * isx)) * US[e];
            if ((lane & 3) == 0) lc[idx] = c;
        }
        LDS_WAIT();
        float acc[64];
#pragma unroll
        for (int i = 0; i < 64; ++i) acc[i] = 0.f;
#if PEER_UP_FP4
#pragma unroll 2
        for (int idx = 0; idx < 128; ++idx) {
            const int e = __builtin_amdgcn_readfirstlane(le[idx]); const float c = __builtin_bit_cast(float, __builtin_amdgcn_readfirstlane(__builtin_bit_cast(int, lc[idx])));
            const unsigned char* rp = UQ + (size_t)e * ROWB_UP + lane * 16;
            const v4u u0 = *(const GAS v4u*)(rp), u1 = *(const GAS v4u*)(rp + 1024);
            const f32x2 cc = (f32x2){c, c};
#pragma unroll
            for (int w = 0; w < 8; ++w) { const unsigned dw = w < 4 ? u0[w] : u1[w - 4];
#define FP4_UP(b2) { const f32x2 xy = __builtin_amdgcn_cvt_scalef32_pk_f32_fp4(dw, 1.0f, b2); const int t0 = 8 * w + 2 * (b2); acc[t0] += c * xy.x; acc[t0 + 1] += c * xy.y; }
                FP4_UP(0) FP4_UP(1) FP4_UP(2) FP4_UP(3)
#undef FP4_UP
            }
        }
#else
#pragma unroll 4
        for (int idx = 0; idx < 128; ++idx) {
            const int e = __builtin_amdgcn_readfirstlane(le[idx]); const float c = __builtin_bit_cast(float, __builtin_amdgcn_readfirstlane(__builtin_bit_cast(int, lc[idx])));
            const unsigned char* rp = UQ + (size_t)e * ROWB + lane * 16;
            float ev[64]; load_qrow(rp, ev);
#pragma unroll
            for (int i = 0; i < 64; ++i) acc[i] += c * ev[i];
        }
#endif
        float ss = 0.f;
#pragma unroll
        for (int i = 0; i < 4; ++i)
#pragma unroll
            for (int j = 0; j < 4; ++j) { const v2u hw = *(const GAS v2u*)(HB + (size_t)m * D + (i * 4 + j) * 256 + ln * 4); const f32x4 nv = *(const GAS f32x4*)(n2w + (i * 4 + j) * 256 + ln * 4);
                f32x4 hv; hv.x = bflo(hw.x) * __builtin_amdgcn_rcpf(nv.x); hv.y = bfhi(hw.x) * __builtin_amdgcn_rcpf(nv.y); hv.z = bflo(hw.y) * __builtin_amdgcn_rcpf(nv.z); hv.w = bfhi(hw.y) * __builtin_amdgcn_rcpf(nv.w);
                acc[i * 16 + j * 4 + 0] += hv.x; acc[i * 16 + j * 4 + 1] += hv.y; acc[i * 16 + j * 4 + 2] += hv.z; acc[i * 16 + j * 4 + 3] += hv.w;
                ss += (acc[i * 16 + j * 4 + 0] * acc[i * 16 + j * 4 + 0] + acc[i * 16 + j * 4 + 1] * acc[i * 16 + j * 4 + 1]) + (acc[i * 16 + j * 4 + 2] * acc[i * 16 + j * 4 + 2] + acc[i * 16 + j * 4 + 3] * acc[i * 16 + j * 4 + 3]); }
        const float rsf = 1.0f / sqrtf(wave_sum(ss) * (1.0f / D) + 1e-6f);
#pragma unroll
        for (int i = 0; i < 4; ++i)
#pragma unroll
            for (int j = 0; j < 4; ++j) { const f32x4 wv = *(const GAS f32x4*)(nfw + (i * 4 + j) * 256 + ln * 4);
                f32x4 o; o.x = acc[i * 16 + j * 4 + 0] * rsf * wv.x; o.y = acc[i * 16 + j * 4 + 1] * rsf * wv.y; o.z = acc[i * 16 + j * 4 + 2] * rsf * wv.z; o.w = acc[i * 16 + j * 4 + 3] * rsf * wv.w;
                *(GAS f32x4*)(OUT + (size_t)m * D + (i * 4 + j) * 256 + ln * 4) = o; }
    }
}

__global__ void __launch_bounds__(NTHREADS, 2) mega_fwd(Args args) {
    extern __shared__ __attribute__((aligned(16))) unsigned char lds_raw[];
    LAS unsigned char* lds = (LAS unsigned char*)lds_raw;
    volatile LAS unsigned* MISC = (volatile LAS unsigned*)(lds + MISC_OFF);
    const int tid = threadIdx.x, lane = tid & 63, wave = __builtin_amdgcn_readfirstlane(tid >> 6);
    const int G = gridDim.x, bx = blockIdx.x;
    const int vcu = (G % 8 == 0) ? (bx % 8) * (G / 8) + bx / 8 : bx;
    const int gw = vcu * NWAVES + wave, NGW = G * NWAVES, gt = gw * 64 + lane, NGT = NGW * 64;
    unsigned char* ws = args.ws;
    for (int u = tid; u < (LDS_BYTES - LDSCTL_OFF) / 4; u += NTHREADS) ((LAS unsigned*)(lds + LDSCTL_OFF))[u] = 0u;
    __syncthreads();
    XcdBarrier bar; bar.bar = (unsigned*)(ws + WS_CTL) + CW_BAR + args.li * XCD_BAR_WORDS; bar.x = 0; bar.st = nullptr;
    if (MK_N_LAUNCHES == 1) bar = xcd_barrier_post((unsigned*)(ws + WS_CTL) + CW_BAR + args.li * XCD_BAR_WORDS, MISC + 8);
    const int lo = args.ph_lo, hi = args.ph_hi;
#ifndef PHASE_MASK
#define PHASE_MASK 0xfff
#endif
#define IN(k) (((PHASE_MASK >> (k)) & 1) && lo <= (k) && (k) < hi)
#ifndef DUP_MASK
#define DUP_MASK 0
#endif
#define DUP(k) ((DUP_MASK >> (k)) & 1)
#define SEAM(k) do { if (IN(k) && IN((k) + 1)) xcd_barrier(bar); } while (0)

    if (IN(0)) { phase0(args, lds, gw, NGW, wave, lane); if (DUP(0)) { __syncthreads(); phase0(args, lds, gw, NGW, wave, lane); } } SEAM(0);
    if (IN(1)) {
        pg8::Gemm g{(const bf16*)(ws + WS_XN), (const bf16*)(ws + WS_WINT), M, NPROJ, D, D}; pg8::StaticOrder S; S.init(M, NPROJ, G, bx);
        pg8::EpiPlainBf16 E{(bf16*)(ws + WS_PROJ), NPROJ};
        pg8::gemm_phase<pg8::EpiPlainBf16, pg8::StaticOrder, true, true>(lds + RING_OFF, g, S, E);
        if (DUP(1)) { __syncthreads(); pg8::gemm_phase<pg8::EpiPlainBf16, pg8::StaticOrder, true, true>(lds + RING_OFF, g, S, E); }
        for (int u = bx; u < (M / 256) * 2 * KSPLIT; u += G) {
            const int pm = u >> 3, pnl = (u >> 2) & 1, ks = u & 3;
            __syncthreads();
            pg8::Gemm g2{(const bf16*)(ws + WS_XN) + ks * (D / KSPLIT), (const bf16*)(ws + WS_WINT) + (size_t)NPROJ * D + ks * (D / KSPLIT), M, SLABW, D / KSPLIT, D};
            pg8::SingleUnit S2{pm, pnl}; pg8::EpiSlabF32 E2{(float*)(ws + WS_SLAB) + (size_t)ks * M * SLABW, SLABW};
            pg8::gemm_phase<pg8::EpiSlabF32, pg8::SingleUnit, false, true>(lds + RING_OFF, g2, S2, E2);
        }
    } SEAM(1);
    if (IN(2)) { phase2(args, gt, NGT); if (DUP(2)) phase2(args, gt, NGT); } SEAM(2);
    if (IN(3)) {
        pg8::Gemm g{(const bf16*)(ws + WS_LIN), (const bf16*)(ws + WS_WLORA), M, NLORA, KLORA, KLORA}; pg8::StaticOrder S; S.init(M, NLORA, G, bx);
        pg8::EpiLora E{(float*)(ws + WS_WD), (bf16*)(ws + WS_AA), (bf16*)(ws + WS_G), args.in[4], args.in[6]};
        pg8::gemm_phase<pg8::EpiLora, pg8::StaticOrder, true, true>(lds + RING_OFF, g, S, E);
        if (DUP(3)) { __syncthreads(); pg8::gemm_phase<pg8::EpiLora, pg8::StaticOrder, true, true>(lds + RING_OFF, g, S, E); }
    } SEAM(3);
    if (!SCAN_CHUNKED) { if (IN(4)) { phase4(args, gw, NGW, lane); } SEAM(4); }
    if (IN(5)) { if (SCAN_CHUNKED) phase5a(args, lds, gw, NGW, wave, lane); else phase5(args, lds, tid); } SEAM(5);
    if (IN(6)) { if (SCAN_CHUNKED) phase5b(args, lds, bx, G, tid, wave, lane); } SEAM(6);
    if (IN(7)) { phase6(args, gw, NGW, lane); if (DUP(7)) phase6(args, gw, NGW, lane); } SEAM(7);
    if (IN(8)) {
        pg8::Gemm g{(const bf16*)(ws + WS_MIXED), (const bf16*)(ws + WS_WOUTT), M, D, D, D}; pg8::StaticOrder S; S.init(M, D, G, bx);
        pg8::EpiOut<true> E{args.in[0], args.out, (bf16*)(ws + WS_XN), args.in[16], (float*)(ws + WS_SSQ)};
        pg8::gemm_phase<pg8::EpiOut<true>, pg8::StaticOrder, true, true>(lds + RING_OFF, g, S, E);
        if (DUP(8)) { __syncthreads(); pg8::EpiOut<false> E2{args.in[0], args.out, (bf16*)(ws + WS_XN), args.in[16], (float*)(ws + WS_SSQ)}; pg8::gemm_phase<pg8::EpiOut<false>, pg8::StaticOrder, true, true>(lds + RING_OFF, g, S, E2); }
    } SEAM(8);
    if (IN(9)) {
        pg8::Gemm g{(const bf16*)(ws + WS_XN), (const bf16*)(ws + WS_WQT), M, 2048, D, D}; pg8::StaticOrder S; S.init(M, 2048, G, bx);
        pg8::EpiQ E{(bf16*)(ws + WS_Q), (const float*)(ws + WS_SSQ)};
        pg8::gemm_phase<pg8::EpiQ, pg8::StaticOrder, true, true>(lds + RING_OFF, g, S, E);
        if (DUP(9)) { __syncthreads(); pg8::gemm_phase<pg8::EpiQ, pg8::StaticOrder, true, true>(lds + RING_OFF, g, S, E); }
    } SEAM(9);
    if (IN(10)) { phase9(args, gw, NGW, lane); if (DUP(10)) phase9(args, gw, NGW, lane); } SEAM(10);
    if (IN(11)) { if (DUP(11)) phase10(args, lds, gw, NGW, wave, lane, (float*)(ws + WS_PROJ)); phase10(args, lds, gw, NGW, wave, lane, args.out); }
#undef IN
#undef SEAM
}

extern "C" void kernel_launch(void* const* d_in, const int* in_sizes, int n_in, void* d_out, int out_size, void* d_ws, size_t ws_size, hipStream_t stream) {
    static int grid = 0;
    if (grid == 0) {
        if (n_in != 22 || in_sizes[0] != M * D || out_size != M * D || ws_size < WS_END) { fprintf(stderr, "kernel_launch: unexpected shapes: n_in %d in0 %d out %d ws %zu (need %zu)\n", n_in, n_in > 0 ? in_sizes[0] : -1, out_size, ws_size, (size_t)WS_END); grid = -1; return; }
        int dev = 0, cus = 0, per_cu = 0;
        if (hipGetDevice(&dev) != hipSuccess || hipDeviceGetAttribute(&cus, hipDeviceAttributeMultiprocessorCount, dev) != hipSuccess) { grid = -1; return; }
        if (hipFuncSetAttribute((const void*)mega_fwd, hipFuncAttributeMaxDynamicSharedMemorySize, LDS_BYTES) != hipSuccess) { fprintf(stderr, "kernel_launch: hipFuncSetAttribute failed\n"); grid = -1; return; }
        if (hipOccupancyMaxActiveBlocksPerMultiprocessor(&per_cu, (const void*)mega_fwd, NTHREADS, LDS_BYTES) != hipSuccess || per_cu < 1) { fprintf(stderr, "kernel_launch: occupancy query says %d blocks per CU\n", per_cu); }
        (void)hipGetLastError();
        grid = cus;
    }
    if (grid < 0) return;
    (void)hipMemsetAsync((char*)d_ws + WS_CTL, 0, CTL_ZERO_BYTES, stream);
    Args a{};
    for (int i = 0; i < 22; ++i) a.in[i] = (const float*)d_in[i];
    a.out = (float*)d_out; a.ws = (unsigned char*)d_ws;
#ifndef REPEAT_PREFIX
#define REPEAT_PREFIX 0
#endif
    if (MK_N_LAUNCHES == 1) { a.ph_lo = 0; a.ph_hi = NPHASES; hipLaunchKernelGGL(mega_fwd, dim3(grid), dim3(NTHREADS), LDS_BYTES, stream, a);
        if (REPEAT_PREFIX > 0) { a.ph_hi = REPEAT_PREFIX; a.li = 1; hipLaunchKernelGGL(mega_fwd, dim3(grid), dim3(NTHREADS), LDS_BYTES, stream, a); } }
    else for (int p = 0; p < NPHASES; ++p) { a.ph_lo = p; a.ph_hi = p + 1; hipLaunchKernelGGL(mega_fwd, dim3(grid), dim3(NTHREADS), LDS_BYTES, stream, a); }
}
```

```cpp
#include <hip/hip_runtime.h>
#include <cstdio>
#include <cstdint>
namespace pg8 {
#define PG8_LAS __attribute__((address_space(3)))
typedef unsigned short bf16_t;
typedef short bf16x8 __attribute__((ext_vector_type(8)));
typedef float f32x4 __attribute__((ext_vector_type(4)));
typedef unsigned u32x4 __attribute__((ext_vector_type(4)));
constexpr int BM = 256, BK = 64, HALF = 128, HTB = HALF * BK * 2  , STAGE_BYTES = 8 * HTB, NXCD = 8, WGM = 8;

__host__ __device__ __forceinline__ int lds_byte(int r, int c) { const int st = (r >> 4) * 2 + (c >> 5), rr = r & 15, cc = c & 31, ob = rr * 64 + cc * 2; return st * 1024 + (ob ^ (((ob >> 9) & 1) << 5)); }
__host__ __device__ __forceinline__ void stage_rc(int b, int& R, int& C) { const int st = b / 1024, sb = b % 1024, swz = sb ^ (((sb >> 9) & 1) << 5); R = (st >> 1) * 16 + swz / 64; C = (st & 1) * 32 + (swz % 64) / 2; }
__host__ __device__ __forceinline__ int perm32(int rho) { const int n = rho >> 4, i = rho & 15; return 8 * (i >> 2) + 4 * n + (i & 3); }

struct Unit { int pm, pn; };
struct Gemm { const bf16_t* A; const bf16_t* Bt; int M, N, K, ld; };

struct StaticOrder {
    int nM, nN, nwg, G, c;
    __host__ __device__ void init(int M, int N, int G_, int c_) { nM = M / BM; nN = N / BM; nwg = nM * nN; G = G_; c = c_; }
    __host__ __device__ bool next(int i, Unit& u) const {
        const long L = (long)i * G + c; if (L >= nwg) return false;
        int wgid = (int)L; { const int q = nwg / NXCD, r = nwg % NXCD, xcd = wgid % NXCD, off = wgid / NXCD; wgid = (xcd < r ? xcd * (q + 1) : r * (q + 1) + (xcd - r) * q) + off; }
        const int nig = WGM * nN, gid = wgid / nig, fm = gid * WGM, gsz = (nM - fm) < WGM ? (nM - fm) : WGM;
        u.pm = fm + ((wgid % nig) % gsz); u.pn = (wgid % nig) / gsz; return true;
    }
    __device__ __forceinline__ void a_ready(const Unit&) const {}
    __device__ __forceinline__ void done(const Unit&) const {}
};

struct SingleUnit {
    int pm, pn;
    __device__ __forceinline__ bool next(int i, Unit& u) const { if (i != 0) return false; u.pm = pm; u.pn = pn; return true; }
    __device__ __forceinline__ void a_ready(const Unit&) const {}
    __device__ __forceinline__ void done(const Unit&) const {}
};
__device__ __forceinline__ unsigned cvt_pk_bf16(float lo, float hi) { unsigned r; asm volatile("v_cvt_pk_bf16_f32 %0, %1, %2" : "=v"(r) : "v"(lo), "v"(hi)); return r; }
typedef float f32x2 __attribute__((ext_vector_type(2)));
__device__ __forceinline__ f32x2 gelu_pk(f32x2 v) {
    const f32x2 av = __builtin_elementwise_abs(v), d = av * 0.2316418882f + 1.0f;
    f32x2 t; t.x = __builtin_amdgcn_rcpf(d.x); t.y = __builtin_amdgcn_rcpf(d.y);
    f32x2 q = t * 0.5307027145f + (-0.7265760135f); q = q * t + 0.7107068705f; q = q * t + (-0.142248368f); q = q * t + 0.127414796f; q = q * t;
    const f32x2 s = (v * v) * (-0.72134752044f);
    f32x2 e; e.x = __builtin_amdgcn_exp2f(s.x); e.y = __builtin_amdgcn_exp2f(s.y);
    const f32x2 m = v * (q * e), r = v - m;
    f32x2 o; o.x = v.x < 0.f ? m.x : r.x; o.y = v.y < 0.f ? m.y : r.y; return o;
}


typedef unsigned u32x2 __attribute__((ext_vector_type(2)));
__device__ __forceinline__ float fast_sigmoid(float v) { return __builtin_amdgcn_rcpf(1.0f + __expf(-v)); }

struct EpiPlainBf16 {
    static constexpr bool PERM = true, AFTER_DRAIN = false;
    bf16_t* O; int ldc;
    __device__ __forceinline__ void operator()(const f32x4 (&acc)[2][2][4][2], const Unit& u, int wr, int wc, int fr, int fq) const {
        const int row0 = u.pm * BM + wr * 64 + fr, col0 = u.pn * BM + wc * 32 + 8 * fq;
#pragma unroll
        for (int ai = 0; ai < 2; ++ai)
#pragma unroll
            for (int m = 0; m < 4; ++m) { bf16_t* rowp = O + (size_t)(row0 + ai * HALF + m * 16) * ldc + col0;
#pragma unroll
                for (int bj = 0; bj < 2; ++bj) { const f32x4 v0 = acc[ai][bj][m][0], v1 = acc[ai][bj][m][1];
                    u32x4 w; w.x = cvt_pk_bf16(v0[0], v0[1]); w.y = cvt_pk_bf16(v0[2], v0[3]); w.z = cvt_pk_bf16(v1[0], v1[1]); w.w = cvt_pk_bf16(v1[2], v1[3]);
                    *(u32x4*)(rowp + bj * HALF) = w; } }
    }
};

struct EpiSlabF32 {
    static constexpr bool PERM = false, AFTER_DRAIN = false;
    float* O; int ldc;
    __device__ __forceinline__ void operator()(const f32x4 (&acc)[2][2][4][2], const Unit& u, int wr, int wc, int fr, int fq) const {
        const int row0 = u.pm * BM + wr * 64 + fr, col0 = u.pn * BM + wc * 32 + 4 * fq;
#pragma unroll
        for (int ai = 0; ai < 2; ++ai)
#pragma unroll
            for (int m = 0; m < 4; ++m) { float* rowp = O + (size_t)(row0 + ai * HALF + m * 16) * ldc + col0;
#pragma unroll
                for (int bj = 0; bj < 2; ++bj)
#pragma unroll
                    for (int n = 0; n < 2; ++n) *(f32x4*)(rowp + bj * HALF + n * 16) = acc[ai][bj][m][n]; }
    }
};

#ifndef SCAN_CHUNKED
#define SCAN_CHUNKED 1
#endif
struct EpiLora {
    static constexpr bool PERM = true, AFTER_DRAIN = false;
    float* Wd; bf16_t* Aa; bf16_t* Gg; const float* w0; const float* a0;
    template <int KIND> __device__ __forceinline__ void run(const f32x4 (&acc)[2][2][4][2], const Unit& u, int wr, int wc, int fr, int fq) const {
        const int row0 = u.pm * BM + wr * 64 + fr, col0 = (u.pn & 7) * BM + wc * 32 + 8 * fq;
        f32x4 bv[2][2];
#pragma unroll
        for (int bj = 0; bj < 2; ++bj)
#pragma unroll
            for (int n = 0; n < 2; ++n) { if (KIND == 2) bv[bj][n] = (f32x4){0.f, 0.f, 0.f, 0.f}; else bv[bj][n] = *(const f32x4*)((KIND == 0 ? w0 : a0) + col0 + bj * HALF + 4 * n); }
#pragma unroll
        for (int ai = 0; ai < 2; ++ai)
#pragma unroll
            for (int m = 0; m < 4; ++m) { const size_t roff = (size_t)(row0 + ai * HALF + m * 16) * 2048 + col0;
#pragma unroll
                for (int bj = 0; bj < 2; ++bj) { f32x4 v0 = acc[ai][bj][m][0] + bv[bj][0], v1 = acc[ai][bj][m][1] + bv[bj][1];
                    if (KIND == 0) {
                        f32x4 d0, d1;
                        d0.x = -0.60653066f * fast_sigmoid(v0.x); d0.y = -0.60653066f * fast_sigmoid(v0.y); d0.z = -0.60653066f * fast_sigmoid(v0.z); d0.w = -0.60653066f * fast_sigmoid(v0.w);
                        d1.x = -0.60653066f * fast_sigmoid(v1.x); d1.y = -0.60653066f * fast_sigmoid(v1.y); d1.z = -0.60653066f * fast_sigmoid(v1.z); d1.w = -0.60653066f * fast_sigmoid(v1.w);
                        if (!SCAN_CHUNKED) { d0.x = __expf(d0.x); d0.y = __expf(d0.y); d0.z = __expf(d0.z); d0.w = __expf(d0.w); d1.x = __expf(d1.x); d1.y = __expf(d1.y); d1.z = __expf(d1.z); d1.w = __expf(d1.w); }
                        *(f32x4*)(Wd + roff + bj * HALF) = d0; *(f32x4*)(Wd + roff + bj * HALF + 4) = d1;
                    } else {
                        if (KIND == 1) { v0.x = fast_sigmoid(v0.x); v0.y = fast_sigmoid(v0.y); v0.z = fast_sigmoid(v0.z); v0.w = fast_sigmoid(v0.w); v1.x = fast_sigmoid(v1.x); v1.y = fast_sigmoid(v1.y); v1.z = fast_sigmoid(v1.z); v1.w = fast_sigmoid(v1.w); }
                        u32x4 w; w.x = cvt_pk_bf16(v0.x, v0.y); w.y = cvt_pk_bf16(v0.z, v0.w); w.z = cvt_pk_bf16(v1.x, v1.y); w.w = cvt_pk_bf16(v1.z, v1.w);
                        *(u32x4*)((KIND == 1 ? Aa : Gg) + roff + bj * HALF) = w;
                    } } }
    }
    __device__ __forceinline__ void operator()(const f32x4 (&acc)[2][2][4][2], const Unit& u, int wr, int wc, int fr, int fq) const {
        const int kind = u.pn >> 3;
        if (kind == 0) run<0>(acc, u, wr, wc, fr, fq); else if (kind == 1) run<1>(acc, u, wr, wc, fr, fq); else run<2>(acc, u, wr, wc, fr, fq);
    }
};

template <bool ATOM> struct EpiOut {
    static constexpr bool PERM = true, AFTER_DRAIN = false;
    const float* X; float* H1; bf16_t* HB; const float* nw; float* ssq;
    __device__ __forceinline__ void operator()(const f32x4 (&acc)[2][2][4][2], const Unit& u, int wr, int wc, int fr, int fq) const {
        const int row0 = u.pm * BM + wr * 64 + fr, col0 = u.pn * BM + wc * 32 + 8 * fq;
        f32x4 nv[2][2];
#pragma unroll
        for (int bj = 0; bj < 2; ++bj)
#pragma unroll
            for (int n = 0; n < 2; ++n) nv[bj][n] = *(const f32x4*)(nw + col0 + bj * HALF + 4 * n);
#pragma unroll
        for (int ai = 0; ai < 2; ++ai)
#pragma unroll
            for (int m = 0; m < 4; ++m) { const int row = row0 + ai * HALF + m * 16; const size_t roff = (size_t)row * 4096 + col0; float s = 0.f;
#pragma unroll
                for (int bj = 0; bj < 2; ++bj) {
                    const f32x4 x0 = *(const f32x4*)(X + roff + bj * HALF), x1 = *(const f32x4*)(X + roff + bj * HALF + 4);
                    const f32x4 h0 = acc[ai][bj][m][0] + x0, h1 = acc[ai][bj][m][1] + x1;
                    s += (h0[0] * h0[0] + h0[1] * h0[1]) + (h0[2] * h0[2] + h0[3] * h0[3]) + (h1[0] * h1[0] + h1[1] * h1[1]) + (h1[2] * h1[2] + h1[3] * h1[3]);
                    const f32x4 g0 = h0 * nv[bj][0], g1 = h1 * nv[bj][1];
                    u32x4 w; w.x = cvt_pk_bf16(g0[0], g0[1]); w.y = cvt_pk_bf16(g0[2], g0[3]); w.z = cvt_pk_bf16(g1[0], g1[1]); w.w = cvt_pk_bf16(g1[2], g1[3]);
                    *(u32x4*)(HB + roff + bj * HALF) = w; }
                s += __shfl_xor(s, 16); s += __shfl_xor(s, 32);
                if (ATOM && fq == 0) atomicAdd(ssq + row, s); }
    }
};

struct EpiQ {
    static constexpr bool PERM = true, AFTER_DRAIN = false;
    bf16_t* Q; const float* ssq;
    __device__ __forceinline__ void operator()(const f32x4 (&acc)[2][2][4][2], const Unit& u, int wr, int wc, int fr, int fq) const {
        const int row0 = u.pm * BM + wr * 64 + fr, col0 = u.pn * BM + wc * 32 + 8 * fq;
#pragma unroll
        for (int ai = 0; ai < 2; ++ai)
#pragma unroll
            for (int m = 0; m < 4; ++m) { const int row = row0 + ai * HALF + m * 16; const float rs = __builtin_amdgcn_rsqf(ssq[row] * (1.0f / 4096.0f) + 1e-6f);
                bf16_t* rowp = Q + (size_t)row * 2048 + col0;
#pragma unroll
                for (int bj = 0; bj < 2; ++bj) { const f32x4 v0 = acc[ai][bj][m][0] * rs, v1 = acc[ai][bj][m][1] * rs;
                    u32x4 w; w.x = cvt_pk_bf16(v0[0], v0[1]); w.y = cvt_pk_bf16(v0[2], v0[3]); w.z = cvt_pk_bf16(v1[0], v1[1]); w.w = cvt_pk_bf16(v1[2], v1[3]);
                    *(u32x4*)(rowp + bj * HALF) = w; } }
    }
};

template <class Epi, class Sched, bool ALIGN_EPI = false, bool SP2 = false>
__device__ __forceinline__ void gemm_phase(PG8_LAS unsigned char* lds, const Gemm g, const Sched& S, const Epi& E) {
    const int tid = threadIdx.x, wid = __builtin_amdgcn_readfirstlane(tid >> 6), lane = tid & 63, wr = wid >> 2, wc = wid & 3, fr = lane & 15, fq = lane >> 4;
    const int K = g.ld, nt = g.K / BK;
    unsigned voffA[2], voffB[2];
#pragma unroll
    for (int i = 0; i < 2; ++i) { int R, C; stage_rc(tid * 16 + i * 8192, R, C); const int Rb = Epi::PERM ? ((R & ~31) + perm32(R & 31)) : R;
        voffA[i] = (unsigned)(R * K + C) * 2u; voffB[i] = (unsigned)(Rb * K + C) * 2u; }
    const size_t kstep = (size_t)(BK * 2);
    const size_t hstep = (size_t)HALF * K * 2;
    const size_t tstep = 2 * hstep;
    const unsigned ldsw = (unsigned)wid * 1024u;
    const int aoff = lds_byte(wr * 64 + fr, fq * 8), boff = lds_byte(wc * 32 + fr, fq * 8);
#define PG8_SA(b, h) (((b) * 2 + (h)) * HTB)
#define PG8_SB(b, h) ((4 + (b) * 2 + (h)) * HTB)
#define PG8_STAGE(bufoff, gbase, voff) do { _Pragma("unroll") for (int _i = 0; _i < 2; ++_i) \
        __builtin_amdgcn_global_load_lds((const unsigned*)((const char*)(gbase) + (voff)[_i]), (PG8_LAS unsigned*)(lds + (bufoff) + ldsw + _i * 8192), 16, 0, 0); } while (0)
#define PG8_LDA(dst, b, h) do { _Pragma("unroll") for (int m = 0; m < 4; ++m) _Pragma("unroll") for (int k = 0; k < 2; ++k) dst[m][k] = *(const PG8_LAS bf16x8*)(lds + PG8_SA(b, h) + aoff + m * 2048 + k * 1024); } while (0)
#define PG8_LDB(dst, b, h) do { _Pragma("unroll") for (int n = 0; n < 2; ++n) _Pragma("unroll") for (int k = 0; k < 2; ++k) dst[n][k] = *(const PG8_LAS bf16x8*)(lds + PG8_SB(b, h) + boff + n * 2048 + k * 1024); } while (0)
#define PG8_MMA(ai, bj, At, Bt) do { __builtin_amdgcn_s_setprio(1); _Pragma("unroll") for (int m = 0; m < 4; ++m) _Pragma("unroll") for (int n = 0; n < 2; ++n) _Pragma("unroll") for (int k = 0; k < 2; ++k) \
        acc[ai][bj][m][n] = __builtin_amdgcn_mfma_f32_16x16x32_bf16(Bt[n][k], At[m][k], acc[ai][bj][m][n], 0, 0, 0); __builtin_amdgcn_s_setprio(0); } while (0)
#define PG8_WAIT_V(n) asm volatile("s_waitcnt vmcnt(" #n ")" ::: "memory")
#define PG8_WAIT_L(n) asm volatile("s_waitcnt lgkmcnt(" #n ")" ::: "memory")
#define PG8_BAR __builtin_amdgcn_s_barrier()
#define PG8_SCHED __builtin_amdgcn_sched_barrier(0)
    Unit cur, nxt; int ui = 0;
    if (!S.next(0, cur)) return;
    f32x4 acc[2][2][4][2];
#pragma unroll
    for (int a = 0; a < 2; ++a)
#pragma unroll
        for (int b = 0; b < 2; ++b)
#pragma unroll
            for (int m = 0; m < 4; ++m)
#pragma unroll
                for (int n = 0; n < 2; ++n) acc[a][b][m][n] = (f32x4){0.f, 0.f, 0.f, 0.f};
    bf16x8 At[4][2], B0[2][2], B1[2][2];
    const char* cA = (const char*)g.A + (size_t)cur.pm * tstep; const char* cB = (const char*)g.Bt + (size_t)cur.pn * tstep;
    S.a_ready(cur);
    if constexpr (SP2) {
        PG8_STAGE(PG8_SB(0, 0), cB, voffB); PG8_STAGE(PG8_SB(0, 1), cB + hstep, voffB); PG8_STAGE(PG8_SA(0, 0), cA, voffA); PG8_STAGE(PG8_SA(0, 1), cA + hstep, voffA);
        if (wr == 1) PG8_BAR;
        PG8_WAIT_V(2); PG8_BAR;
        PG8_STAGE(PG8_SB(1, 0), cB + kstep, voffB); PG8_STAGE(PG8_SA(1, 0), cA + kstep, voffA); PG8_STAGE(PG8_SB(1, 1), cB + hstep + kstep, voffB);
        PG8_WAIT_V(6); PG8_BAR;
    } else {
        PG8_STAGE(PG8_SB(0, 0), cB, voffB); PG8_STAGE(PG8_SA(0, 0), cA, voffA); PG8_STAGE(PG8_SB(0, 1), cB + hstep, voffB); PG8_STAGE(PG8_SA(0, 1), cA + hstep, voffA);
        if (wr == 1) PG8_BAR;
        PG8_WAIT_V(4); PG8_BAR;
        PG8_STAGE(PG8_SB(1, 0), cB + kstep, voffB); PG8_STAGE(PG8_SA(1, 0), cA + kstep, voffA); PG8_STAGE(PG8_SB(1, 1), cB + hstep + kstep, voffB);
        PG8_WAIT_V(6); PG8_BAR;
    }
    for (;;) {
        const bool has_next = S.next(ui + 1, nxt);
        const char* nA = has_next ? (const char*)g.A + (size_t)nxt.pm * tstep : cA; const char* nB = has_next ? (const char*)g.Bt + (size_t)nxt.pn * tstep : cB;
        for (int t = 0; t < nt; t += 2) {
            const bool last = (t == nt - 2);
            const char* a1 = cA + (size_t)(t + 1) * kstep;
            const char* a2 = last ? nA : cA + (size_t)(t + 2) * kstep; const char* b2 = last ? nB : cB + (size_t)(t + 2) * kstep;
            const char* a3 = a2 + kstep; const char* b3 = b2 + kstep;
            if (last && has_next) S.a_ready(nxt);
            if constexpr (SP2) {
            PG8_LDB(B0, 0, 0); PG8_LDB(B1, 0, 1); PG8_SCHED; PG8_LDA(At, 0, 0); PG8_STAGE(PG8_SA(1, 1), a1 + hstep, voffA);
            PG8_WAIT_V(8); PG8_WAIT_L(0); PG8_BAR; PG8_MMA(0, 0, At, B0); PG8_MMA(0, 1, At, B1); PG8_BAR; PG8_SCHED;
            PG8_LDA(At, 0, 1); PG8_STAGE(PG8_SB(0, 0), b2, voffB); PG8_STAGE(PG8_SB(0, 1), b2 + hstep, voffB); PG8_STAGE(PG8_SA(0, 0), a2, voffA);
            PG8_WAIT_V(8); PG8_WAIT_L(0); PG8_BAR; PG8_MMA(1, 0, At, B0); PG8_MMA(1, 1, At, B1); PG8_BAR; PG8_SCHED;
            PG8_LDB(B0, 1, 0); PG8_LDB(B1, 1, 1); PG8_SCHED; PG8_LDA(At, 1, 0); PG8_STAGE(PG8_SA(0, 1), a2 + hstep, voffA);
            PG8_WAIT_V(8); PG8_WAIT_L(0); PG8_BAR; PG8_MMA(0, 0, At, B0); PG8_MMA(0, 1, At, B1); PG8_BAR; PG8_SCHED;
            PG8_LDA(At, 1, 1); PG8_STAGE(PG8_SB(1, 0), b3, voffB); PG8_STAGE(PG8_SB(1, 1), b3 + hstep, voffB); PG8_STAGE(PG8_SA(1, 0), a3, voffA);
            PG8_WAIT_V(8); PG8_WAIT_L(0); PG8_BAR; PG8_MMA(1, 0, At, B0); PG8_MMA(1, 1, At, B1); PG8_BAR; PG8_SCHED;
            } else {
            PG8_LDB(B0, 0, 0); PG8_SCHED; PG8_LDA(At, 0, 0); PG8_STAGE(PG8_SA(1, 1), a1 + hstep, voffA);
            PG8_WAIT_L(8); PG8_BAR; PG8_WAIT_L(0); PG8_MMA(0, 0, At, B0); PG8_BAR; PG8_SCHED;
            PG8_LDB(B1, 0, 1); PG8_STAGE(PG8_SB(0, 0), b2, voffB);
            PG8_BAR; PG8_WAIT_L(0); PG8_MMA(0, 1, At, B1); PG8_BAR;
            PG8_LDA(At, 0, 1); PG8_STAGE(PG8_SA(0, 0), a2, voffA);
            PG8_BAR; PG8_WAIT_L(0); PG8_MMA(1, 0, At, B0); PG8_BAR; PG8_SCHED;
            PG8_STAGE(PG8_SB(0, 1), b2 + hstep, voffB);
            PG8_WAIT_V(6); PG8_BAR; PG8_MMA(1, 1, At, B1); PG8_BAR;
            PG8_LDB(B0, 1, 0); PG8_SCHED; PG8_LDA(At, 1, 0); PG8_STAGE(PG8_SA(0, 1), a2 + hstep, voffA);
            PG8_WAIT_L(8); PG8_BAR; PG8_WAIT_L(0); PG8_MMA(0, 0, At, B0); PG8_BAR; PG8_SCHED;
            PG8_LDB(B1, 1, 1); PG8_STAGE(PG8_SB(1, 0), b3, voffB);
            PG8_BAR; PG8_WAIT_L(0); PG8_MMA(0, 1, At, B1); PG8_BAR;
            PG8_LDA(At, 1, 1); PG8_STAGE(PG8_SA(1, 0), a3, voffA);
            PG8_BAR; PG8_WAIT_L(0); PG8_MMA(1, 0, At, B0); PG8_BAR; PG8_SCHED;
            PG8_STAGE(PG8_SB(1, 1), b3 + hstep, voffB);
            PG8_WAIT_V(6); PG8_BAR; PG8_MMA(1, 1, At, B1); PG8_BAR;
            }
        }
        if constexpr (ALIGN_EPI) { if (wr == 0) PG8_BAR; }
        if constexpr (!Epi::AFTER_DRAIN) { E(acc, cur, wr, wc, fr, fq); S.done(cur); }
        if (!has_next) break;
#pragma unroll
        for (int a = 0; a < 2; ++a)
#pragma unroll
            for (int b = 0; b < 2; ++b)
#pragma unroll
                for (int m = 0; m < 4; ++m)
#pragma unroll
                    for (int n = 0; n < 2; ++n) acc[a][b][m][n] = (f32x4){0.f, 0.f, 0.f, 0.f};
        cur = nxt; cA = nA; cB = nB; ++ui;
        if constexpr (ALIGN_EPI) { if (wr == 1) PG8_BAR; }
    }
    PG8_WAIT_V(0);
    if constexpr (!ALIGN_EPI) { if (wr == 0) PG8_BAR; }
    PG8_BAR;
    if constexpr (Epi::AFTER_DRAIN) { E.fused(acc, cur, wr, wc, fr, fq, lds, wid, lane); S.done(cur); }
#undef PG8_SA
#undef PG8_SB
#undef PG8_STAGE
#undef PG8_LDA
#undef PG8_LDB
#undef PG8_MMA
#undef PG8_WAIT_V
#undef PG8_WAIT_L
#undef PG8_BAR
#undef PG8_SCHED
}
}


#define GAS __attribute__((address_space(1)))
#define LAS __attribute__((address_space(3)))
typedef unsigned short bf16;
typedef unsigned v4u __attribute__((ext_vector_type(4)));
typedef int v8i __attribute__((ext_vector_type(8)));
typedef unsigned v2u __attribute__((ext_vector_type(2)));
typedef float f32x4 __attribute__((ext_vector_type(4)));
typedef float f32x2 __attribute__((ext_vector_type(2)));
#define RLX_AGENT __ATOMIC_RELAXED, __HIP_MEMORY_SCOPE_AGENT
#define LDS_WAIT() asm volatile("s_waitcnt lgkmcnt(0)" ::: "memory")
#define VM_WAIT() asm volatile("s_waitcnt vmcnt(0)" ::: "memory")

constexpr int NWAVES = 8, NTHREADS = 512;
#ifndef MK_N_LAUNCHES
#define MK_N_LAUNCHES 1
#endif
constexpr int D = 4096, BATCH = 2, SEQ = 4096, M = BATCH * SEQ;
constexpr int RW = 2048, CW = 2048, NH = 32, HD = 64;
constexpr int RWKV_IN = 6592, IN_TOTAL = 12736, NWIN = 12800, NPROJ = 12288;
constexpr int COL_R = 0, COL_K = 2048, COL_V = 4096, COL_CB = 6144, COL_CC = 8192, COL_CH = 10240;
constexpr int SRC_WL = 6144, NLIN = 448, KSPLIT = 4, SLABW = 512;
constexpr int KLORA = 512, NLORA = 6144;
constexpr int PH = 8, NKEYS = 128, NEXP = 16384, PQ = 256, TOPK = 16;
constexpr int NPHASES = 12;

constexpr size_t MiB = 1u << 20;
constexpr size_t WS_CTL = 0, CTL_ZERO_BYTES = 64 * 1024;
constexpr size_t WS_SSQ = 1 * MiB;
constexpr size_t WS_DSCALE = WS_SSQ + 64 * 1024;
constexpr size_t WS_USCALE = WS_DSCALE + 64 * 1024;
constexpr size_t WS_BONUS = 2 * MiB;
constexpr size_t WS_WLORA = 4 * MiB;
constexpr size_t WS_WQT = 10 * MiB;
constexpr size_t WS_WOUTT = 26 * MiB;
constexpr size_t WS_WINT = 58 * MiB;
constexpr size_t WS_XN = 158 * MiB;
constexpr size_t WS_PROJ = 222 * MiB;
constexpr size_t WS_LIN = 422 * MiB;
constexpr size_t WS_WD = 430 * MiB;
constexpr size_t WS_AA = 494 * MiB;
constexpr size_t WS_G = 526 * MiB;
constexpr size_t WS_R = 558 * MiB, WS_K = 590 * MiB, WS_KK = 622 * MiB, WS_BB = 654 * MiB;
constexpr size_t WS_REC = 558 * MiB;
constexpr size_t WS_V = 750 * MiB;
constexpr size_t WS_SLAB = 718 * MiB;
constexpr size_t WS_Y = WS_WD;
constexpr size_t WS_MIXED = 782 * MiB;
constexpr size_t WS_Q = 846 * MiB;
constexpr size_t WS_EIDX = 878 * MiB;
constexpr size_t WS_GATE = 882 * MiB;
constexpr size_t WS_DQ = 886 * MiB;
constexpr size_t WS_UQ = 950 * MiB;
constexpr size_t WS_SKB = 1016 * MiB;
constexpr size_t WS_BR = 1014 * MiB, WS_KR = 1015 * MiB;
constexpr size_t WS_END = 1017 * MiB;

constexpr int CW_BAR = 1024;

constexpr int RING_OFF = 0, RING_BYTES = 131072;
constexpr int LDSCTL_OFF = 147456, MISC_OFF = LDSCTL_OFF + 64;
constexpr int LDS_BYTES = 147456 + 512;

__device__ __forceinline__ unsigned f2bf(float f) { unsigned u = __builtin_bit_cast(unsigned, f); return (u + 0x7fffu + ((u >> 16) & 1u)) >> 16; }
typedef __bf16 bf16x2v __attribute__((ext_vector_type(2)));
__device__ __forceinline__ unsigned pk2(float lo, float hi) { const bf16x2v r = __builtin_convertvector((f32x2){lo, hi}, bf16x2v); return __builtin_bit_cast(unsigned, r); }
__device__ __forceinline__ float bflo(unsigned w) { return __builtin_bit_cast(float, w << 16); }
__device__ __forceinline__ float bfhi(unsigned w) { return __builtin_bit_cast(float, w & 0xffff0000u); }
__device__ __forceinline__ float wave_sum(float v) {
#pragma unroll
    for (int o = 1; o < 64; o <<= 1) v += __shfl_xor(v, o);
    return v;
}
__device__ __forceinline__ float wave_max(float v) {
#pragma unroll
    for (int o = 1; o < 64; o <<= 1) v = fmaxf(v, __shfl_xor(v, o));
    return v;
}
__device__ __forceinline__ float sigmoidf_(float v) { return 1.0f / (1.0f + __expf(-v)); }

#define XB_TMO      128
#define XB_XCNT(j)  (256  + 64 * (j))
#define XB_XSUB(j)  (1280 + 64 * (j))
#define XB_XGEN(j)  (2304 + 64 * (j))
#define XB_TOP      3328
#define XB_TOPGEN   3392
#define XCD_BAR_WORDS 3456
#define XB_SPIN_CAP (1u << 22)
__device__ __forceinline__ unsigned xb_ld(unsigned* p)              { return __hip_atomic_load(p, __ATOMIC_RELAXED, __HIP_MEMORY_SCOPE_AGENT); }
__device__ __forceinline__ unsigned xb_add(unsigned* p, unsigned v) { return __hip_atomic_fetch_add(p, v, __ATOMIC_RELAXED, __HIP_MEMORY_SCOPE_AGENT); }
__device__ __forceinline__ unsigned xb_xcc_id() { return (unsigned)__builtin_amdgcn_s_getreg((3 << 11) | 20) & 0xFu; }
#define XB_SPIN(cond, bar) do { unsigned _sp = 0; while (cond) { __builtin_amdgcn_s_sleep(1); \
    if ((++_sp & 255u) == 0u) { if (xb_ld(&(bar)[XB_TMO])) break; if (_sp > XB_SPIN_CAP) { atomicAdd(&(bar)[XB_TMO], 1u); break; } } } } while (0)
struct XcdBarrier { unsigned* bar; unsigned x; volatile LAS unsigned* st; };
__device__ __forceinline__ XcdBarrier xcd_barrier_post(unsigned* bar, volatile LAS unsigned* st) {
    XcdBarrier b; b.bar = bar; b.x = xb_xcc_id(); b.st = st;
    if (threadIdx.x == 0) (void)xb_add(&bar[XB_XCNT(b.x)], 1u);
    return b;
}
__device__ __forceinline__ void xcd_barrier_complete(unsigned* bar, unsigned x, unsigned& nloc, unsigned& nx) {
    const unsigned G = gridDim.x * gridDim.y * gridDim.z;
    unsigned sum, cnt, mine, sp = 0u;
    for (;;) {
        sum = 0u; cnt = 0u; mine = 0u;
#pragma unroll
        for (unsigned j = 0; j < 16; ++j) { const unsigned c = xb_ld(&bar[XB_XCNT(j)]); sum += c; cnt += (c > 0u) ? 1u : 0u; mine = (j == x) ? c : mine; }
        if (sum == G) break;
        __builtin_amdgcn_s_sleep(1);
        if ((++sp & 255u) == 0u) { if (xb_ld(&bar[XB_TMO])) break; if (sp > XB_SPIN_CAP) { atomicAdd(&bar[XB_TMO], 1u); break; } }
    }
    nloc = mine > 0u ? mine : 1u; nx = cnt > 0u ? cnt : 1u;
}
__device__ __forceinline__ void xcd_barrier(const XcdBarrier& b) {
    asm volatile("s_waitcnt vmcnt(0)" ::: "memory");
    __syncthreads();
    if (threadIdx.x == 0) {
        unsigned* bar = b.bar;
        __builtin_amdgcn_s_waitcnt(0);
        unsigned nloc = b.st[0], nx = b.st[1];
        if (nloc == 0u) { xcd_barrier_complete(bar, b.x, nloc, nx); b.st[0] = nloc; b.st[1] = nx; }
        const unsigned old = xb_add(&bar[XB_XSUB(b.x)], 1u);
        const unsigned gen = old / nloc;
        if (old + 1u == (gen + 1u) * nloc) {
            __builtin_amdgcn_fence(__ATOMIC_RELEASE, "agent");
            asm volatile("s_waitcnt vmcnt(0)" ::: "memory");
            const unsigned og = xb_add(&bar[XB_TOP], 1u);
            const unsigned tg = og / nx;
            if (og + 1u == (tg + 1u) * nx) xb_add(&bar[XB_TOPGEN], 1u);
            else XB_SPIN(xb_ld(&bar[XB_TOPGEN]) == tg, bar);
            __builtin_amdgcn_fence(__ATOMIC_ACQUIRE, "agent");
            xb_add(&bar[XB_XGEN(b.x)], 1u);
            asm volatile("s_waitcnt vmcnt(0)" ::: "memory");
        } else {
            XB_SPIN(xb_ld(&bar[XB_XGEN(b.x)]) == gen, bar);
            __builtin_amdgcn_fence(__ATOMIC_ACQUIRE, "agent");
            asm volatile("s_waitcnt vmcnt(0)" ::: "memory");
        }
    }
    __syncthreads();
}

struct Args {
    const float* in[22]; float* out; unsigned char* ws; int ph_lo, ph_hi, li, pad;
};

template <bool WIN> __device__ __forceinline__ void p0_transpose_item(const float* W, int K, int N, bf16* WT, LAS float* scr, int item, int lane) {
    const int nblk = N / 32, kb = item / nblk, nb = item % nblk, k0 = 64 * kb, n0 = 32 * nb;
    const int d0 = !WIN ? n0 : (n0 < SRC_WL ? n0 : (n0 < RWKV_IN ? NPROJ + (n0 - SRC_WL) : n0 - NLIN));
#pragma unroll 8
    for (int i = 0; i < 32; ++i) { const int kk = 2 * i + (lane >> 5); scr[kk * 33 + (lane & 31)] = W[(size_t)(k0 + kk) * N + n0 + (lane & 31)]; }
    LDS_WAIT(); asm volatile("" ::: "memory");
    const int c = lane & 7;
#pragma unroll
    for (int j = 0; j < 4; ++j) { const int n = (lane >> 3) + 8 * j; const LAS float* s = scr + (8 * c) * 33 + n;
        v4u o; o.x = pk2(s[0 * 33], s[1 * 33]); o.y = pk2(s[2 * 33], s[3 * 33]); o.z = pk2(s[4 * 33], s[5 * 33]); o.w = pk2(s[6 * 33], s[7 * 33]);
        *(GAS v4u*)(WT + (size_t)(d0 + n) * K + k0 + 8 * c) = o; }
    LDS_WAIT(); asm volatile("" ::: "memory");
}

#ifndef PEER_FP6
#define PEER_FP6 1
#endif
#ifndef PEER_UP_FP4
#define PEER_UP_FP4 1
#endif
constexpr int ROWB = PEER_FP6 ? 3072 : 4096;
#ifndef PEER_DN_FP4
#define PEER_DN_FP4 1
#define PEER_DN_MFMA 1
#endif
constexpr int ROWB_DN = PEER_DN_FP4 ? 2048 : ROWB;
constexpr int ROWB_UP = PEER_UP_FP4 ? 2048 : ROWB;
typedef float f32x16v __attribute__((ext_vector_type(16)));
typedef float f32x32v __attribute__((ext_vector_type(32)));
typedef unsigned v6u __attribute__((ext_vector_type(6)));
__device__ __forceinline__ void quant_pack_store(const f32x4 (&v)[16], float am, unsigned char* dst, float* scp, int lane, bool fp4 = false) {
    if ((PEER_UP_FP4 || PEER_DN_FP4) && fp4) {
        const float s4 = am > 0.f ? 6.0f / am : 1.0f;
        if (lane == 0) *scp = am > 0.f ? am * (1.0f / 6.0f) : 1.0f;
        unsigned d4[8];
#pragma unroll
        for (int w = 0; w < 8; ++w) { unsigned p = 0u;
#define FP4_PK(b2) { const int t0 = 8 * w + 2 * (b2); p = (unsigned)__builtin_amdgcn_cvt_scalef32_pk_fp4_f32(p, v[t0 >> 2][t0 & 3] * s4, v[(t0 + 1) >> 2][(t0 + 1) & 3] * s4, 1.0f, b2); }
            FP4_PK(0) FP4_PK(1) FP4_PK(2) FP4_PK(3)
#undef FP4_PK
            d4[w] = p; }
        *(GAS v4u*)(dst + lane * 16) = (v4u){d4[0], d4[1], d4[2], d4[3]}; *(GAS v4u*)(dst + 1024 + lane * 16) = (v4u){d4[4], d4[5], d4[6], d4[7]};
        return;
    }
    constexpr float QMAX = PEER_FP6 ? 7.5f : 448.0f;
    const float s = am > 0.f ? QMAX / am : 1.0f;
    if (lane == 0) *scp = am > 0.f ? am * (1.0f / QMAX) : 1.0f;
#if PEER_FP6
    unsigned d[12];
#pragma unroll
    for (int g = 0; g < 2; ++g) { f32x16v x0, x1;
#pragma unroll
        for (int i = 0; i < 16; ++i) { const int t0 = 32 * g + 2 * i, t1 = t0 + 1;
            x0[i] = v[t0 >> 2][t0 & 3] * s; x1[i] = v[t1 >> 2][t1 & 3] * s; }
        const v6u pk = __builtin_amdgcn_cvt_scalef32_2xpk16_fp6_f32(x0, x1, 1.0f);
#pragma unroll
        for (int k = 0; k < 6; ++k) d[g * 6 + k] = pk[k]; }
#pragma unroll
    for (int c = 0; c < 3; ++c) *(GAS v4u*)(dst + c * 1024 + lane * 16) = (v4u){d[4 * c], d[4 * c + 1], d[4 * c + 2], d[4 * c + 3]};
#else
#pragma unroll
    for (int i = 0; i < 4; ++i) { v4u o;
#pragma unroll
        for (int j = 0; j < 4; ++j) { const f32x4 x = v[i * 4 + j] * s; int p = __builtin_amdgcn_cvt_pk_fp8_f32(x.x, x.y, 0, false); p = __builtin_amdgcn_cvt_pk_fp8_f32(x.z, x.w, p, true); o[j] = (unsigned)p; }
        *(GAS v4u*)(dst + i * 1024 + lane * 16) = o; }
#endif
}
__device__ __forceinline__ void load_qrow(const unsigned char* rp  , float (&e)[64]) {
#if PEER_FP6
    const v4u c0 = *(const GAS v4u*)(rp), c1 = *(const GAS v4u*)(rp + 1024), c2 = *(const GAS v4u*)(rp + 2048);
    const v6u pa = (v6u){c0.x, c0.y, c0.z, c0.w, c1.x, c1.y}, pb = (v6u){c1.z, c1.w, c2.x, c2.y, c2.z, c2.w};
    const f32x32v ra = __builtin_amdgcn_cvt_scalef32_pk32_f32_fp6(pa, 1.0f), rb = __builtin_amdgcn_cvt_scalef32_pk32_f32_fp6(pb, 1.0f);
#pragma unroll
    for (int k = 0; k < 32; ++k) { e[k] = ra[k]; e[32 + k] = rb[k]; }
#else
#pragma unroll
    for (int i = 0; i < 4; ++i) { const v4u w = *(const GAS v4u*)(rp + i * 1024);
#pragma unroll
        for (int j = 0; j < 4; ++j) { const f32x2 lo = __builtin_amdgcn_cvt_pk_f32_fp8(w[j], false), hi = __builtin_amdgcn_cvt_pk_f32_fp8(w[j], true);
            e[i * 16 + j * 4 + 0] = lo.x; e[i * 16 + j * 4 + 1] = lo.y; e[i * 16 + j * 4 + 2] = hi.x; e[i * 16 + j * 4 + 3] = hi.y; } }
#endif
}
__device__ __forceinline__ void p0_quant_row(const float* src, unsigned char* dst, float* sc, int lane, bool fp4 = false) {
    f32x4 v[16]; float am = 0.f;
#pragma unroll
    for (int i = 0; i < 4; ++i)
#pragma unroll
        for (int j = 0; j < 4; ++j) { v[i * 4 + j] = *(const GAS f32x4*)(src + (i * 4 + j) * 256 + lane * 4);
            am = fmaxf(am, fmaxf(fmaxf(fabsf(v[i * 4 + j].x), fabsf(v[i * 4 + j].y)), fmaxf(fabsf(v[i * 4 + j].z), fabsf(v[i * 4 + j].w)))); }
    am = wave_max(am);
    quant_pack_store(v, am, dst, sc, lane, fp4);
}

__device__ __forceinline__ void quant_rows(const Args& a, int first, int stride, int lane) {
    unsigned char* ws = a.ws;
    f32x4 cur[16], nxt[16];
    auto srcp = [&](int r) { return r < NEXP ? a.in[19] + (size_t)r * D : a.in[20] + (size_t)(r - NEXP) * D; };
    if (first < 2 * NEXP) { const float* p = srcp(first);
#pragma unroll
        for (int k = 0; k < 16; ++k) cur[k] = *(const GAS f32x4*)(p + k * 256 + lane * 4); }
    for (int r = first; r < 2 * NEXP; r += stride) {
        const int rn = r + stride;
        if (rn < 2 * NEXP) { const float* p = srcp(rn);
#pragma unroll
            for (int k = 0; k < 16; ++k) nxt[k] = *(const GAS f32x4*)(p + k * 256 + lane * 4); }
        float am = 0.f;
#pragma unroll
        for (int k = 0; k < 16; ++k) am = fmaxf(am, fmaxf(fmaxf(fabsf(cur[k].x), fabsf(cur[k].y)), fmaxf(fabsf(cur[k].z), fabsf(cur[k].w))));
        am = wave_max(am);
        if (r < NEXP) quant_pack_store(cur, am, ws + WS_DQ + (size_t)r * ROWB_DN, (float*)(ws + WS_DSCALE) + r, lane, PEER_DN_FP4 != 0);
        else quant_pack_store(cur, am, ws + WS_UQ + (size_t)(r - NEXP) * ROWB_UP, (float*)(ws + WS_USCALE) + (r - NEXP), lane, true);
#pragma unroll
        for (int k = 0; k < 16; ++k) cur[k] = nxt[k];
    }
}

#ifndef QUANT_IN_SCAN
#define QUANT_IN_SCAN 1
#endif
__device__ __forceinline__ void phase0(const Args& a, LAS unsigned char* lds, int gw, int NGW, int wave, int lane) {
    unsigned char* ws = a.ws;
    LAS float* scr = (LAS float*)(lds + RING_OFF + wave * 16384);
    constexpr int I_IN = (D / 64) * (IN_TOTAL / 32), I_OUT = (D / 64) * (D / 32), I_Q = (D / 64) * (2048 / 32);
    for (int it = gw; it < I_IN + I_OUT + I_Q; it += NGW) {
        int r = it;
        if (r < I_IN) { p0_transpose_item<true>(a.in[2], D, IN_TOTAL, (bf16*)(ws + WS_WINT), scr, r, lane); continue; } r -= I_IN;
        if (r < I_OUT) { p0_transpose_item<false>(a.in[15], D, D, (bf16*)(ws + WS_WOUTT), scr, r, lane); continue; } r -= I_OUT;
        p0_transpose_item<false>(a.in[17], D, 2048, (bf16*)(ws + WS_WQT), scr, r, lane);
    }
    const int gt = gw * 64 + lane, NGT = NGW * 64;
    { GAS v4u* p = (GAS v4u*)(ws + WS_WINT + (size_t)IN_TOTAL * D * 2);
      for (int i = gt; i < (NWIN - IN_TOTAL) * D * 2 / 16; i += NGT) p[i] = (v4u){0u, 0u, 0u, 0u}; }
    { const float* sk = a.in[18]; bf16* SKB = (bf16*)(ws + WS_SKB);
      for (int i = gt; i < PH * 2 * NKEYS * 128 / 8; i += NGT) { const f32x4 v0 = *(const GAS f32x4*)(sk + (size_t)i * 8), v1 = *(const GAS f32x4*)(sk + (size_t)i * 8 + 4);
          v4u o; o.x = pk2(v0.x, v0.y); o.y = pk2(v0.z, v0.w); o.z = pk2(v1.x, v1.y); o.w = pk2(v1.z, v1.w); *(GAS v4u*)(SKB + (size_t)i * 8) = o; } }
    { float* p = (float*)(ws + WS_SSQ); for (int i = gt; i < M; i += NGT) p[i] = 0.f; }
    { bf16* WL = (bf16*)(ws + WS_WLORA); const float* w2 = a.in[5]; const float* a2 = a.in[7]; const float* g2 = a.in[8];
      for (int it = gw; it < (KLORA / 64) * (NLORA / 32); it += NGW) {
          const int kb = it / (NLORA / 32), nb = it % (NLORA / 32), k0 = 64 * kb, n0 = 32 * nb, kind = n0 >> 11, cb = (n0 & 2047) + (lane & 31);
          const float* srcw = kind == 0 ? w2 : (kind == 1 ? a2 : g2); const int klo = kind == 0 ? 0 : (kind == 1 ? 96 : 192), khi = kind == 0 ? 96 : (kind == 1 ? 192 : 448);
#pragma unroll 8
          for (int i = 0; i < 32; ++i) { const int kk = 2 * i + (lane >> 5), k = k0 + kk; scr[kk * 33 + (lane & 31)] = (k >= klo && k < khi) ? srcw[(size_t)(k - klo) * 2048 + cb] : 0.f; }
          LDS_WAIT(); asm volatile("" ::: "memory");
          const int c = lane & 7;
#pragma unroll
          for (int j = 0; j < 4; ++j) { const int n = (lane >> 3) + 8 * j; const LAS float* s = scr + (8 * c) * 33 + n;
              v4u o; o.x = pk2(s[0 * 33], s[1 * 33]); o.y = pk2(s[2 * 33], s[3 * 33]); o.z = pk2(s[4 * 33], s[5 * 33]); o.w = pk2(s[6 * 33], s[7 * 33]);
              *(GAS v4u*)(WL + (size_t)(n0 + n) * KLORA + k0 + 8 * c) = o; }
          LDS_WAIT(); asm volatile("" ::: "memory");
      } }
    { const float* x = a.in[0]; const float* nw = a.in[1]; bf16* XN = (bf16*)(ws + WS_XN);
      for (int m = gw; m < M; m += NGW) {
          f32x4 v[16]; float s = 0.f;
#pragma unroll
          for (int c = 0; c < 8; ++c)
#pragma unroll
              for (int j = 0; j < 2; ++j) { const f32x4 t = *(const GAS f32x4*)(x + (size_t)m * D + c * 512 + lane * 8 + j * 4); v[c * 2 + j] = t; s += (t.x * t.x + t.y * t.y) + (t.z * t.z + t.w * t.w); }
          const float rs = 1.0f / sqrtf(wave_sum(s) * (1.0f / D) + 1e-6f);
#pragma unroll
          for (int c = 0; c < 8; ++c) { const f32x4 w0 = *(const GAS f32x4*)(nw + c * 512 + lane * 8), w1 = *(const GAS f32x4*)(nw + c * 512 + lane * 8 + 4);
              const f32x4 p = v[c * 2] * rs * w0, q = v[c * 2 + 1] * rs * w1;
              v4u o; o.x = pk2(p.x, p.y); o.y = pk2(p.z, p.w); o.z = pk2(q.x, q.y); o.w = pk2(q.z, q.w);
              *(GAS v4u*)(XN + (size_t)m * D + c * 512 + lane * 8) = o; }
      } }
    if (!QUANT_IN_SCAN) { const float* ed = a.in[19]; const float* eu = a.in[20];
      for (int r = gw; r < 2 * NEXP; r += NGW) {
          if (r < NEXP) p0_quant_row(ed + (size_t)r * D, ws + WS_DQ + (size_t)r * ROWB_DN, (float*)(ws + WS_DSCALE) + r, lane, PEER_DN_FP4 != 0);
          else { const int e = r - NEXP; p0_quant_row(eu + (size_t)e * D, ws + WS_UQ + (size_t)e * ROWB_UP, (float*)(ws + WS_USCALE) + e, lane, true); } } }
}

__device__ __forceinline__ void unpack8(const v4u w, float (&f)[8]) {
    f[0] = bflo(w.x); f[1] = bfhi(w.x); f[2] = bflo(w.y); f[3] = bfhi(w.y); f[4] = bflo(w.z); f[5] = bfhi(w.z); f[6] = bflo(w.w); f[7] = bfhi(w.w);
}
__device__ __forceinline__ v4u pack8(const float (&f)[8]) { v4u o; o.x = pk2(f[0], f[1]); o.y = pk2(f[2], f[3]); o.z = pk2(f[4], f[5]); o.w = pk2(f[6], f[7]); return o; }

__device__ __forceinline__ void phase2(const Args& a, int gt, int NGT) {
    unsigned char* ws = a.ws;
    const bf16* P = (const bf16*)(ws + WS_PROJ); const float* mu = a.in[3]; const float* cw = a.in[14];
    bf16* LIN = (bf16*)(ws + WS_LIN); bf16* MIX = (bf16*)(ws + WS_MIXED);
    const v4u z4 = (v4u){0u, 0u, 0u, 0u};
    const float* SL = (const float*)(ws + WS_SLAB);
    for (int it = gt; it < M * 64; it += NGT) {
        const int m = it >> 6, j0 = (it & 63) * 8, t = m & (SEQ - 1);
        v4u o = z4;
        if (j0 < NLIN) {
            f32x4 p0 = (f32x4){0.f, 0.f, 0.f, 0.f}, p1 = p0, q0 = p0, q1 = p0;
#pragma unroll
            for (int ks = 0; ks < KSPLIT; ++ks) { const float* sp = SL + ((size_t)ks * M + m) * SLABW + j0;
                p0 += *(const GAS f32x4*)(sp); p1 += *(const GAS f32x4*)(sp + 4);
                if (t > 0) { q0 += *(const GAS f32x4*)(sp - SLABW); q1 += *(const GAS f32x4*)(sp - SLABW + 4); } }
            const f32x4 m0 = *(const GAS f32x4*)(mu + SRC_WL + j0), m1 = *(const GAS f32x4*)(mu + SRC_WL + j0 + 4);
            float r[8];
#pragma unroll
            for (int j = 0; j < 8; ++j) { const float p = j < 4 ? p0[j] : p1[j - 4], q = j < 4 ? q0[j] : q1[j - 4], mm = j < 4 ? m0[j] : m1[j - 4]; const float ps = p + (q - p) * mm;
                r[j] = j0 < 96 ? tanhf(ps) : (j0 < 192 ? ps : sigmoidf_(ps)); }
            o = pack8(r);
        }
        *(GAS v4u*)(LIN + (size_t)m * KLORA + j0) = o;
    }
    for (int it = gt; it < M * 256; it += NGT) {
        const int m = it >> 8, c0 = (it & 255) * 8, t = m & (SEQ - 1);
        const bf16* row = P + (size_t)m * NPROJ;
        float bg[8], c_[8], h_[8], z0[8], z1[8], z2[8], y[8];
        unpack8(*(const GAS v4u*)(row + COL_CB + c0), bg); unpack8(*(const GAS v4u*)(row + COL_CC + c0), c_); unpack8(*(const GAS v4u*)(row + COL_CH + c0), h_);
#pragma unroll
        for (int j = 0; j < 8; ++j) z0[j] = c_[j] * h_[j];
        if (t >= 1) { unpack8(*(const GAS v4u*)(row - NPROJ + COL_CC + c0), c_); unpack8(*(const GAS v4u*)(row - NPROJ + COL_CH + c0), h_);
#pragma unroll
            for (int j = 0; j < 8; ++j) z1[j] = c_[j] * h_[j]; }
        else {
#pragma unroll
            for (int j = 0; j < 8; ++j) z1[j] = 0.f; }
        if (t >= 2) { unpack8(*(const GAS v4u*)(row - 2 * NPROJ + COL_CC + c0), c_); unpack8(*(const GAS v4u*)(row - 2 * NPROJ + COL_CH + c0), h_);
#pragma unroll
            for (int j = 0; j < 8; ++j) z2[j] = c_[j] * h_[j]; }
        else {
#pragma unroll
            for (int j = 0; j < 8; ++j) z2[j] = 0.f; }
        const float* cwp = cw + c0 * 3;
#pragma unroll
        for (int j = 0; j < 8; ++j) y[j] = bg[j] * (cwp[j * 3 + 0] * z2[j] + cwp[j * 3 + 1] * z1[j] + cwp[j * 3 + 2] * z0[j]);
        *(GAS v4u*)(MIX + (size_t)m * D + RW + c0) = pack8(y);
    }
}

__device__ __forceinline__ void phase4(const Args& a, int gw, int NGW, int lane) {
    unsigned char* ws = a.ws;
    const bf16* P = (const bf16*)(ws + WS_PROJ); const float* mu = a.in[3]; const bf16* AA = (const bf16*)(ws + WS_AA);
    const float* k_k = a.in[9]; const float* k_a = a.in[10]; const float* r_k = a.in[11];
    bf16* R = (bf16*)(ws + WS_R); bf16* K = (bf16*)(ws + WS_K); bf16* KK = (bf16*)(ws + WS_KK); bf16* BB = (bf16*)(ws + WS_BB); bf16* V = (bf16*)(ws + WS_V);
    float* BON = (float*)(ws + WS_BONUS);
    const v4u z4 = (v4u){0u, 0u, 0u, 0u};
    for (int it = gw; it < M * 4; it += NGW) {
        const int m = it >> 2, ch = (it & 3) * 512 + lane * 8, t = m & (SEQ - 1);
        const bf16* row = P + (size_t)m * NPROJ;
        float r[8], k[8], v[8], q[8], av[8];
        auto lerp8 = [&](int col, float (&o)[8]) {
            unpack8(*(const GAS v4u*)(row + col + ch), o); unpack8(t > 0 ? *(const GAS v4u*)(row - NPROJ + col + ch) : z4, q);
            const f32x4 m0 = *(const GAS f32x4*)(mu + col + ch), m1 = *(const GAS f32x4*)(mu + col + ch + 4);
#pragma unroll
            for (int j = 0; j < 8; ++j) o[j] = o[j] + (q[j] - o[j]) * (j < 4 ? m0[j] : m1[j - 4]);
        };
        lerp8(COL_R, r); lerp8(COL_K, k); lerp8(COL_V, v);
        unpack8(*(const GAS v4u*)(AA + (size_t)m * RW + ch), av);
        float kk[8], kp[8], bb[8]; float ss = 0.f, bn = 0.f, kr = 0.f, brs = 0.f;
        const f32x4 kk0 = *(const GAS f32x4*)(k_k + ch), kk1 = *(const GAS f32x4*)(k_k + ch + 4), ka0 = *(const GAS f32x4*)(k_a + ch), ka1 = *(const GAS f32x4*)(k_a + ch + 4);
        const f32x4 rk0 = *(const GAS f32x4*)(r_k + ch), rk1 = *(const GAS f32x4*)(r_k + ch + 4);
#pragma unroll
        for (int j = 0; j < 8; ++j) { kk[j] = k[j] * (j < 4 ? kk0[j] : kk1[j - 4]); ss += kk[j] * kk[j];
            kp[j] = k[j] * (1.0f + (av[j] - 1.0f) * (j < 4 ? ka0[j] : ka1[j - 4])); bn += r[j] * kp[j] * (j < 4 ? rk0[j] : rk1[j - 4]); kr += r[j] * kp[j]; }
        ss += __shfl_xor(ss, 1); ss += __shfl_xor(ss, 2); ss += __shfl_xor(ss, 4);
        bn += __shfl_xor(bn, 1); bn += __shfl_xor(bn, 2); bn += __shfl_xor(bn, 4);
        const float inv = 1.0f / sqrtf(fmaxf(ss, 1e-24f));
#pragma unroll
        for (int j = 0; j < 8; ++j) { kk[j] *= inv; bb[j] = kk[j] * av[j]; brs += bb[j] * r[j]; }
        brs += __shfl_xor(brs, 1); brs += __shfl_xor(brs, 2); brs += __shfl_xor(brs, 4);
        kr += __shfl_xor(kr, 1); kr += __shfl_xor(kr, 2); kr += __shfl_xor(kr, 4);
        const size_t o = (size_t)m * RW + ch;
        *(GAS v4u*)(R + o) = pack8(r); *(GAS v4u*)(K + o) = pack8(kp); *(GAS v4u*)(KK + o) = pack8(kk); *(GAS v4u*)(BB + o) = pack8(bb); *(GAS v4u*)(V + o) = pack8(v);
        if ((lane & 7) == 0) { BON[(size_t)m * NH + (ch >> 6)] = bn; ((float*)(ws + WS_BR))[(size_t)m * NH + (ch >> 6)] = brs; ((float*)(ws + WS_KR))[(size_t)m * NH + (ch >> 6)] = kr; }
    }
}

constexpr int TC = 32;
constexpr int SC_A = 0, SC_WR = TC * 256, SC_W = 2 * TC * 256, SC_B = 3 * TC * 256, SC_K = 4 * TC * 256, SC_V = 5 * TC * 256, SC_S = SC_V + TC * 64, SC_BYTES = SC_S + TC * 8;
__device__ __forceinline__ float dpp_f(float v, const int ctrl_sel) {
    const int x = __builtin_bit_cast(int, v); int r;
    if (ctrl_sel == 0) r = __builtin_amdgcn_update_dpp(0, x, 0xB1, 0xF, 0xF, true);
    else if (ctrl_sel == 1) r = __builtin_amdgcn_update_dpp(0, x, 0x4E, 0xF, 0xF, true);
    else if (ctrl_sel == 2) r = __builtin_amdgcn_update_dpp(0, x, 0x141, 0xF, 0xF, true);
    else r = __builtin_amdgcn_update_dpp(0, x, 0x140, 0xF, 0xF, true);
    return __builtin_bit_cast(float, r);
}
__device__ __forceinline__ void phase5(const Args& a, LAS unsigned char* lds, int tid) {
    unsigned char* ws = a.ws;
    const float* WD = (const float*)(ws + WS_WD);
    const bf16* R = (const bf16*)(ws + WS_R); const bf16* K = (const bf16*)(ws + WS_K); const bf16* KK = (const bf16*)(ws + WS_KK); const bf16* BB = (const bf16*)(ws + WS_BB); const bf16* V = (const bf16*)(ws + WS_V);
    const float* BRs = (const float*)(ws + WS_BR); const float* KRs = (const float*)(ws + WS_KR);
    float* Y = (float*)(ws + WS_Y);
    constexpr int NCH = SEQ / TC;
    const int qlane = tid & 63, NLW = gridDim.x * 4; int qnext = blockIdx.x * 4 + ((tid >> 6) & 3), qrow = 2 * NEXP;
    for (int item = blockIdx.x; item < 256; item += gridDim.x) {
        const int bh = item >> 2, rg = item & 3, b = bh >> 5, h = bh & 31;
        const size_t base = (size_t)b * SEQ * RW + h * 64;
        __syncthreads();
        if (tid >= 256) {
            const int lt = tid - 256, st = lt >> 3, c8 = (lt & 7) * 8;
            f32x4 w0, w1; v4u xkk, xbb, xk, xr; unsigned xv; float sbr = 0.f, skr = 0.f;
            auto gload = [&](int c) {
                const size_t o = base + (size_t)(c * TC + st) * RW + c8;
                w0 = *(const GAS f32x4*)(WD + o); w1 = *(const GAS f32x4*)(WD + o + 4);
                xkk = *(const GAS v4u*)(KK + o); xbb = *(const GAS v4u*)(BB + o); xk = *(const GAS v4u*)(K + o); xr = *(const GAS v4u*)(R + o);
                xv = *(const GAS unsigned*)(V + base + (size_t)(c * TC + st) * RW + rg * 16 + (lt & 7) * 2);
                if (lt < TC) { const size_t mm = (size_t)b * SEQ + c * TC + lt; sbr = BRs[mm * NH + h]; skr = KRs[mm * NH + h]; }
            };
            f32x4 qv[16];
            auto quant_load = [&](int r) {
                const float* srcp = (r < NEXP ? a.in[19] + (size_t)r * D : a.in[20] + (size_t)(r - NEXP) * D);
#pragma unroll
                for (int i2 = 0; i2 < 4; ++i2)
#pragma unroll
                    for (int j = 0; j < 4; ++j) qv[i2 * 4 + j] = *(const GAS f32x4*)(srcp + (i2 * 4 + j) * 256 + qlane * 4);
            };
            auto quant_finish = [&](int r) {
                float am = 0.f;
#pragma unroll
                for (int k = 0; k < 16; ++k) am = fmaxf(am, fmaxf(fmaxf(fabsf(qv[k].x), fabsf(qv[k].y)), fmaxf(fabsf(qv[k].z), fabsf(qv[k].w))));
                am = wave_max(am);
                unsigned char* dst = (r < NEXP ? ws + WS_DQ + (size_t)r * ROWB_DN : ws + WS_UQ + (size_t)(r - NEXP) * ROWB_UP);
                float* scp = (r < NEXP ? (float*)(ws + WS_DSCALE) + r : (float*)(ws + WS_USCALE) + (r - NEXP));
                quant_pack_store(qv, am, dst, scp, qlane, r >= NEXP || PEER_DN_FP4 != 0);
            };
            auto lstore = [&](int buf) {
                LAS unsigned char* L = lds + buf * SC_BYTES; const int o = st * 256 + c8 * 4;
                float fk[8], fb[8], fkk[8], fr[8]; unpack8(xkk, fkk); unpack8(xbb, fb); unpack8(xk, fk); unpack8(xr, fr);
                *(LAS f32x4*)(L + SC_A + o) = (f32x4){-fkk[0], -fkk[1], -fkk[2], -fkk[3]}; *(LAS f32x4*)(L + SC_A + o + 16) = (f32x4){-fkk[4], -fkk[5], -fkk[6], -fkk[7]};
                *(LAS f32x4*)(L + SC_WR + o) = (f32x4){w0.x * fr[0], w0.y * fr[1], w0.z * fr[2], w0.w * fr[3]}; *(LAS f32x4*)(L + SC_WR + o + 16) = (f32x4){w1.x * fr[4], w1.y * fr[5], w1.z * fr[6], w1.w * fr[7]};
                *(LAS f32x4*)(L + SC_W + o) = w0; *(LAS f32x4*)(L + SC_W + o + 16) = w1;
                *(LAS f32x4*)(L + SC_B + o) = (f32x4){fb[0], fb[1], fb[2], fb[3]}; *(LAS f32x4*)(L + SC_B + o + 16) = (f32x4){fb[4], fb[5], fb[6], fb[7]};
                *(LAS f32x4*)(L + SC_K + o) = (f32x4){fk[0], fk[1], fk[2], fk[3]}; *(LAS f32x4*)(L + SC_K + o + 16) = (f32x4){fk[4], fk[5], fk[6], fk[7]};
                *(LAS f32x2*)(L + SC_V + st * 64 + (lt & 7) * 8) = (f32x2){bflo(xv), bfhi(xv)};
                if (lt < TC) *(LAS f32x2*)(L + SC_S + lt * 8) = (f32x2){sbr, skr};
            };
            gload(0); lstore(0);
            gload(1);
            __syncthreads();
            for (int c = 0; c < NCH; ++c) {
                if (c + 1 < NCH) lstore((c + 1) & 1);
                if (c + 2 < NCH) gload(c + 2);
                if (QUANT_IN_SCAN) {
                    const int ph = c & 3;
                    if (ph == 0) { qrow = qnext; qnext += NLW; if (qrow < 2 * NEXP) quant_load(qrow); }
                    else if (ph == 2) { if (qrow < 2 * NEXP) quant_finish(qrow); }
                }
                __syncthreads();
            }
        } else {
            const int i = tid >> 4, q = tid & 15;
            f32x2 s01 = (f32x2){0.f, 0.f}, s23 = (f32x2){0.f, 0.f};
            float* yp = Y + base + rg * 16 + i;
            float ykeep = 0.f;
            __builtin_amdgcn_s_setprio(3);
            __syncthreads();
            for (int c = 0; c < NCH; ++c) {
                const LAS unsigned char* L = lds + (c & 1) * SC_BYTES;
                f32x4 a4 = *(const LAS f32x4*)(L + SC_A + q * 16), wr4 = *(const LAS f32x4*)(L + SC_WR + q * 16), w4 = *(const LAS f32x4*)(L + SC_W + q * 16), b4 = *(const LAS f32x4*)(L + SC_B + q * 16), k4 = *(const LAS f32x4*)(L + SC_K + q * 16);
                float vi = *(const LAS float*)(L + SC_V + i * 4); f32x2 sc = *(const LAS f32x2*)(L + SC_S);
#pragma unroll
                for (int tt = 0; tt < TC; ++tt) {
                    const f32x4 ca = a4, cwr = wr4, cw = w4, cb = b4, ck = k4; const float cvi = vi; const f32x2 csc = sc;
                    if (tt + 1 < TC) {
                        a4 = *(const LAS f32x4*)(L + SC_A + (tt + 1) * 256 + q * 16); wr4 = *(const LAS f32x4*)(L + SC_WR + (tt + 1) * 256 + q * 16); w4 = *(const LAS f32x4*)(L + SC_W + (tt + 1) * 256 + q * 16);
                        b4 = *(const LAS f32x4*)(L + SC_B + (tt + 1) * 256 + q * 16); k4 = *(const LAS f32x4*)(L + SC_K + (tt + 1) * 256 + q * 16);
                        vi = *(const LAS float*)(L + SC_V + (tt + 1) * 64 + i * 4); sc = *(const LAS f32x2*)(L + SC_S + (tt + 1) * 8);
                    }
                    f32x2 da = s01 * (f32x2){ca.x, ca.y}; da = s23 * (f32x2){ca.z, ca.w} + da;
                    f32x2 dr = s01 * (f32x2){cwr.x, cwr.y}; dr = s23 * (f32x2){cwr.z, cwr.w} + dr;
                    float sa = da.x + da.y, yy = dr.x + dr.y;
                    const f32x2 vv = (f32x2){cvi, cvi};
                    const f32x2 t01 = s01 * (f32x2){cw.x, cw.y} + vv * (f32x2){ck.x, ck.y}, t23 = s23 * (f32x2){cw.z, cw.w} + vv * (f32x2){ck.z, ck.w};
                    sa += dpp_f(sa, 0); yy += dpp_f(yy, 0);
                    sa += dpp_f(sa, 1); yy += dpp_f(yy, 1);
                    sa += dpp_f(sa, 2); yy += dpp_f(yy, 2);
                    sa += dpp_f(sa, 3); yy += dpp_f(yy, 3);
                    const f32x2 ss = (f32x2){sa, sa};
                    s01 = ss * (f32x2){cb.x, cb.y} + t01; s23 = ss * (f32x2){cb.z, cb.w} + t23;
                    yy += sa * csc.x + cvi * csc.y;
                    ykeep = ((tt & 15) == q) ? yy : ykeep;
                    if ((tt & 15) == 15) yp[(size_t)(c * TC + (tt & 16) + q) * RW] = ykeep;
                }
                __syncthreads();
            }
            __builtin_amdgcn_s_setprio(0);
        }
    }
    if (QUANT_IN_SCAN && tid >= 256) {
        for (; qnext < 2 * NEXP; qnext += NLW) {
            const int r = qnext;
            if (r < NEXP) p0_quant_row(a.in[19] + (size_t)r * D, ws + WS_DQ + (size_t)r * ROWB_DN, (float*)(ws + WS_DSCALE) + r, qlane, PEER_DN_FP4 != 0);
            else p0_quant_row(a.in[20] + (size_t)(r - NEXP) * D, ws + WS_UQ + (size_t)(r - NEXP) * ROWB_UP, (float*)(ws + WS_USCALE) + (r - NEXP), qlane, true);
        }
    }
}

constexpr int CH = 32, NCHK = SEQ / CH;
constexpr int SUM_GT = 0, SUM_QT = 8192, SUM_HT = 12288, SUM_YL = 20480, SUM_BYTES = 24576;
constexpr int CW_BYTES = 18432;
constexpr int CA_OFF = 0, CB_OFF = 8704, CC_OFF = 13312;
constexpr int TMS = 144, CMS = 80;
typedef float f32x16c __attribute__((ext_vector_type(16)));
typedef short bf16x8c __attribute__((ext_vector_type(8)));
__device__ __forceinline__ bf16x8c cvt8(const f32x16c& x, const int base) {
    v4u w; w.x = pk2(x[base + 0], x[base + 1]); w.y = pk2(x[base + 2], x[base + 3]); w.z = pk2(x[base + 4], x[base + 5]); w.w = pk2(x[base + 6], x[base + 7]);
    return __builtin_bit_cast(bf16x8c, w);
}
__device__ __forceinline__ bf16x8c lds_nat(const LAS unsigned char* img, int row, int pitch, int ks, int hf) {
    return __builtin_bit_cast(bf16x8c, *(const LAS v4u*)(img + row * pitch + (16 * ks + 8 * hf) * 2));
}
__device__ __forceinline__ bf16x8c lds_sig(const LAS unsigned char* img, int row, int pitch, int ks, int hf) {
    const v2u lo = *(const LAS v2u*)(img + row * pitch + (16 * ks + 4 * hf) * 2), hi = *(const LAS v2u*)(img + row * pitch + (16 * ks + 8 + 4 * hf) * 2);
    return __builtin_bit_cast(bf16x8c, (v4u){lo.x, lo.y, hi.x, hi.y});
}
#define MFMA32(a, b, c) __builtin_amdgcn_mfma_f32_32x32x16_bf16((a), (b), (c), 0, 0, 0)

__device__ __forceinline__ void diag_add(f32x16c& x, int tl, int hf, float v) {
#pragma unroll
    for (int i = 0; i < 16; ++i) { const int r = (i & 3) + 8 * (i >> 2) + 4 * hf; x[i] += (r == tl) ? v : 0.f; }
}
__device__ __forceinline__ f32x16c xty(const f32x16c& X, const f32x16c& Y, f32x16c c) { c = MFMA32(cvt8(X, 0), cvt8(Y, 0), c); c = MFMA32(cvt8(X, 8), cvt8(Y, 8), c); return c; }
__device__ __forceinline__ void phase5a(const Args& a, LAS unsigned char* lds, int gw, int NGW, int wave, int lane_in) {
    unsigned char* ws = a.ws;
    const float* LWG = (const float*)(ws + WS_WD);
    const bf16* PRJ = (const bf16*)(ws + WS_PROJ); const bf16* AAg = (const bf16*)(ws + WS_AA); bf16* Vw = (bf16*)(ws + WS_V); float* BONw = (float*)(ws + WS_BONUS);
    const float* mu = a.in[3]; const float* k_k = a.in[9]; const float* k_a = a.in[10]; const float* r_k = a.in[11];
    LAS unsigned char* LA = lds + wave * CW_BYTES + CA_OFF; LAS unsigned char* LB = lds + wave * CW_BYTES + CB_OFF; LAS unsigned char* LC = lds + wave * CW_BYTES + CC_OFF;
    f32x16c zero16;
#pragma unroll
    for (int i = 0; i < 16; ++i) zero16[i] = 0.f;
    for (int item = gw; item < 64 * NCHK; item += NGW) {
        int lane_l = lane_in; asm volatile("" : "+v"(lane_l));
        const int lane = lane_l, tl = lane & 31, hf = lane >> 5;
        const int bh = item / NCHK, c = item % NCHK, b = bh >> 5, h = bh & 31;
        const float* lwu = LWG + ((size_t)b * SEQ + c * CH) * RW + h * 64;
        const int tpos = c * CH + tl;
        const bf16* pu = PRJ + ((size_t)b * SEQ + c * CH) * NPROJ + h * 64;
        const int lo_p = tl * NPROJ + 32 * hf, lo_q = (tpos > 0) ? lo_p - NPROJ : lo_p;
        const float pmask = (tpos > 0) ? 1.0f : 0.0f;
        const int lo_c = tl * RW + 32 * hf;
        const size_t ub = ((size_t)b * SEQ + c * CH) * RW + h * 64;
        const bf16* aau = AAg + ub; bf16* vwu = Vw + ub;
        const float* muu = mu + h * 64; const float* kku = k_k + h * 64; const float* kau = k_a + h * 64; const float* rku = r_k + h * 64; const int lo_h = 32 * hf;
        f32x4 lwr[8]; v4u rcw[4], rpw[4], vcw[4], vpw[4], kcw[4], kpw[4], aaw[4];
#pragma unroll
        for (int q = 0; q < 8; ++q) lwr[q] = *(const GAS f32x4*)(lwu + lo_c + 4 * q);
#pragma unroll
        for (int q = 0; q < 4; ++q) { rcw[q] = *(const GAS v4u*)(pu + COL_R + lo_p + 8 * q); rpw[q] = *(const GAS v4u*)(pu + COL_R + lo_q + 8 * q);
            vcw[q] = *(const GAS v4u*)(pu + COL_V + lo_p + 8 * q); vpw[q] = *(const GAS v4u*)(pu + COL_V + lo_q + 8 * q);
        }
        asm volatile("" ::: "memory");
        {
#pragma unroll
          for (int q = 0; q < 8; ++q) *(LAS f32x4*)(LA + (tl * 68 + 32 * hf + 4 * q) * 4) = lwr[q];
          LDS_WAIT();
          float accl = 0.f;
#pragma unroll
          for (int t = 0; t < CH; ++t) { accl += *(const LAS float*)(LA + (t * 68 + lane) * 4); *(LAS float*)(LA + (t * 68 + lane) * 4) = accl; }
          LDS_WAIT();
        }
#pragma unroll
        for (int q = 0; q < 4; ++q) { kcw[q] = *(const GAS v4u*)(pu + COL_K + lo_p + 8 * q); kpw[q] = *(const GAS v4u*)(pu + COL_K + lo_q + 8 * q); aaw[q] = *(const GAS v4u*)(aau + lo_c + 8 * q); }
        asm volatile("" ::: "memory");
        const float pc0 = __expf(*(const LAS float*)(LA + (31 * 68 + tl) * 4)), pc1 = __expf(*(const LAS float*)(LA + (31 * 68 + 32 + tl) * 4));
        v4u kh_[4], rt_[4], at_[4];
        bf16x8c fb[4], fk[4], fr[4], fa[4];
#define TM_WRITE(dst, src) do { _Pragma("unroll") for (int q = 0; q < 4; ++q) *(LAS v4u*)((dst) + tl * TMS + (32 * hf + 8 * q) * 2) = src[q]; LDS_WAIT(); } while (0)
#define TM_FRAGS(dst) do { _Pragma("unroll") for (int ks = 0; ks < 4; ++ks) dst[ks] = lds_nat(LB, tl, TMS, ks, hf); LDS_WAIT(); } while (0)
#define CM_WRITE(dst, src) do { _Pragma("unroll") for (int q = 0; q < 4; ++q) { const v4u _w = src[q]; _Pragma("unroll") for (int e = 0; e < 4; ++e) { \
            *(LAS unsigned short*)((dst) + (32 * hf + 8 * q + 2 * e) * CMS + tl * 2) = (unsigned short)(_w[e] & 0xffffu); *(LAS unsigned short*)((dst) + (32 * hf + 8 * q + 2 * e + 1) * CMS + tl * 2) = (unsigned short)(_w[e] >> 16); } } LDS_WAIT(); } while (0)
#define LROW(q) const f32x4 L0 = *(const LAS f32x4*)(LA + (tl * 68 + 32 * hf + 8 * (q)) * 4), L1 = *(const LAS f32x4*)(LA + (tl * 68 + 32 * hf + 8 * (q) + 4) * 4)
#define EROW(q) const f32x4 E0 = *(const LAS f32x4*)(LA + (31 * 68 + 32 * hf + 8 * (q)) * 4), E1 = *(const LAS f32x4*)(LA + (31 * 68 + 32 * hf + 8 * (q) + 4) * 4)
#define LERP8(cw, pw, col, q, out) do { float _c[8], _p[8]; unpack8(cw[q], _c); unpack8(pw[q], _p); \
            const f32x4 _m0 = *(const GAS f32x4*)(muu + (col) + lo_h + 8 * (q)), _m1 = *(const GAS f32x4*)(muu + (col) + lo_h + 8 * (q) + 4); \
            _Pragma("unroll") for (int j = 0; j < 8; ++j) out[j] = _c[j] + (_p[j] * pmask - _c[j]) * (j < 4 ? _m0[j] : _m1[j - 4]); } while (0)
        {
#pragma unroll
            for (int q = 0; q < 4; ++q) { LROW(q); float x8[8], u1[8]; LERP8(rcw, rpw, COL_R, q, x8);
#pragma unroll
                for (int j = 0; j < 8; ++j) { const float L = j < 4 ? L0[j] : L1[j - 4]; u1[j] = x8[j] * __expf(L); }
                rt_[q] = pack8(u1); }
        }
        {
#pragma unroll
            for (int q = 0; q < 4; ++q) { float x8[8]; LERP8(vcw, vpw, COL_V, q, x8); *(GAS v4u*)(vwu + lo_c + 8 * q) = pack8(x8); }
        }
        float inv_kk; v4u ks_[4];
        {
            float ss = 0.f;
#pragma unroll
            for (int q = 0; q < 4; ++q) { float x8[8]; LERP8(kcw, kpw, COL_K, q, x8); ks_[q] = pack8(x8);
                const f32x4 k0 = *(const GAS f32x4*)(kku + lo_h + 8 * q), k1 = *(const GAS f32x4*)(kku + lo_h + 8 * q + 4);
#pragma unroll
                for (int j = 0; j < 8; ++j) { const float t2 = x8[j] * (j < 4 ? k0[j] : k1[j - 4]); ss += t2 * t2; } }
            ss += __shfl_xor(ss, 32);
            inv_kk = 1.0f / sqrtf(fmaxf(ss, 1e-24f));
        }
        {
            v4u kt_[4]; float bon = 0.f;
#pragma unroll
            for (int q = 0; q < 4; ++q) { LROW(q); EROW(q); float x8[8], av[8], rt8[8]; unpack8(ks_[q], x8); unpack8(aaw[q], av); unpack8(rt_[q], rt8);
                const f32x4 a0v = *(const GAS f32x4*)(kau + lo_h + 8 * q), a1v = *(const GAS f32x4*)(kau + lo_h + 8 * q + 4), q0 = *(const GAS f32x4*)(rku + lo_h + 8 * q), q1 = *(const GAS f32x4*)(rku + lo_h + 8 * q + 4);
                float o_kt[8], o_kh[8];
#pragma unroll
                for (int j = 0; j < 8; ++j) { const float L = j < 4 ? L0[j] : L1[j - 4], Le = j < 4 ? E0[j] : E1[j - 4];
                    const float kp = x8[j] * (1.0f + (av[j] - 1.0f) * (j < 4 ? a0v[j] : a1v[j - 4])), enL = __expf(-L);
                    bon += rt8[j] * enL * (j < 4 ? q0[j] : q1[j - 4]) * kp;
                    o_kt[j] = kp * enL; o_kh[j] = kp * __expf(Le - L); }
                kt_[q] = pack8(o_kt); kh_[q] = pack8(o_kh); if (q == 1) asm volatile("" ::: "memory"); }
            bon += __shfl_xor(bon, 32);
            if (hf == 0) (BONw + ((size_t)b * SEQ + c * CH) * NH + h)[tl * NH] = bon;
            TM_WRITE(LB, kt_); TM_FRAGS(fk);
        }
        asm volatile("" ::: "memory");
        {
            v4u bt_[4], bh_[4];
#pragma unroll
            for (int q = 0; q < 4; ++q) { LROW(q); EROW(q); float x8[8], av[8]; unpack8(ks_[q], x8); unpack8(aaw[q], av);
                const f32x4 k0 = *(const GAS f32x4*)(kku + lo_h + 8 * q), k1 = *(const GAS f32x4*)(kku + lo_h + 8 * q + 4);
                const int rwp = tl > 0 ? tl - 1 : 0; const float pm2 = tl > 0 ? 1.0f : 0.0f;
                const f32x4 W0 = *(const LAS f32x4*)(LA + (rwp * 68 + 32 * hf + 8 * q) * 4) * pm2, W1 = *(const LAS f32x4*)(LA + (rwp * 68 + 32 * hf + 8 * q + 4) * 4) * pm2;
                float o_at[8], o_bt[8], o_bh[8];
#pragma unroll
                for (int j = 0; j < 8; ++j) { const float L = j < 4 ? L0[j] : L1[j - 4], Le = j < 4 ? E0[j] : E1[j - 4], lw1 = j < 4 ? W0[j] : W1[j - 4];
                    const float kk = x8[j] * (j < 4 ? k0[j] : k1[j - 4]) * inv_kk, bb = kk * av[j];
                    o_at[j] = -kk * __expf(lw1); o_bt[j] = bb * __expf(-L); o_bh[j] = bb * __expf(Le - L); }
                at_[q] = pack8(o_at); bt_[q] = pack8(o_bt); bh_[q] = pack8(o_bh); if (q == 1) asm volatile("" ::: "memory"); }
            TM_WRITE(LB, bt_); TM_FRAGS(fb); CM_WRITE(LC, bh_);
        }
        asm volatile("" ::: "memory");
        TM_WRITE(LB, rt_); TM_FRAGS(fr);
        TM_WRITE(LB, at_); TM_FRAGS(fa);
        asm volatile("" ::: "memory");
#undef LERP8
        CM_WRITE(LA, at_);
        TM_WRITE(LB, rt_);
        f32x16c P = zero16, R = zero16, KT = zero16, Mkr = zero16, Mbr = zero16;
#pragma unroll
        for (int ks = 0; ks < 4; ++ks) { P = MFMA32(fb[ks], fa[ks], P); R = MFMA32(fa[ks], fb[ks], R); KT = MFMA32(fa[ks], fk[ks], KT); Mkr = MFMA32(fk[ks], fr[ks], Mkr); Mbr = MFMA32(fb[ks], fr[ks], Mbr); }
#pragma unroll
        for (int i = 0; i < 16; ++i) { const int r = (i & 3) + 8 * (i >> 2) + 4 * hf;
            P[i] = (r < tl) ? P[i] : 0.f; Mkr[i] = (r <= tl) ? Mkr[i] : 0.f; Mbr[i] = (r <= tl) ? Mbr[i] : 0.f;
            R[i] = (tl < r) ? R[i] : 0.f; KT[i] = (tl < r) ? KT[i] : 0.f; }
        f32x16c T = P; diag_add(T, tl, hf, 1.0f);
#pragma unroll
        for (int lev = 0; lev < 4; ++lev) {
            const f32x16c Pn = (lev < 3) ? xty(R, P, zero16) : zero16;
            const f32x16c Rn = xty(P, R, zero16);
            P = Pn; R = Rn;
            f32x16c IR = R; diag_add(IR, tl, hf, 1.0f);
            T = xty(IR, T, zero16);
        }
        f32x16c Xa[2], Wt;
        { const bf16x8c t0 = cvt8(T, 0), t1 = cvt8(T, 8);
#pragma unroll
          for (int jt = 0; jt < 2; ++jt) { Xa[jt] = MFMA32(t0, lds_sig(LA, 32 * jt + tl, CMS, 0, hf), zero16); Xa[jt] = MFMA32(t1, lds_sig(LA, 32 * jt + tl, CMS, 1, hf), Xa[jt]); }
          Wt = MFMA32(t0, cvt8(KT, 0), zero16); Wt = MFMA32(t1, cvt8(KT, 8), Wt); }
        bf16x8c bs[2][2];
#pragma unroll
        for (int rt2 = 0; rt2 < 2; ++rt2)
#pragma unroll
            for (int ks = 0; ks < 2; ++ks) bs[rt2][ks] = lds_sig(LC, 32 * rt2 + tl, CMS, ks, hf);
        LDS_WAIT();
        { v4u vr[4];
#pragma unroll
          for (int q = 0; q < 4; ++q) vr[q] = *(const GAS v4u*)(vwu + lo_c + 8 * q);
          TM_WRITE(LA, kh_);
          CM_WRITE(LC, vr); }
        unsigned char* rec = ws + WS_REC + (size_t)item * SUM_BYTES;
#pragma unroll
        for (int bt2 = 0; bt2 < 2; ++bt2) { const bf16x8c x0 = cvt8(Xa[bt2], 0), x1 = cvt8(Xa[bt2], 8);
#pragma unroll
            for (int at2 = 0; at2 < 2; ++at2) { f32x16c g = MFMA32(x0, bs[at2][0], zero16); g = MFMA32(x1, bs[at2][1], g);
                if (at2 == bt2) diag_add(g, tl, hf, at2 == 0 ? pc0 : pc1);
#pragma unroll
                for (int k2 = 0; k2 < 2; ++k2) *(GAS bf16x8c*)(rec + SUM_GT + (32 * at2 + tl) * 128 + (2 * bt2 + k2) * 32 + hf * 16) = cvt8(g, 8 * k2);
            } }
        { const bf16x8c mb0 = cvt8(Mbr, 0), mb1 = cvt8(Mbr, 8);
#pragma unroll
          for (int jt = 0; jt < 2; ++jt) { f32x16c qv_;
#pragma unroll
              for (int i = 0; i < 16; ++i) { const int j = 32 * jt + (i & 3) + 8 * (i >> 2) + 4 * hf; qv_[i] = __builtin_bit_cast(float, (unsigned)(*(const LAS unsigned short*)(LB + tl * TMS + j * 2)) << 16); }
              qv_ = MFMA32(cvt8(Xa[jt], 0), mb0, qv_); qv_ = MFMA32(cvt8(Xa[jt], 8), mb1, qv_);
#pragma unroll
              for (int k2 = 0; k2 < 2; ++k2) *(GAS bf16x8c*)(rec + SUM_QT + tl * 128 + (2 * jt + k2) * 32 + hf * 16) = cvt8(qv_, 8 * k2);
          } }
        LDS_WAIT();
        bf16x8c vp[2][2];
#pragma unroll
        for (int it = 0; it < 2; ++it)
#pragma unroll
            for (int ks = 0; ks < 2; ++ks) vp[it][ks] = lds_sig(LC, 32 * it + tl, CMS, ks, hf);
        const bf16x8c w0 = cvt8(Wt, 0), w1 = cvt8(Wt, 8);
#pragma unroll
        for (int jt = 0; jt < 2; ++jt) { f32x16c zk;
#pragma unroll
            for (int i = 0; i < 16; ++i) { const int s = (i & 3) + 8 * (i >> 2) + 4 * hf; zk[i] = __builtin_bit_cast(float, (unsigned)(*(const LAS unsigned short*)(LA + s * TMS + (32 * jt + tl) * 2)) << 16); }
            zk = MFMA32(w0, bs[jt][0], zk); zk = MFMA32(w1, bs[jt][1], zk);
            const bf16x8c z0 = cvt8(zk, 0), z1 = cvt8(zk, 8);
#pragma unroll
            for (int it = 0; it < 2; ++it) { f32x16c hv = MFMA32(z0, vp[it][0], zero16); hv = MFMA32(z1, vp[it][1], hv);
                unsigned char* dst = rec + SUM_HT + ((size_t)(it * 64 + lane) * 2 + jt) * 32;
                *(GAS bf16x8c*)(dst) = cvt8(hv, 0); *(GAS bf16x8c*)(dst + 16) = cvt8(hv, 8);
            } }
        { f32x16c zy = MFMA32(w0, cvt8(Mbr, 0), Mkr); zy = MFMA32(w1, cvt8(Mbr, 8), zy);
          const bf16x8c y0 = cvt8(zy, 0), y1 = cvt8(zy, 8);
#pragma unroll
          for (int it = 0; it < 2; ++it) { f32x16c yv = MFMA32(y0, vp[it][0], zero16); yv = MFMA32(y1, vp[it][1], yv);
              unsigned char* dst = rec + SUM_YL + (size_t)(it * 64 + lane) * 32;
              *(GAS bf16x8c*)(dst) = cvt8(yv, 0); *(GAS bf16x8c*)(dst + 16) = cvt8(yv, 8);
          } }
        LDS_WAIT();
#undef TM_WRITE
#undef TM_FRAGS
#undef CM_WRITE
#undef LROW
#undef EROW
    }
}

constexpr int RING_SLOTS = 5, NLOADW = 5, RING_FLAGS = RING_SLOTS * SUM_BYTES;
__device__ __forceinline__ int ring_swz(int o) {
    return (o < SUM_HT) ? ((o & ~127) | ((((o >> 4) ^ (o >> 7)) & 7) << 4)) : o;
}
__device__ __forceinline__ void spin_until(volatile LAS unsigned* p, unsigned want) {
    unsigned sp = 0u;
    while (*p < want) { __builtin_amdgcn_s_sleep(1); if (++sp > (1u << 24)) break; }
}
__device__ __forceinline__ void phase5b(const Args& a, LAS unsigned char* lds, int bx, int G, int tid, int wave, int lane) {
    unsigned char* ws = a.ws;
    const int tl = lane & 31, hf = lane >> 5;
    volatile LAS unsigned* full = (volatile LAS unsigned*)(lds + RING_FLAGS); volatile LAS unsigned* freef = (volatile LAS unsigned*)(lds + RING_FLAGS + 32);
    if (tid < 64) ((LAS unsigned*)(lds + RING_FLAGS))[tid] = 0u;
    __syncthreads();
    const bool chain_block = (G >= 128) && (bx < 128);
    const int bh = bx >> 1, it = bx & 1, b = bh >> 5, h = bh & 31;
    const unsigned char* rec0 = ws + WS_REC + (size_t)bh * NCHK * SUM_BYTES;
    volatile LAS unsigned* freeB = (volatile LAS unsigned*)(lds + RING_FLAGS + 64); volatile LAS unsigned* sfull = (volatile LAS unsigned*)(lds + RING_FLAGS + 96); volatile LAS unsigned* sfree = (volatile LAS unsigned*)(lds + RING_FLAGS + 112);
    LAS unsigned char* sring = lds + RING_FLAGS + 256;
    constexpr int SSLOTS = 2;
    auto unp16 = [&](const bf16x8c lo, const bf16x8c hi2) { f32x16c r; const v4u l4 = __builtin_bit_cast(v4u, lo), h4 = __builtin_bit_cast(v4u, hi2);
#pragma unroll
        for (int e2 = 0; e2 < 4; ++e2) { r[2 * e2] = bflo(l4[e2]); r[2 * e2 + 1] = bfhi(l4[e2]); r[8 + 2 * e2] = bflo(h4[e2]); r[8 + 2 * e2 + 1] = bfhi(h4[e2]); }
        return r; };
    if (chain_block && wave == 0) {
        f32x16c S0, S1;
#pragma unroll
        for (int i = 0; i < 16; ++i) { S0[i] = 0.f; S1[i] = 0.f; }
        for (int c = 0; c < NCHK; ++c) {
            const int slot = c % RING_SLOTS, ss = c % SSLOTS; const LAS unsigned char* R = lds + slot * SUM_BYTES; LAS unsigned char* SR = sring + ss * 4096;
            const bf16x8c bs0 = cvt8(S0, 0), bs1 = cvt8(S0, 8), bs2 = cvt8(S1, 0), bs3 = cvt8(S1, 8);
            if (c >= SSLOTS) spin_until(sfree + ss, (unsigned)(c - SSLOTS + 1));
            asm volatile("" ::: "memory");
            *(LAS bf16x8c*)(SR + lane * 16) = bs0; *(LAS bf16x8c*)(SR + 1024 + lane * 16) = bs1; *(LAS bf16x8c*)(SR + 2048 + lane * 16) = bs2; *(LAS bf16x8c*)(SR + 3072 + lane * 16) = bs3;
            asm volatile("" ::: "memory");
            if (lane == 0) sfull[ss] = (unsigned)(c + 1);
            spin_until(full + slot, (unsigned)(c + 1));
            asm volatile("" ::: "memory");
            bf16x8c ga[2][4], hi_[2][2];
#pragma unroll
            for (int at2 = 0; at2 < 2; ++at2)
#pragma unroll
                for (int ks = 0; ks < 4; ++ks) ga[at2][ks] = *(const LAS bf16x8c*)(R + ring_swz(SUM_GT + (32 * at2 + tl) * 128 + ks * 32 + hf * 16));
#pragma unroll
            for (int jt = 0; jt < 2; ++jt) { const int o = SUM_HT + ((it * 64 + lane) * 2 + jt) * 32; hi_[jt][0] = *(const LAS bf16x8c*)(R + o); hi_[jt][1] = *(const LAS bf16x8c*)(R + o + 16); }
            LDS_WAIT();
            if (lane == 0) freef[slot] = (unsigned)(c + 1);
            f32x16c n0 = unp16(hi_[0][0], hi_[0][1]), n1 = unp16(hi_[1][0], hi_[1][1]);
            n0 = MFMA32(ga[0][0], bs0, n0); n1 = MFMA32(ga[1][0], bs0, n1);
            n0 = MFMA32(ga[0][1], bs1, n0); n1 = MFMA32(ga[1][1], bs1, n1);
            n0 = MFMA32(ga[0][2], bs2, n0); n1 = MFMA32(ga[1][2], bs2, n1);
            n0 = MFMA32(ga[0][3], bs3, n0); n1 = MFMA32(ga[1][3], bs3, n1);
            S0 = n0; S1 = n1;
        }
    } else if (chain_block && wave == 1) {
        float* Y = (float*)(ws + WS_Y);
        for (int c = 0; c < NCHK; ++c) {
            const int slot = c % RING_SLOTS, ss = c % SSLOTS; const LAS unsigned char* R = lds + slot * SUM_BYTES; const LAS unsigned char* SR = sring + ss * 4096;
            spin_until(full + slot, (unsigned)(c + 1)); spin_until(sfull + ss, (unsigned)(c + 1));
            asm volatile("" ::: "memory");
            bf16x8c qa[4], yi_[2];
#pragma unroll
            for (int ks = 0; ks < 4; ++ks) qa[ks] = *(const LAS bf16x8c*)(R + ring_swz(SUM_QT + tl * 128 + ks * 32 + hf * 16));
            { const int o = SUM_YL + (it * 64 + lane) * 32; yi_[0] = *(const LAS bf16x8c*)(R + o); yi_[1] = *(const LAS bf16x8c*)(R + o + 16); }
            const bf16x8c bs0 = *(const LAS bf16x8c*)(SR + lane * 16), bs1 = *(const LAS bf16x8c*)(SR + 1024 + lane * 16), bs2 = *(const LAS bf16x8c*)(SR + 2048 + lane * 16), bs3 = *(const LAS bf16x8c*)(SR + 3072 + lane * 16);
            LDS_WAIT();
            if (lane == 0) { freeB[slot] = (unsigned)(c + 1); sfree[ss] = (unsigned)(c + 1); }
            f32x16c yv = unp16(yi_[0], yi_[1]);
            yv = MFMA32(qa[0], bs0, yv); yv = MFMA32(qa[1], bs1, yv); yv = MFMA32(qa[2], bs2, yv); yv = MFMA32(qa[3], bs3, yv);
            float* yp = Y + ((size_t)b * SEQ + c * CH) * RW + h * 64 + 32 * it + tl;
#pragma unroll
            for (int i = 0; i < 16; ++i) { const int t = (i & 3) + 8 * (i >> 2) + 4 * hf; yp[(size_t)t * RW] = yv[i]; }
        }
    } else if (chain_block && wave >= 2 && wave < 2 + NLOADW) {
        for (int c = wave - 2; c < NCHK; c += NLOADW) {
            const int slot = c % RING_SLOTS; LAS unsigned char* R = lds + slot * SUM_BYTES;
            const unsigned char* rec = rec0 + (size_t)c * SUM_BYTES;
            v4u buf[18];
#pragma unroll
            for (int k = 0; k < 18; ++k) { const int pc = k < 12 ? k : (k < 16 ? 12 + 4 * it + (k - 12) : 20 + 2 * it + (k - 16)); buf[k] = *(const GAS v4u*)(rec + pc * 1024 + lane * 16); }
            if (c >= RING_SLOTS) { spin_until(freef + slot, (unsigned)(c - RING_SLOTS + 1)); spin_until(freeB + slot, (unsigned)(c - RING_SLOTS + 1)); }
            asm volatile("" ::: "memory");
#pragma unroll
            for (int k = 0; k < 18; ++k) { const int pc = k < 12 ? k : (k < 16 ? 12 + 4 * it + (k - 12) : 20 + 2 * it + (k - 16)); *(LAS v4u*)(R + ring_swz(pc * 1024 + lane * 16)) = buf[k]; }
            LDS_WAIT();
            if (lane == 0) full[slot] = (unsigned)(c + 1);
        }
    } else if (QUANT_IN_SCAN) {
        constexpr int NQW = 6 - NLOADW;
        const int nchain = (G >= 128) ? 128 : 0;
        const int nq = NQW * nchain + 8 * (G - nchain);
        const int qid = chain_block ? NQW * bx + (wave - 2 - NLOADW) : NQW * nchain + 8 * (bx - nchain) + wave;
        quant_rows(a, qid, nq, lane);
    }
    if (G < 128 && bx == 0 && wave == 0) {
        float* Y = (float*)(ws + WS_Y); for (int i = lane; i < 4096; i += 64) Y[i] = __builtin_nanf("");
    }
}

__device__ __forceinline__ void phase6(const Args& a, int gw, int NGW, int lane) {
    unsigned char* ws = a.ws;
    const float* Y = (const float*)(ws + WS_Y); const bf16* V = (const bf16*)(ws + WS_V); const bf16* G = (const bf16*)(ws + WS_G); const float* BON = (const float*)(ws + WS_BONUS);
    const float* lw = a.in[12]; const float* lb = a.in[13]; bf16* MIX = (bf16*)(ws + WS_MIXED);
    constexpr int PB = 4;
    for (int it0 = gw; it0 < M * 4; it0 += PB * NGW) {
        f32x4 y0[PB], y1[PB]; v4u vv[PB], gg[PB]; float bnv[PB];
#pragma unroll
        for (int u = 0; u < PB; ++u) { const int it = it0 + u * NGW; if (it < M * 4) { const int m = it >> 2, ch = (it & 3) * 512 + lane * 8; const size_t o = (size_t)m * RW + ch;
            y0[u] = *(const GAS f32x4*)(Y + o); y1[u] = *(const GAS f32x4*)(Y + o + 4); vv[u] = *(const GAS v4u*)(V + o); gg[u] = *(const GAS v4u*)(G + o); bnv[u] = BON[(size_t)m * NH + (ch >> 6)]; } }
        asm volatile("" ::: "memory");
#pragma unroll
        for (int u = 0; u < PB; ++u) { const int it = it0 + u * NGW; if (it < M * 4) {
            const int m = it >> 2, ch = (it & 3) * 512 + lane * 8;
            float y[8] = {y0[u].x, y0[u].y, y0[u].z, y0[u].w, y1[u].x, y1[u].y, y1[u].z, y1[u].w}, v[8], g[8];
            unpack8(vv[u], v); unpack8(gg[u], g);
            float s = 0.f;
#pragma unroll
            for (int j = 0; j < 8; ++j) s += y[j];
            s += __shfl_xor(s, 1); s += __shfl_xor(s, 2); s += __shfl_xor(s, 4);
            const float mean = s * (1.0f / 64.0f); float q = 0.f;
#pragma unroll
            for (int j = 0; j < 8; ++j) { y[j] -= mean; q += y[j] * y[j]; }
            q += __shfl_xor(q, 1); q += __shfl_xor(q, 2); q += __shfl_xor(q, 4);
            const float rstd = 1.0f / sqrtf(q * (1.0f / 64.0f) + 64e-5f), bn = bnv[u];
            const f32x4 w0 = *(const GAS f32x4*)(lw + ch), w1 = *(const GAS f32x4*)(lw + ch + 4), b0 = *(const GAS f32x4*)(lb + ch), b1 = *(const GAS f32x4*)(lb + ch + 4);
            float r[8];
#pragma unroll
            for (int j = 0; j < 8; ++j) r[j] = (y[j] * rstd * (j < 4 ? w0[j] : w1[j - 4]) + (j < 4 ? b0[j] : b1[j - 4]) + bn * v[j]) * g[j];
            *(GAS v4u*)(MIX + (size_t)m * D + ch) = pack8(r); } }
    }
}

typedef short bf16x8_t __attribute__((ext_vector_type(8)));
typedef float f32x16 __attribute__((ext_vector_type(16)));
__device__ __forceinline__ unsigned f2ord(float f) { const unsigned u = __builtin_bit_cast(unsigned, f); return (u & 0x80000000u) ? ~u : (u | 0x80000000u); }
__device__ __forceinline__ float ord2f(unsigned o) { const unsigned u = (o & 0x80000000u) ? (o & 0x7fffffffu) : ~o; return __builtin_bit_cast(float, u); }
__device__ __forceinline__ void ce_desc(unsigned& x, unsigned& y) { const unsigned hi = max(x, y), lo = min(x, y); x = hi; y = lo; }
template <int B> __device__ __forceinline__ void sort16_desc(unsigned (&u)[64]) {
#define CE(i, j) ce_desc(u[B + (i)], u[B + (j)]);
    CE(0,1) CE(2,3) CE(0,2) CE(1,3) CE(1,2) CE(4,5) CE(6,7) CE(4,6) CE(5,7) CE(5,6) CE(0,4) CE(2,6) CE(2,4) CE(1,5) CE(3,7) CE(3,5) CE(1,2) CE(3,4) CE(5,6) CE(8,9) CE(10,11) CE(8,10) CE(9,11) CE(9,10) CE(12,13) CE(14,15) CE(12,14) CE(13,15) CE(13,14) CE(8,12) CE(10,14) CE(10,12) CE(9,13) CE(11,15) CE(11,13) CE(9,10) CE(11,12) CE(13,14) CE(0,8) CE(4,12) CE(4,8) CE(2,10) CE(6,14) CE(6,10) CE(2,4) CE(6,8) CE(10,12) CE(1,9) CE(5,13) CE(5,9) CE(3,11) CE(7,15) CE(7,11) CE(3,5) CE(7,9) CE(11,13) CE(1,2) CE(3,4) CE(5,6) CE(7,8) CE(9,10) CE(11,12) CE(13,14)
#undef CE
}
template <int B> __device__ __forceinline__ void bitonic16_desc(unsigned (&u)[64]) {
#define CE(i, j) ce_desc(u[B + (i)], u[B + (j)]);
    CE(0,8) CE(1,9) CE(2,10) CE(3,11) CE(4,12) CE(5,13) CE(6,14) CE(7,15) CE(0,4) CE(1,5) CE(2,6) CE(3,7) CE(8,12) CE(9,13) CE(10,14) CE(11,15) CE(0,2) CE(1,3) CE(4,6) CE(5,7) CE(8,10) CE(9,11) CE(12,14) CE(13,15) CE(0,1) CE(2,3) CE(4,5) CE(6,7) CE(8,9) CE(10,11) CE(12,13) CE(14,15)
#undef CE
}
template <int BA, int BB> __device__ __forceinline__ void merge_top16(unsigned (&u)[64]) {
#pragma unroll
    for (int i = 0; i < 16; ++i) u[BA + i] = max(u[BA + i], u[BB + 15 - i]);
    bitonic16_desc<BA>(u);
}
__device__ __forceinline__ void top16_of_64(unsigned (&u)[64]) {
    sort16_desc<0>(u); sort16_desc<16>(u); sort16_desc<32>(u); sort16_desc<48>(u);
    merge_top16<0, 16>(u); merge_top16<32, 48>(u); merge_top16<0, 32>(u);
}
__device__ __forceinline__ void phase9(const Args& a, int gw, int NGW, int lane) {
    unsigned char* ws = a.ws;
    const bf16* SKB = (const bf16*)(ws + WS_SKB); const bf16* Q = (const bf16*)(ws + WS_Q);
    int* EIDX = (int*)(ws + WS_EIDX); float* GATE = (float*)(ws + WS_GATE);
    const int tokl = lane & 31, hh = lane >> 5;
    for (int unit = gw; unit < (M / 32) * PH; unit += NGW) {
        const int h = unit & 7, m0 = (unit >> 3) * 32;
        unsigned tc[2][16];
#pragma unroll
        for (int c = 0; c < 2; ++c) {
            f32x16 acc[4];
#pragma unroll
            for (int t = 0; t < 4; ++t)
#pragma unroll
                for (int r = 0; r < 16; ++r) acc[t][r] = 0.f;
            const bf16* qrow = Q + (size_t)(m0 + tokl) * 2048 + h * 256 + c * 128 + 8 * hh;
            const bf16* krow = SKB + ((size_t)(h * 2 + c) * 128 + tokl) * 128 + 8 * hh;
#pragma unroll 4
            for (int ks = 0; ks < 8; ++ks) {
                const bf16x8_t bq = __builtin_bit_cast(bf16x8_t, *(const GAS v4u*)(qrow + ks * 16));
#pragma unroll
                for (int t = 0; t < 4; ++t) { const bf16x8_t ak = __builtin_bit_cast(bf16x8_t, *(const GAS v4u*)(krow + t * 32 * 128 + ks * 16));
                    acc[t] = __builtin_amdgcn_mfma_f32_32x32x16_bf16(ak, bq, acc[t], 0, 0, 0); }
            }
            unsigned u[64];
#pragma unroll
            for (int t = 0; t < 4; ++t)
#pragma unroll
                for (int r = 0; r < 16; ++r) { const int nb = t * 32 + (r & 3) + 8 * (r >> 2);
                    u[t * 16 + r] = (f2ord(acc[t][r]) & ~127u) | (unsigned)(127 - nb - 4 * hh); }
            top16_of_64(u);
#pragma unroll
            for (int i = 0; i < 16; ++i) { const unsigned p = (unsigned)__shfl_xor((int)u[15 - i], 32); u[16 + i] = p; }
#pragma unroll
            for (int i = 0; i < 16; ++i) u[i] = max(u[i], u[16 + i]);
            bitonic16_desc<0>(u);
#pragma unroll
            for (int i = 0; i < 16; ++i) tc[c][i] = u[i];
        }
        float s0[16], s1[16]; unsigned n0[16], n1[16];
#pragma unroll
        for (int i = 0; i < 16; ++i) { s0[i] = ord2f(tc[0][i] & ~127u); s1[i] = ord2f(tc[1][i] & ~127u); n0[i] = (127u - (tc[0][i] & 127u)) << 7; n1[i] = 127u - (tc[1][i] & 127u); }
        unsigned u[64];
#define CAND(k, i, j) u[k] = (f2ord(s0[i] + s1[j]) & ~0x3FFFu) | (n0[i] | n1[j]);
        CAND(0,0,0) CAND(1,0,1) CAND(2,0,2) CAND(3,0,3) CAND(4,0,4) CAND(5,0,5) CAND(6,0,6) CAND(7,0,7) CAND(8,0,8) CAND(9,0,9) CAND(10,0,10) CAND(11,0,11) CAND(12,0,12) CAND(13,0,13) CAND(14,0,14) CAND(15,0,15) CAND(16,1,0) CAND(17,1,1) CAND(18,1,2) CAND(19,1,3) CAND(20,1,4) CAND(21,1,5) CAND(22,1,6) CAND(23,1,7) CAND(24,2,0) CAND(25,2,1) CAND(26,2,2) CAND(27,2,3) CAND(28,2,4) CAND(29,3,0) CAND(30,3,1) CAND(31,3,2) CAND(32,3,3) CAND(33,4,0) CAND(34,4,1) CAND(35,4,2) CAND(36,5,0) CAND(37,5,1) CAND(38,6,0) CAND(39,6,1) CAND(40,7,0) CAND(41,7,1) CAND(42,8,0) CAND(43,9,0) CAND(44,10,0) CAND(45,11,0) CAND(46,12,0) CAND(47,13,0) CAND(48,14,0) CAND(49,15,0)
#undef CAND
#pragma unroll
        for (int k = 50; k < 64; ++k) u[k] = 0u;
        top16_of_64(u);
        float ex[16]; float den = 0.f; const float mx = ord2f(u[0] & ~0x3FFFu);
#pragma unroll
        for (int r = 0; r < 16; ++r) { ex[r] = __expf(ord2f(u[r] & ~0x3FFFu) - mx); den += ex[r]; }
        const float inv = 1.0f / den;
        if (hh == 0) {
            const size_t o = (size_t)(m0 + tokl) * 128 + h * 16;
#pragma unroll
            for (int r4 = 0; r4 < 4; ++r4) {
                *(GAS v4u*)(EIDX + o + r4 * 4) = (v4u){u[r4 * 4] & 0x3FFFu, u[r4 * 4 + 1] & 0x3FFFu, u[r4 * 4 + 2] & 0x3FFFu, u[r4 * 4 + 3] & 0x3FFFu};
                *(GAS f32x4*)(GATE + o + r4 * 4) = (f32x4){ex[r4 * 4] * inv, ex[r4 * 4 + 1] * inv, ex[r4 * 4 + 2] * inv, ex[r4 * 4 + 3] * inv};
            }
        }
    }
}

__device__ __forceinline__ float gelu_erf(float v) { return 0.5f * v * (1.0f + erff(v * 0.70710678118f)); }
constexpr int PW_BYTES = 1536;
__device__ __forceinline__ void phase10(const Args& a, LAS unsigned char* lds, int gw, int NGW, int wave, int lane, float* OUT) {
    unsigned char* ws = a.ws;
    const bf16* HB = (const bf16*)(ws + WS_XN); const float* SSQ = (const float*)(ws + WS_SSQ);
    const int* EIDX = (const int*)(ws + WS_EIDX); const float* GATE = (const float*)(ws + WS_GATE);
    const unsigned char* DQ = ws + WS_DQ; const unsigned char* UQ = ws + WS_UQ; const float* DS = (const float*)(ws + WS_DSCALE); const float* US = (const float*)(ws + WS_USCALE);
    const float* nfw = a.in[21]; const float* n2w = a.in[16];
    LAS int* le = (LAS int*)(lds + wave * PW_BYTES); LAS float* lg = (LAS float*)(lds + wave * PW_BYTES + 512); LAS float* lc = (LAS float*)(lds + wave * PW_BYTES + 1024);
    for (int m = gw; m < M; m += NGW) {
        int ln = lane; asm volatile("" : "+v"(ln));
        const float rs2 = 1.0f / sqrtf(SSQ[m] * (1.0f / D) + 1e-6f);
        LDS_WAIT();
        le[lane] = EIDX[(size_t)m * 128 + lane]; le[lane + 64] = EIDX[(size_t)m * 128 + 64 + lane];
        lg[lane] = GATE[(size_t)m * 128 + lane]; lg[lane + 64] = GATE[(size_t)m * 128 + 64 + lane];
        float xs[64];
#pragma unroll
        for (int k = 0; k < 16; ++k) { const v2u w = *(const GAS v2u*)(HB + (size_t)m * D + k * 256 + ln * 4);
            xs[4 * k + 0] = bflo(w.x); xs[4 * k + 1] = bfhi(w.x); xs[4 * k + 2] = bflo(w.y); xs[4 * k + 3] = bfhi(w.y); }
        LDS_WAIT();
#if PEER_DN_MFMA
        float amx = 0.f;
#pragma unroll
        for (int i = 0; i < 64; ++i) amx = fmaxf(amx, fabsf(xs[i]));
        amx = fmaxf(wave_max(amx), 1e-30f);
        const float sx = 224.0f * __builtin_amdgcn_rcpf(amx), isx = amx * (1.0f / 224.0f);
        v8i xn0, xn1, xq0, xq1;
#pragma unroll
        for (int w = 0; w < 8; ++w) {
            int p0 = __builtin_amdgcn_cvt_pk_fp8_f32(xs[4 * w] * sx, xs[4 * w + 1] * sx, 0, false); p0 = __builtin_amdgcn_cvt_pk_fp8_f32(xs[4 * w + 2] * sx, xs[4 * w + 3] * sx, p0, true); xn0[w] = p0;
            int p1 = __builtin_amdgcn_cvt_pk_fp8_f32(xs[32 + 4 * w] * sx, xs[32 + 4 * w + 1] * sx, 0, false); p1 = __builtin_amdgcn_cvt_pk_fp8_f32(xs[32 + 4 * w + 2] * sx, xs[32 + 4 * w + 3] * sx, p1, true); xn1[w] = p1; }
        { const int srcA = (ln & 15) + 16 * (ln >> 5), srcB = srcA + 32; const bool odd = (ln & 16) != 0;
#pragma unroll
          for (int r = 0; r < 4; ++r) {
              int lo = __shfl(xn0[r], srcA), hi = __shfl(xn0[4 + r], srcA); xq0[r] = odd ? hi : lo; lo = __shfl(xn0[r], srcB); hi = __shfl(xn0[4 + r], srcB); xq0[4 + r] = odd ? hi : lo;
              lo = __shfl(xn1[r], srcA); hi = __shfl(xn1[4 + r], srcA); xq1[r] = odd ? hi : lo; lo = __shfl(xn1[r], srcB); hi = __shfl(xn1[4 + r], srcB); xq1[4 + r] = odd ? hi : lo; } }
        const bool dgv = ((lane & 15) >> 2) == (lane >> 4);
        const float dm0 = (dgv && (lane & 3) == 0) ? 1.f : 0.f, dm1 = (dgv && (lane & 3) == 1) ? 1.f : 0.f, dm2 = (dgv && (lane & 3) == 2) ? 1.f : 0.f, dm3 = (dgv && (lane & 3) == 3) ? 1.f : 0.f;
#else
        const float isx = 1.0f;
#endif
#pragma unroll 1
        for (int g = 0; g < 8; ++g) {
            float pv[16];
#pragma unroll
            for (int k = 0; k < 16; ++k) {
                const int e = __builtin_amdgcn_readfirstlane(le[g * 16 + k]);
                const unsigned char* rp = DQ + (size_t)e * ROWB_DN + lane * 16;
#if PEER_DN_MFMA
                { const v4u u0 = *(const GAS v4u*)(rp), u1 = *(const GAS v4u*)(rp + 1024);
                  const v8i a0 = {(int)u0.x, (int)u0.y, (int)u0.z, (int)u0.w, 0, 0, 0, 0}, a1 = {(int)u1.x, (int)u1.y, (int)u1.z, (int)u1.w, 0, 0, 0, 0};
                  f32x4 c4 = __builtin_amdgcn_mfma_scale_f32_16x16x128_f8f6f4(a0, xq0, (f32x4){0.f, 0.f, 0.f, 0.f}, 4, 0, 0, 0, 0, 0);
                  c4 = __builtin_amdgcn_mfma_scale_f32_16x16x128_f8f6f4(a1, xq1, c4, 4, 0, 0, 0, 0, 0);
                  pv[k] = (dm0 * c4[0] + dm1 * c4[1]) + (dm2 * c4[2] + dm3 * c4[3]); }
                continue;
#endif
                float ev[64];
#if PEER_DN_FP4
                { const v4u u0 = *(const GAS v4u*)(rp), u1 = *(const GAS v4u*)(rp + 1024);
#pragma unroll
                  for (int w = 0; w < 8; ++w) { const unsigned dw = w < 4 ? u0[w] : u1[w - 4];
#define FP4_DN(b2) { const f32x2 xy = __builtin_amdgcn_cvt_scalef32_pk_f32_fp4(dw, 1.0f, b2); ev[8 * w + 2 * (b2)] = xy.x; ev[8 * w + 2 * (b2) + 1] = xy.y; }
                      FP4_DN(0) FP4_DN(1) FP4_DN(2) FP4_DN(3)
#undef FP4_DN
                  } }
#else
                load_qrow(rp, ev);
#endif
                f32x2 p2a = (f32x2){0.f, 0.f}, p2b = (f32x2){0.f, 0.f};
#pragma unroll
                for (int i = 0; i < 16; ++i) { p2a += (f32x2){ev[4 * i], ev[4 * i + 1]} * (f32x2){xs[4 * i], xs[4 * i + 1]}; p2b += (f32x2){ev[4 * i + 2], ev[4 * i + 3]} * (f32x2){xs[4 * i + 2], xs[4 * i + 3]}; }
                const float p = (p2a.x + p2a.y) + (p2b.x + p2b.y);
                pv[k] = p;
            }
#pragma unroll
            for (int k = 0; k < 8; ++k) { const bool up = (lane & 32) != 0; const float send = up ? pv[k] : pv[k + 8], keep = up ? pv[k + 8] : pv[k]; pv[k] = keep + __shfl_xor(send, 32); }
#pragma unroll
            for (int k = 0; k < 4; ++k) { const bool up = (lane & 16) != 0; const float send = up ? pv[k] : pv[k + 4], keep = up ? pv[k + 4] : pv[k]; pv[k] = keep + __shfl_xor(send, 16); }
#pragma unroll
            for (int k = 0; k < 2; ++k) { const bool up = (lane & 8) != 0; const float send = up ? pv[k] : pv[k + 2], keep = up ? pv[k + 2] : pv[k]; pv[k] = keep + __shfl_xor(send, 8); }
            { const bool up = (lane & 4) != 0; const float send = up ? pv[0] : pv[1], keep = up ? pv[1] : pv[0]; pv[0] = keep + __shfl_xor(send, 4); }
            float tot = pv[0]; tot += __shfl_xor(tot, 1); tot += __shfl_xor(tot, 2);
            const int idx = g * 16 + ((lane >> 2) & 15); const int e = le[idx];
            const float c = lg[idx] * gelu_erf(tot * DS[e] * (rs2 * isx)) * US[e];
            if ((lane & 3) == 0) lc[idx] = c;
        }
        LDS_WAIT();
        float acc[64];
#pragma unroll
        for (int i = 0; i < 64; ++i) acc[i] = 0.f;
#if PEER_UP_FP4
#pragma unroll 2
        for (int idx = 0; idx < 128; ++idx) {
            const int e = __builtin_amdgcn_readfirstlane(le[idx]); const float c = __builtin_bit_cast(float, __builtin_amdgcn_readfirstlane(__builtin_bit_cast(int, lc[idx])));
            const unsigned char* rp = UQ + (size_t)e * ROWB_UP + lane * 16;
            const v4u u0 = *(const GAS v4u*)(rp), u1 = *(const GAS v4u*)(rp + 1024);
            const f32x2 cc = (f32x2){c, c};
#pragma unroll
            for (int w = 0; w < 8; ++w) { const unsigned dw = w < 4 ? u0[w] : u1[w - 4];
#define FP4_UP(b2) { const f32x2 xy = __builtin_amdgcn_cvt_scalef32_pk_f32_fp4(dw, 1.0f, b2); const int t0 = 8 * w + 2 * (b2); acc[t0] += c * xy.x; acc[t0 + 1] += c * xy.y; }
                FP4_UP(0) FP4_UP(1) FP4_UP(2) FP4_UP(3)
#undef FP4_UP
            }
        }
#else
#pragma unroll 4
        for (int idx = 0; idx < 128; ++idx) {
            const int e = __builtin_amdgcn_readfirstlane(le[idx]); const float c = __builtin_bit_cast(float, __builtin_amdgcn_readfirstlane(__builtin_bit_cast(int, lc[idx])));
            const unsigned char* rp = UQ + (size_t)e * ROWB + lane * 16;
            float ev[64]; load_qrow(rp, ev);
#pragma unroll
            for (int i = 0; i < 64; ++i) acc[i] += c * ev[i];
        }
#endif
        float ss = 0.f;
#pragma unroll
        for (int i = 0; i < 4; ++i)
#pragma unroll
            for (int j = 0; j < 4; ++j) { const v2u hw = *(const GAS v2u*)(HB + (size_t)m * D + (i * 4 + j) * 256 + ln * 4); const f32x4 nv = *(const GAS f32x4*)(n2w + (i * 4 + j) * 256 + ln * 4);
                f32x4 hv; hv.x = bflo(hw.x) * __builtin_amdgcn_rcpf(nv.x); hv.y = bfhi(hw.x) * __builtin_amdgcn_rcpf(nv.y); hv.z = bflo(hw.y) * __builtin_amdgcn_rcpf(nv.z); hv.w = bfhi(hw.y) * __builtin_amdgcn_rcpf(nv.w);
                acc[i * 16 + j * 4 + 0] += hv.x; acc[i * 16 + j * 4 + 1] += hv.y; acc[i * 16 + j * 4 + 2] += hv.z; acc[i * 16 + j * 4 + 3] += hv.w;
                ss += (acc[i * 16 + j * 4 + 0] * acc[i * 16 + j * 4 + 0] + acc[i * 16 + j * 4 + 1] * acc[i * 16 + j * 4 + 1]) + (acc[i * 16 + j * 4 + 2] * acc[i * 16 + j * 4 + 2] + acc[i * 16 + j * 4 + 3] * acc[i * 16 + j * 4 + 3]); }
        const float rsf = 1.0f / sqrtf(wave_sum(ss) * (1.0f / D) + 1e-6f);
#pragma unroll
        for (int i = 0; i < 4; ++i)
#pragma unroll
            for (int j = 0; j < 4; ++j) { const f32x4 wv = *(const GAS f32x4*)(nfw + (i * 4 + j) * 256 + ln * 4);
                f32x4 o; o.x = acc[i * 16 + j * 4 + 0] * rsf * wv.x; o.y = acc[i * 16 + j * 4 + 1] * rsf * wv.y; o.z = acc[i * 16 + j * 4 + 2] * rsf * wv.z; o.w = acc[i * 16 + j * 4 + 3] * rsf * wv.w;
                *(GAS f32x4*)(OUT + (size_t)m * D + (i * 4 + j) * 256 + ln * 4) = o; }
    }
}

__global__ void __launch_bounds__(NTHREADS, 2) mega_fwd(Args args) {
    extern __shared__ __attribute__((aligned(16))) unsigned char lds_raw[];
    LAS unsigned char* lds = (LAS unsigned char*)lds_raw;
    volatile LAS unsigned* MISC = (volatile LAS unsigned*)(lds + MISC_OFF);
    const int tid = threadIdx.x, lane = tid & 63, wave = __builtin_amdgcn_readfirstlane(tid >> 6);
    const int G = gridDim.x, bx = blockIdx.x;
    const int vcu = (G % 8 == 0) ? (bx % 8) * (G / 8) + bx / 8 : bx;
    const int gw = vcu * NWAVES + wave, NGW = G * NWAVES, gt = gw * 64 + lane, NGT = NGW * 64;
    unsigned char* ws = args.ws;
    for (int u = tid; u < (LDS_BYTES - LDSCTL_OFF) / 4; u += NTHREADS) ((LAS unsigned*)(lds + LDSCTL_OFF))[u] = 0u;
    __syncthreads();
    XcdBarrier bar; bar.bar = (unsigned*)(ws + WS_CTL) + CW_BAR + args.li * XCD_BAR_WORDS; bar.x = 0; bar.st = nullptr;
    if (MK_N_LAUNCHES == 1) bar = xcd_barrier_post((unsigned*)(ws + WS_CTL) + CW_BAR + args.li * XCD_BAR_WORDS, MISC + 8);
    const int lo = args.ph_lo, hi = args.ph_hi;
#ifndef PHASE_MASK
#define PHASE_MASK 0xfff
#endif
#define IN(k) (((PHASE_MASK >> (k)) & 1) && lo <= (k) && (k) < hi)
#ifndef DUP_MASK
#define DUP_MASK 0
#endif
#define DUP(k) ((DUP_MASK >> (k)) & 1)
#define SEAM(k) do { if (IN(k) && IN((k) + 1)) xcd_barrier(bar); } while (0)

    if (IN(0)) { phase0(args, lds, gw, NGW, wave, lane); if (DUP(0)) { __syncthreads(); phase0(args, lds, gw, NGW, wave, lane); } } SEAM(0);
    if (IN(1)) {
        pg8::Gemm g{(const bf16*)(ws + WS_XN), (const bf16*)(ws + WS_WINT), M, NPROJ, D, D}; pg8::StaticOrder S; S.init(M, NPROJ, G, bx);
        pg8::EpiPlainBf16 E{(bf16*)(ws + WS_PROJ), NPROJ};
        pg8::gemm_phase<pg8::EpiPlainBf16, pg8::StaticOrder, true, true>(lds + RING_OFF, g, S, E);
        if (DUP(1)) { __syncthreads(); pg8::gemm_phase<pg8::EpiPlainBf16, pg8::StaticOrder, true, true>(lds + RING_OFF, g, S, E); }
        for (int u = bx; u < (M / 256) * 2 * KSPLIT; u += G) {
            const int pm = u >> 3, pnl = (u >> 2) & 1, ks = u & 3;
            __syncthreads();
            pg8::Gemm g2{(const bf16*)(ws + WS_XN) + ks * (D / KSPLIT), (const bf16*)(ws + WS_WINT) + (size_t)NPROJ * D + ks * (D / KSPLIT), M, SLABW, D / KSPLIT, D};
            pg8::SingleUnit S2{pm, pnl}; pg8::EpiSlabF32 E2{(float*)(ws + WS_SLAB) + (size_t)ks * M * SLABW, SLABW};
            pg8::gemm_phase<pg8::EpiSlabF32, pg8::SingleUnit, false, true>(lds + RING_OFF, g2, S2, E2);
        }
    } SEAM(1);
    if (IN(2)) { phase2(args, gt, NGT); if (DUP(2)) phase2(args, gt, NGT); } SEAM(2);
    if (IN(3)) {
        pg8::Gemm g{(const bf16*)(ws + WS_LIN), (const bf16*)(ws + WS_WLORA), M, NLORA, KLORA, KLORA}; pg8::StaticOrder S; S.init(M, NLORA, G, bx);
        pg8::EpiLora E{(float*)(ws + WS_WD), (bf16*)(ws + WS_AA), (bf16*)(ws + WS_G), args.in[4], args.in[6]};
        pg8::gemm_phase<pg8::EpiLora, pg8::StaticOrder, true, true>(lds + RING_OFF, g, S, E);
        if (DUP(3)) { __syncthreads(); pg8::gemm_phase<pg8::EpiLora, pg8::StaticOrder, true, true>(lds + RING_OFF, g, S, E); }
    } SEAM(3);
    if (!SCAN_CHUNKED) { if (IN(4)) { phase4(args, gw, NGW, lane); } SEAM(4); }
    if (IN(5)) { if (SCAN_CHUNKED) phase5a(args, lds, gw, NGW, wave, lane); else phase5(args, lds, tid); } SEAM(5);
    if (IN(6)) { if (SCAN_CHUNKED) phase5b(args, lds, bx, G, tid, wave, lane); } SEAM(6);
    if (IN(7)) { phase6(args, gw, NGW, lane); if (DUP(7)) phase6(args, gw, NGW, lane); } SEAM(7);
    if (IN(8)) {
        pg8::Gemm g{(const bf16*)(ws + WS_MIXED), (const bf16*)(ws + WS_WOUTT), M, D, D, D}; pg8::StaticOrder S; S.init(M, D, G, bx);
        pg8::EpiOut<true> E{args.in[0], args.out, (bf16*)(ws + WS_XN), args.in[16], (float*)(ws + WS_SSQ)};
        pg8::gemm_phase<pg8::EpiOut<true>, pg8::StaticOrder, true, true>(lds + RING_OFF, g, S, E);
        if (DUP(8)) { __syncthreads(); pg8::EpiOut<false> E2{args.in[0], args.out, (bf16*)(ws + WS_XN), args.in[16], (float*)(ws + WS_SSQ)}; pg8::gemm_phase<pg8::EpiOut<false>, pg8::StaticOrder, true, true>(lds + RING_OFF, g, S, E2); }
    } SEAM(8);
    if (IN(9)) {
        pg8::Gemm g{(const bf16*)(ws + WS_XN), (const bf16*)(ws + WS_WQT), M, 2048, D, D}; pg8::StaticOrder S; S.init(M, 2048, G, bx);
        pg8::EpiQ E{(bf16*)(ws + WS_Q), (const float*)(ws + WS_SSQ)};
        pg8::gemm_phase<pg8::EpiQ, pg8::StaticOrder, true, true>(lds + RING_OFF, g, S, E);
        if (DUP(9)) { __syncthreads(); pg8::gemm_phase<pg8::EpiQ, pg8::StaticOrder, true, true>(lds + RING_OFF, g, S, E); }
    } SEAM(9);
    if (IN(10)) { phase9(args, gw, NGW, lane); if (DUP(10)) phase9(args, gw, NGW, lane); } SEAM(10);
    if (IN(11)) { if (DUP(11)) phase10(args, lds, gw, NGW, wave, lane, (float*)(ws + WS_PROJ)); phase10(args, lds, gw, NGW, wave, lane, args.out); }
#undef IN
#undef SEAM
}

extern "C" void kernel_launch(void* const* d_in, const int* in_sizes, int n_in, void* d_out, int out_size, void* d_ws, size_t ws_size, hipStream_t stream) {
    static int grid = 0;
    if (grid == 0) {
        if (n_in != 22 || in_sizes[0] != M * D || out_size != M * D || ws_size < WS_END) { fprintf(stderr, "kernel_launch: unexpected shapes: n_in %d in0 %d out %d ws %zu (need %zu)\n", n_in, n_in > 0 ? in_sizes[0] : -1, out_size, ws_size, (size_t)WS_END); grid = -1; return; }
        int dev = 0, cus = 0, per_cu = 0;
        if (hipGetDevice(&dev) != hipSuccess || hipDeviceGetAttribute(&cus, hipDeviceAttributeMultiprocessorCount, dev) != hipSuccess) { grid = -1; return; }
        if (hipFuncSetAttribute((const void*)mega_fwd, hipFuncAttributeMaxDynamicSharedMemorySize, LDS_BYTES) != hipSuccess) { fprintf(stderr, "kernel_launch: hipFuncSetAttribute failed\n"); grid = -1; return; }
        if (hipOccupancyMaxActiveBlocksPerMultiprocessor(&per_cu, (const void*)mega_fwd, NTHREADS, LDS_BYTES) != hipSuccess || per_cu < 1) { fprintf(stderr, "kernel_launch: occupancy query says %d blocks per CU\n", per_cu); }
        (void)hipGetLastError();
        grid = cus;
    }
    if (grid < 0) return;
    (void)hipMemsetAsync((char*)d_ws + WS_CTL, 0, CTL_ZERO_BYTES, stream);
    Args a{};
    for (int i = 0; i < 22; ++i) a.in[i] = (const float*)d_in[i];
    a.out = (float*)d_out; a.ws = (unsigned char*)d_ws;
#ifndef REPEAT_PREFIX
#define REPEAT_PREFIX 0
#endif
    if (MK_N_LAUNCHES == 1) { a.ph_lo = 0; a.ph_hi = NPHASES; hipLaunchKernelGGL(mega_fwd, dim3(grid), dim3(NTHREADS), LDS_BYTES, stream, a);
        if (REPEAT_PREFIX > 0) { a.ph_hi = REPEAT_PREFIX; a.li = 1; hipLaunchKernelGGL(mega_fwd, dim3(grid), dim3(NTHREADS), LDS_BYTES, stream, a); } }
    else for (int p = 0; p < NPHASES; ++p) { a.ph_lo = p; a.ph_hi = p + 1; hipLaunchKernelGGL(mega_fwd, dim3(grid), dim3(NTHREADS), LDS_BYTES, stream, a); }
}
```
